# Optimizing an MI355X kernel written in HIP

```python
import math
import jax, jax.numpy as jnp
from jax import lax
import numpy as np

D_MODEL = 1024
BATCH = 8
SEQ = 2048
DEPTH = 2

CHUNK = 64
N_MIXERS = 2
SB_HEADS = 16
SB_HEAD_DIM = D_MODEL // SB_HEADS
Q_BLOCK = 128
LRU_WIDTH = D_MODEL
LRU_BLOCKS = 16
LRU_BLOCK_W = LRU_WIDTH // LRU_BLOCKS
LRU_C = 8.0
CONV_W = 4
D_FF = 2816
NORM_EPS = 1e-6

kernel_name = "macaron_stickbreak_rglru_hybrid"


def rms_norm(x, gain):
    xf = x.astype(jnp.float32)
    y = xf * lax.rsqrt(jnp.mean(xf * xf, axis=-1, keepdims=True) + NORM_EPS)
    return (y * gain.astype(jnp.float32)).astype(x.dtype)


def swiglu(xn, w_in, w_out):
    gate, up = jnp.split(xn @ w_in, 2, axis=-1)
    return (jax.nn.silu(gate) * up) @ w_out


def stick_breaking_attention(xn, w_qkv, q_gain, k_gain, w_o):
    b, s, _ = xn.shape
    qkv = (xn @ w_qkv).reshape(b, s, 3, SB_HEADS, SB_HEAD_DIM)
    q = rms_norm(qkv[:, :, 0], q_gain).astype(jnp.float32).transpose(0, 2, 1, 3)
    k = rms_norm(qkv[:, :, 1], k_gain).astype(jnp.float32).transpose(0, 2, 1, 3)
    v = qkv[:, :, 2].astype(jnp.float32).transpose(0, 2, 1, 3)
    scale = 1.0 / math.sqrt(SB_HEAD_DIM)
    outs = []
    for blk in range(s // Q_BLOCK):
        lo = blk * Q_BLOCK
        hi = lo + Q_BLOCK
        z = jnp.einsum('bhqd,bhkd->bhqk', q[:, :, lo:hi], k[:, :, :hi]) * scale
        t_idx = lo + jnp.arange(Q_BLOCK)[:, None]
        s_idx = jnp.arange(hi)[None, :]
        mask = s_idx < t_idx
        log_beta = jax.nn.log_sigmoid(z)
        log_1m = jnp.where(mask, jax.nn.log_sigmoid(-z), 0.0)
        rev = lax.cumsum(log_1m, axis=3, reverse=True)
        rev_excl = jnp.concatenate([rev[..., 1:], jnp.zeros_like(rev[..., :1])], axis=-1)
        w = jnp.where(mask, jnp.exp(log_beta + rev_excl), 0.0)
        outs.append(jnp.einsum('bhqk,bhkd->bhqd', w, v[:, :, :hi]))
    o = jnp.concatenate(outs, axis=2)
    o = o.transpose(0, 2, 1, 3).reshape(b, s, SB_HEADS * SB_HEAD_DIM).astype(xn.dtype)
    return o @ w_o


def rglru_block(xn, w_in, conv_w, conv_b, w_r, b_r, w_i, b_i, lam, w_o):
    b, s, _ = xn.shape
    xb, yb = jnp.split(xn @ w_in, 2, axis=-1)
    y = jax.nn.gelu(yb, approximate=True)
    xpad = jnp.pad(xb, ((0, 0), (CONV_W - 1, 0), (0, 0)))
    xc = conv_b + sum(conv_w[j] * xpad[:, j:j + s] for j in range(CONV_W))
    xh = xc.reshape(b, s, LRU_BLOCKS, LRU_BLOCK_W)
    r = jax.nn.sigmoid(jnp.einsum('bsnc,ncd->bsnd', xh, w_r).reshape(b, s, LRU_WIDTH) + b_r)
    i = jax.nn.sigmoid(jnp.einsum('bsnc,ncd->bsnd', xh, w_i).reshape(b, s, LRU_WIDTH) + b_i)
    log_a = LRU_C * r.astype(jnp.float32) * jax.nn.log_sigmoid(lam.astype(jnp.float32))
    a = jnp.exp(log_a)
    mult = jnp.sqrt(-jnp.expm1(2.0 * log_a))
    u = mult * (i * xc).astype(jnp.float32)

    def combine(left, right):
        a_l, h_l = left
        a_r, h_r = right
        return a_l * a_r, a_r * h_l + h_r

    _, h = lax.associative_scan(combine, (a, u), axis=1)
    return (h.astype(xn.dtype) * y) @ w_o


def setup_inputs(seed: int = 0) -> dict:
    key = jax.random.key(seed)
    keys = iter(jax.random.split(key, 40))

    def normal(shape, scale):
        return jax.random.normal(next(keys), shape, jnp.float32) * scale

    def gain(n):
        return 1.0 + normal((n,), 0.02)

    def lam_init(n):
        a_c = jax.random.uniform(next(keys), (n,), jnp.float32, 0.9, 0.999)
        a = a_c ** (1.0 / LRU_C)
        return jnp.log(a) - jnp.log1p(-a)

    d, f, w = D_MODEL, D_FF, LRU_WIDTH
    p = {}
    p["x"] = normal((BATCH, SEQ, d), 1.0)
    p["l0_ff1_norm"] = gain(d)
    p["l0_ff1_w_in"] = normal((d, 2 * f), d ** -0.5)
    p["l0_ff1_w_out"] = normal((f, d), f ** -0.5)
    p["l0_mix_norm"] = gain(d)
    p["l0_sb_w_qkv"] = normal((d, 3 * SB_HEADS * SB_HEAD_DIM), d ** -0.5)
    p["l0_sb_q_norm"] = gain(SB_HEAD_DIM)
    p["l0_sb_k_norm"] = gain(SB_HEAD_DIM)
    p["l0_sb_w_o"] = normal((SB_HEADS * SB_HEAD_DIM, d), d ** -0.5)
    p["l0_ff2_norm"] = gain(d)
    p["l0_ff2_w_in"] = normal((d, 2 * f), d ** -0.5)
    p["l0_ff2_w_out"] = normal((f, d), f ** -0.5)
    p["l1_ff1_norm"] = gain(d)
    p["l1_ff1_w_in"] = normal((d, 2 * f), d ** -0.5)
    p["l1_ff1_w_out"] = normal((f, d), f ** -0.5)
    p["l1_mix_norm"] = gain(d)
    p["l1_lru_w_in"] = normal((d, 2 * w), d ** -0.5)
    p["l1_lru_conv_w"] = normal((CONV_W, w), CONV_W ** -0.5)
    p["l1_lru_conv_b"] = normal((w,), 0.01)
    p["l1_lru_w_r"] = normal((LRU_BLOCKS, LRU_BLOCK_W, LRU_BLOCK_W), LRU_BLOCK_W ** -0.5)
    p["l1_lru_b_r"] = normal((w,), 0.01)
    p["l1_lru_w_i"] = normal((LRU_BLOCKS, LRU_BLOCK_W, LRU_BLOCK_W), LRU_BLOCK_W ** -0.5)
    p["l1_lru_b_i"] = normal((w,), 0.01)
    p["l1_lru_lambda"] = lam_init(w)
    p["l1_lru_w_o"] = normal((w, d), w ** -0.5)
    p["l1_ff2_norm"] = gain(d)
    p["l1_ff2_w_in"] = normal((d, 2 * f), d ** -0.5)
    p["l1_ff2_w_out"] = normal((f, d), f ** -0.5)
    return p


def reference(x,
              l0_ff1_norm, l0_ff1_w_in, l0_ff1_w_out,
              l0_mix_norm, l0_sb_w_qkv, l0_sb_q_norm, l0_sb_k_norm, l0_sb_w_o,
              l0_ff2_norm, l0_ff2_w_in, l0_ff2_w_out,
              l1_ff1_norm, l1_ff1_w_in, l1_ff1_w_out,
              l1_mix_norm, l1_lru_w_in, l1_lru_conv_w, l1_lru_conv_b,
              l1_lru_w_r, l1_lru_b_r, l1_lru_w_i, l1_lru_b_i, l1_lru_lambda, l1_lru_w_o,
              l1_ff2_norm, l1_ff2_w_in, l1_ff2_w_out):
    ffn1 = [(l0_ff1_norm, l0_ff1_w_in, l0_ff1_w_out),
            (l1_ff1_norm, l1_ff1_w_in, l1_ff1_w_out)]
    ffn2 = [(l0_ff2_norm, l0_ff2_w_in, l0_ff2_w_out),
            (l1_ff2_norm, l1_ff2_w_in, l1_ff2_w_out)]
    mixers = [(l0_mix_norm, (l0_sb_w_qkv, l0_sb_q_norm, l0_sb_k_norm, l0_sb_w_o)),
              (l1_mix_norm, (l1_lru_w_in, l1_lru_conv_w, l1_lru_conv_b, l1_lru_w_r, l1_lru_b_r,
                             l1_lru_w_i, l1_lru_b_i, l1_lru_lambda, l1_lru_w_o))]
    for layer in range(DEPTH):
        n1, wi1, wo1 = ffn1[layer]
        x = x + 0.5 * swiglu(rms_norm(x, n1), wi1, wo1)
        mix_norm, mix_params = mixers[layer]
        xn = rms_norm(x, mix_norm)
        if layer % N_MIXERS == 0:
            x = x + stick_breaking_attention(xn, *mix_params)
        else:
            x = x + rglru_block(xn, *mix_params)
        n2, wi2, wo2 = ffn2[layer]
        x = x + 0.5 * swiglu(rms_norm(x, n2), wi2, wo2)
    return x
```

```cpp
#include <hip/hip_runtime.h>
#include <hip/hip_cooperative_groups.h>
#include <cstdio>
#include <cstdint>
namespace cg = cooperative_groups;
__device__ __forceinline__ int lane_id_() { int l; asm volatile("v_mbcnt_lo_u32_b32 %0, -1, 0\n\tv_mbcnt_hi_u32_b32 %0, -1, %0" : "=v"(l)); return l; }
namespace pg8 {
#define PG8_LAS __attribute__((address_space(3)))
typedef unsigned short bf16_t;
typedef short bf16x8 __attribute__((ext_vector_type(8)));
typedef float f32x4 __attribute__((ext_vector_type(4)));
typedef unsigned u32x4 __attribute__((ext_vector_type(4)));
constexpr int BM = 256, BK = 64, HALF = 128, HTB = HALF * BK * 2  , STAGE_BYTES = 8 * HTB, NXCD = 8, WGM = 8;

__host__ __device__ __forceinline__ int lds_byte(int r, int c) { const int st = (r >> 4) * 2 + (c >> 5), rr = r & 15, cc = c & 31, ob = rr * 64 + cc * 2; return st * 1024 + (ob ^ (((ob >> 9) & 1) << 5)); }
__host__ __device__ __forceinline__ void stage_rc(int b, int& R, int& C) { const int st = b / 1024, sb = b % 1024, swz = sb ^ (((sb >> 9) & 1) << 5); R = (st >> 1) * 16 + swz / 64; C = (st & 1) * 32 + (swz % 64) / 2; }
__host__ __device__ __forceinline__ int perm32(int rho) { const int n = rho >> 4, i = rho & 15; return 8 * (i >> 2) + 4 * n + (i & 3); }

struct Unit { int pm, pn; };
struct Gemm { const bf16_t* A; const bf16_t* Bt; int M, N, K; };

struct StaticOrder {
    int nM, nN, nwg, G, c;
    __host__ __device__ void init(int M, int N, int G_, int c_) { nM = M / BM; nN = N / BM; nwg = nM * nN; G = G_; c = c_; }
    __host__ __device__ bool next(int i, Unit& u) const {
        const long L = (long)i * G + c; if (L >= nwg) return false;
        int wgid = (int)L; { const int q = nwg / NXCD, r = nwg % NXCD, xcd = wgid % NXCD, off = wgid / NXCD; wgid = (xcd < r ? xcd * (q + 1) : r * (q + 1) + (xcd - r) * q) + off; }
        const int nig = WGM * nN, gid = wgid / nig, fm = gid * WGM, gsz = (nM - fm) < WGM ? (nM - fm) : WGM;
        u.pm = fm + ((wgid % nig) % gsz); u.pn = (wgid % nig) / gsz; return true;
    }
    __device__ __forceinline__ void a_ready(const Unit&) const {}
    __device__ __forceinline__ void done(const Unit&) const {}
};

__device__ __forceinline__ unsigned cvt_pk_bf16(float lo, float hi) { unsigned r; asm volatile("v_cvt_pk_bf16_f32 %0, %1, %2" : "=v"(r) : "v"(lo), "v"(hi)); return r; }
typedef float f32x2 __attribute__((ext_vector_type(2)));
__device__ __forceinline__ unsigned pk_bf16(float lo, float hi) { typedef __bf16 b2_t __attribute__((ext_vector_type(2))); f32x2 v = {lo, hi}; b2_t b = __builtin_convertvector(v, b2_t); return __builtin_bit_cast(unsigned, b); }
__device__ __forceinline__ float fast_sigmoid(float v) { return __builtin_amdgcn_rcpf(1.0f + __builtin_amdgcn_exp2f(-1.44269504089f * v)); }
struct EpiSwiglu {
    static constexpr bool PERM = true, AFTER_DRAIN = false; static constexpr int NSTORES = 8;
    bf16_t* H; int ldh; const float* ssq;
    __device__ __forceinline__ void operator()(const f32x4 (&acc)[2][2][4][2], const Unit& u, int wr, int wc, int fr, int fq) const {
        const int row0 = u.pm * BM + wr * 64 + fr, col0 = u.pn * HALF + wc * 32 + 8 * fq;
#pragma unroll
        for (int ai = 0; ai < 2; ++ai)
#pragma unroll
            for (int m = 0; m < 4; ++m) {
                bf16_t* p = H + (size_t)(row0 + ai * HALF + m * 16) * ldh + col0;
                const float rstd = __builtin_amdgcn_rsqf(ssq[row0 + ai * HALF + m * 16] * (1.0f / 1024.0f) + 1e-6f);
                float h[8];
#pragma unroll
                for (int n = 0; n < 2; ++n)
#pragma unroll
                    for (int j = 0; j < 4; ++j) { const float g = acc[ai][0][m][n][j] * rstd, up = acc[ai][1][m][n][j] * rstd; h[4 * n + j] = g * fast_sigmoid(g) * up; }
                u32x4 w; w.x = pk_bf16(h[0], h[1]); w.y = pk_bf16(h[2], h[3]); w.z = pk_bf16(h[4], h[5]); w.w = pk_bf16(h[6], h[7]);
                *(u32x4*)p = w;
            }
    }
};
template <bool FIRST, bool LAST, bool HALF_ALPHA> struct EpiResid {
    static constexpr bool PERM = true, AFTER_DRAIN = false; static constexpr int NSTORES = 0;
    const float* base32; float* out32; bf16_t* xn; float* ssq;
    __device__ __forceinline__ void operator()(const f32x4 (&acc)[2][2][4][2], const Unit& u, int wr, int wc, int fr, int fq) const {
        const int row0 = u.pm * BM + wr * 64 + fr, col0 = u.pn * BM + wc * 32 + 8 * fq;
        constexpr float alpha = HALF_ALPHA ? 0.5f : 1.0f;
#pragma unroll
        for (int ai = 0; ai < 2; ++ai)
#pragma unroll
            for (int m = 0; m < 4; ++m) {
                float s = 0.f;
#pragma unroll
                for (int bj = 0; bj < 2; ++bj) {
                    const size_t off = (size_t)(row0 + ai * HALF + m * 16) * 1024 + col0 + bj * HALF;
                    f32x4 b0, b1;
                    if (FIRST) { b0 = *(const f32x4*)(base32 + off); b1 = *(const f32x4*)(base32 + off + 4); }
                    else { const u32x4 r = *(const u32x4*)(xn + off);
                        b0 = (f32x4){__uint_as_float(r.x << 16), __uint_as_float(r.x & 0xffff0000u), __uint_as_float(r.y << 16), __uint_as_float(r.y & 0xffff0000u)};
                        b1 = (f32x4){__uint_as_float(r.z << 16), __uint_as_float(r.z & 0xffff0000u), __uint_as_float(r.w << 16), __uint_as_float(r.w & 0xffff0000u)}; }
                    const f32x4 v0 = b0 + alpha * acc[ai][bj][m][0], v1 = b1 + alpha * acc[ai][bj][m][1];
                    if (LAST) { *(f32x4*)(out32 + off) = v0; *(f32x4*)(out32 + off + 4) = v1; }
                    else {
                        u32x4 w; w.x = pk_bf16(v0[0], v0[1]); w.y = pk_bf16(v0[2], v0[3]); w.z = pk_bf16(v1[0], v1[1]); w.w = pk_bf16(v1[2], v1[3]);
                        *(u32x4*)(xn + off) = w;
                        const float r0 = __uint_as_float(w.x << 16), r1 = __uint_as_float(w.x & 0xffff0000u), r2 = __uint_as_float(w.y << 16), r3 = __uint_as_float(w.y & 0xffff0000u);
                        const float r4 = __uint_as_float(w.z << 16), r5 = __uint_as_float(w.z & 0xffff0000u), r6 = __uint_as_float(w.w << 16), r7 = __uint_as_float(w.w & 0xffff0000u);
                        s += (r0 * r0 + r1 * r1) + (r2 * r2 + r3 * r3) + (r4 * r4 + r5 * r5) + (r6 * r6 + r7 * r7);
                    }
                }
                if (!LAST) { s += __shfl_xor(s, 16); s += __shfl_xor(s, 32); if (fq == 0) __hip_atomic_fetch_add(ssq + row0 + ai * HALF + m * 16, s, __ATOMIC_RELAXED, __HIP_MEMORY_SCOPE_AGENT); }
            }
    }
};
template <int GELU_FROM> struct EpiSplit {
    static constexpr bool PERM = true, AFTER_DRAIN = false; static constexpr int NSTORES = 16;
    bf16_t* O; size_t split_stride; const float* ssq;
    __device__ __forceinline__ void operator()(const f32x4 (&acc)[2][2][4][2], const Unit& u, int wr, int wc, int fr, int fq) const {
        const int t = u.pn >> 2; bf16_t* basep = O + (size_t)t * split_stride;
        const int row0 = u.pm * BM + wr * 64 + fr, col0 = (u.pn & 3) * BM + wc * 32 + 8 * fq;
        const bool act = t >= GELU_FROM;
#pragma unroll
        for (int ai = 0; ai < 2; ++ai)
#pragma unroll
            for (int m = 0; m < 4; ++m) {
                const float rstd = __builtin_amdgcn_rsqf(ssq[row0 + ai * HALF + m * 16] * (1.0f / 1024.0f) + 1e-6f);
#pragma unroll
                for (int bj = 0; bj < 2; ++bj) {
                    float h[8];
#pragma unroll
                    for (int n = 0; n < 2; ++n)
#pragma unroll
                        for (int j = 0; j < 4; ++j) { float v = acc[ai][bj][m][n][j] * rstd;
                            if (act) { const float z = 1.5957691216f * (v + 0.044715f * v * v * v); v = v * fast_sigmoid(z); }
                            h[4 * n + j] = v; }
                    u32x4 w; w.x = pk_bf16(h[0], h[1]); w.y = pk_bf16(h[2], h[3]); w.z = pk_bf16(h[4], h[5]); w.w = pk_bf16(h[6], h[7]);
                    *(u32x4*)(basep + (size_t)(row0 + ai * HALF + m * 16) * 1024 + col0 + bj * HALF) = w;
                }
            }
    }
};
template <class Epi, class Sched, bool ALIGN_EPI = false, bool SP2 = false>
__device__ __forceinline__ void gemm_phase(PG8_LAS unsigned char* lds, const Gemm g, const Sched& S, const Epi& E, int wave_s) {
    int tid = wave_s * 64 + lane_id_(); asm volatile("" : "+v"(tid));
    const int wid = __builtin_amdgcn_readfirstlane(tid >> 6), lane = tid & 63, wr = wid >> 2, wc = wid & 3, fr = lane & 15, fq = lane >> 4;
    const int K = g.K, nt = K / BK;
    unsigned voffA[2], voffB[2];
#pragma unroll
    for (int i = 0; i < 2; ++i) { int R, C; stage_rc(tid * 16 + i * 8192, R, C); const int Rb = Epi::PERM ? ((R & ~31) + perm32(R & 31)) : R;
        voffA[i] = (unsigned)(R * K + C) * 2u; voffB[i] = (unsigned)(Rb * K + C) * 2u; }
    const size_t kstep = (size_t)(BK * 2);
    const size_t hstep = (size_t)HALF * K * 2;
    const size_t tstep = 2 * hstep;
    const unsigned ldsw = (unsigned)wid * 1024u;
    const int aoff = lds_byte(wr * 64 + fr, fq * 8), boff = lds_byte(wc * 32 + fr, fq * 8);
#define PG8_SA(b, h) (((b) * 2 + (h)) * HTB)
#define PG8_SB(b, h) ((4 + (b) * 2 + (h)) * HTB)
#define PG8_STAGE(bufoff, gbase, voff) do { _Pragma("unroll") for (int _i = 0; _i < 2; ++_i) \
        __builtin_amdgcn_global_load_lds((const unsigned*)((const char*)(gbase) + (voff)[_i]), (PG8_LAS unsigned*)(lds + (bufoff) + ldsw + _i * 8192), 16, 0, 0); } while (0)
#define PG8_LDA(dst, b, h) do { _Pragma("unroll") for (int m = 0; m < 4; ++m) _Pragma("unroll") for (int k = 0; k < 2; ++k) dst[m][k] = *(const PG8_LAS bf16x8*)(lds + PG8_SA(b, h) + aoff + m * 2048 + k * 1024); } while (0)
#define PG8_LDB(dst, b, h) do { _Pragma("unroll") for (int n = 0; n < 2; ++n) _Pragma("unroll") for (int k = 0; k < 2; ++k) dst[n][k] = *(const PG8_LAS bf16x8*)(lds + PG8_SB(b, h) + boff + n * 2048 + k * 1024); } while (0)
#define PG8_MMA(ai, bj, At, Bt) do { __builtin_amdgcn_s_setprio(1); _Pragma("unroll") for (int m = 0; m < 4; ++m) _Pragma("unroll") for (int n = 0; n < 2; ++n) _Pragma("unroll") for (int k = 0; k < 2; ++k) \
        acc[ai][bj][m][n] = __builtin_amdgcn_mfma_f32_16x16x32_bf16(Bt[n][k], At[m][k], acc[ai][bj][m][n], 0, 0, 0); __builtin_amdgcn_s_setprio(0); } while (0)
#define PG8_WAIT_V(n) asm volatile("s_waitcnt vmcnt(" #n ")" ::: "memory")
#define PG8_WAIT_L(n) asm volatile("s_waitcnt lgkmcnt(" #n ")" ::: "memory")
#define PG8_WAIT_V8_STRICT() asm volatile("s_waitcnt vmcnt(8)" ::: "memory")
#define PG8_WAIT_V8_RELAX() do { if constexpr (Epi::NSTORES == 8) asm volatile("s_waitcnt vmcnt(16)" ::: "memory"); else if constexpr (Epi::NSTORES == 16) asm volatile("s_waitcnt vmcnt(24)" ::: "memory"); else asm volatile("s_waitcnt vmcnt(8)" ::: "memory"); } while (0)
#define PG8_BAR __builtin_amdgcn_s_barrier()
#define PG8_SCHED __builtin_amdgcn_sched_barrier(0)
#define PG8_SP2_PAIR(WAITM) do { \
            PG8_LDB(B0, 0, 0); PG8_LDB(B1, 0, 1); PG8_SCHED; PG8_LDA(At, 0, 0); PG8_STAGE(PG8_SA(1, 1), a1 + hstep, voffA); \
            WAITM(); PG8_WAIT_L(0); PG8_BAR; PG8_MMA(0, 0, At, B0); PG8_MMA(0, 1, At, B1); PG8_BAR; PG8_SCHED; \
            PG8_LDA(At, 0, 1); PG8_STAGE(PG8_SB(0, 0), b2, voffB); PG8_STAGE(PG8_SB(0, 1), b2 + hstep, voffB); PG8_STAGE(PG8_SA(0, 0), a2, voffA); \
            WAITM(); PG8_WAIT_L(0); PG8_BAR; PG8_MMA(1, 0, At, B0); PG8_MMA(1, 1, At, B1); PG8_BAR; PG8_SCHED; \
            PG8_LDB(B0, 1, 0); PG8_LDB(B1, 1, 1); PG8_SCHED; PG8_LDA(At, 1, 0); PG8_STAGE(PG8_SA(0, 1), a2 + hstep, voffA); \
            WAITM(); PG8_WAIT_L(0); PG8_BAR; PG8_MMA(0, 0, At, B0); PG8_MMA(0, 1, At, B1); PG8_BAR; PG8_SCHED; \
            PG8_LDA(At, 1, 1); PG8_STAGE(PG8_SB(1, 0), b3, voffB); PG8_STAGE(PG8_SB(1, 1), b3 + hstep, voffB); PG8_STAGE(PG8_SA(1, 0), a3, voffA); \
            WAITM(); PG8_WAIT_L(0); PG8_BAR; PG8_MMA(1, 0, At, B0); PG8_MMA(1, 1, At, B1); PG8_BAR; PG8_SCHED; \
            } while (0)
    Unit cur, nxt; int ui = 0; bool peeled = false;
    if (!S.next(0, cur)) return;
    f32x4 acc[2][2][4][2];
#pragma unroll
    for (int a = 0; a < 2; ++a)
#pragma unroll
        for (int b = 0; b < 2; ++b)
#pragma unroll
            for (int m = 0; m < 4; ++m)
#pragma unroll
                for (int n = 0; n < 2; ++n) acc[a][b][m][n] = (f32x4){0.f, 0.f, 0.f, 0.f};
    bf16x8 At[4][2], B0[2][2], B1[2][2];
    const char* cA = (const char*)g.A + (size_t)cur.pm * tstep; const char* cB = (const char*)g.Bt + (size_t)cur.pn * tstep;
    S.a_ready(cur);
    if constexpr (SP2) {
        PG8_STAGE(PG8_SB(0, 0), cB, voffB); PG8_STAGE(PG8_SB(0, 1), cB + hstep, voffB); PG8_STAGE(PG8_SA(0, 0), cA, voffA); PG8_STAGE(PG8_SA(0, 1), cA + hstep, voffA);
        if (wr == 1) PG8_BAR;
        PG8_WAIT_V(2); PG8_BAR;
        PG8_STAGE(PG8_SB(1, 0), cB + kstep, voffB); PG8_STAGE(PG8_SA(1, 0), cA + kstep, voffA); PG8_STAGE(PG8_SB(1, 1), cB + hstep + kstep, voffB);
        PG8_WAIT_V(6); PG8_BAR;
    } else {
        PG8_STAGE(PG8_SB(0, 0), cB, voffB); PG8_STAGE(PG8_SA(0, 0), cA, voffA); PG8_STAGE(PG8_SB(0, 1), cB + hstep, voffB); PG8_STAGE(PG8_SA(0, 1), cA + hstep, voffA);
        if (wr == 1) PG8_BAR;
        PG8_WAIT_V(4); PG8_BAR;
        PG8_STAGE(PG8_SB(1, 0), cB + kstep, voffB); PG8_STAGE(PG8_SA(1, 0), cA + kstep, voffA); PG8_STAGE(PG8_SB(1, 1), cB + hstep + kstep, voffB);
        PG8_WAIT_V(6); PG8_BAR;
    }
    for (;;) {
        const bool has_next = S.next(ui + 1, nxt);
        const char* nA = has_next ? (const char*)g.A + (size_t)nxt.pm * tstep : cA; const char* nB = has_next ? (const char*)g.Bt + (size_t)nxt.pn * tstep : cB;
        for (int t = peeled ? 2 : 0; t < nt; t += 2) {
            const bool last = (t == nt - 2);
            const char* a1 = cA + (size_t)(t + 1) * kstep;
            const char* a2 = last ? nA : cA + (size_t)(t + 2) * kstep; const char* b2 = last ? nB : cB + (size_t)(t + 2) * kstep;
            const char* a3 = a2 + kstep; const char* b3 = b2 + kstep;
            if (last && has_next) S.a_ready(nxt);
            if constexpr (SP2) {
            PG8_SP2_PAIR(PG8_WAIT_V8_STRICT);
            } else {
            PG8_LDB(B0, 0, 0); PG8_SCHED; PG8_LDA(At, 0, 0); PG8_STAGE(PG8_SA(1, 1), a1 + hstep, voffA);
            PG8_WAIT_L(8); PG8_BAR; PG8_WAIT_L(0); PG8_MMA(0, 0, At, B0); PG8_BAR; PG8_SCHED;
            PG8_LDB(B1, 0, 1); PG8_STAGE(PG8_SB(0, 0), b2, voffB);
            PG8_BAR; PG8_WAIT_L(0); PG8_MMA(0, 1, At, B1); PG8_BAR;
            PG8_LDA(At, 0, 1); PG8_STAGE(PG8_SA(0, 0), a2, voffA);
            PG8_BAR; PG8_WAIT_L(0); PG8_MMA(1, 0, At, B0); PG8_BAR; PG8_SCHED;
            PG8_STAGE(PG8_SB(0, 1), b2 + hstep, voffB);
            PG8_WAIT_V(6); PG8_BAR; PG8_MMA(1, 1, At, B1); PG8_BAR;
            PG8_LDB(B0, 1, 0); PG8_SCHED; PG8_LDA(At, 1, 0); PG8_STAGE(PG8_SA(0, 1), a2 + hstep, voffA);
            PG8_WAIT_L(8); PG8_BAR; PG8_WAIT_L(0); PG8_MMA(0, 0, At, B0); PG8_BAR; PG8_SCHED;
            PG8_LDB(B1, 1, 1); PG8_STAGE(PG8_SB(1, 0), b3, voffB);
            PG8_BAR; PG8_WAIT_L(0); PG8_MMA(0, 1, At, B1); PG8_BAR;
            PG8_LDA(At, 1, 1); PG8_STAGE(PG8_SA(1, 0), a3, voffA);
            PG8_BAR; PG8_WAIT_L(0); PG8_MMA(1, 0, At, B0); PG8_BAR; PG8_SCHED;
            PG8_STAGE(PG8_SB(1, 1), b3 + hstep, voffB);
            PG8_WAIT_V(6); PG8_BAR; PG8_MMA(1, 1, At, B1); PG8_BAR;
            }
        }
        if constexpr (ALIGN_EPI) { if (wr == 0) PG8_BAR; }
        if constexpr (!Epi::AFTER_DRAIN) { E(acc, cur, wr, wc, fr, fq); S.done(cur); }
        if (!has_next) break;
#pragma unroll
        for (int a = 0; a < 2; ++a)
#pragma unroll
            for (int b = 0; b < 2; ++b)
#pragma unroll
                for (int m = 0; m < 4; ++m)
#pragma unroll
                    for (int n = 0; n < 2; ++n) acc[a][b][m][n] = (f32x4){0.f, 0.f, 0.f, 0.f};
        cur = nxt; cA = nA; cB = nB; ++ui;
        if constexpr (ALIGN_EPI) { if (wr == 1) PG8_BAR; }
        if constexpr (SP2 && Epi::NSTORES > 0 && !Epi::AFTER_DRAIN) {
            const char* a1 = cA + kstep; const char* a2 = cA + 2 * kstep; const char* b2 = cB + 2 * kstep; const char* a3 = a2 + kstep; const char* b3 = b2 + kstep;
            PG8_SP2_PAIR(PG8_WAIT_V8_RELAX);
            peeled = true;
        }
    }
    PG8_WAIT_V(0);
    if constexpr (!ALIGN_EPI) { if (wr == 0) PG8_BAR; }
    PG8_BAR;
    if constexpr (Epi::AFTER_DRAIN) { E.fused(acc, cur, wr, wc, fr, fq, lds, wid, lane); S.done(cur); }
#undef PG8_SA
#undef PG8_SB
#undef PG8_STAGE
#undef PG8_LDA
#undef PG8_LDB
#undef PG8_MMA
#undef PG8_WAIT_V
#undef PG8_WAIT_L
#undef PG8_SP2_PAIR
#undef PG8_BAR
#undef PG8_SCHED
}
}
constexpr int BATCH = 8, SEQ = 2048, D = 1024, M = BATCH * SEQ, FF = 2816, NH = 16, HD = 64;
constexpr float EPS = 1e-6f;
constexpr size_t MiB = 1u << 20;
constexpr size_t WS_CTL = 0, WS_SSQ = 65536, CTL_ZERO_BYTES = 65536 + 6 * 65536;
constexpr size_t WS_SUM = 1 * MiB;
constexpr size_t WS_W = 3 * MiB;
constexpr size_t SZ_WIN = (size_t)2 * FF * D * 2, SZ_WOUT = (size_t)D * FF * 2;
constexpr size_t W_FF0 = WS_W, W_FF1 = W_FF0 + SZ_WIN + SZ_WOUT, W_FF2 = W_FF1 + SZ_WIN + SZ_WOUT, W_FF3 = W_FF2 + SZ_WIN + SZ_WOUT;
constexpr size_t W_QKV = W_FF3 + SZ_WIN + SZ_WOUT, W_O = W_QKV + (size_t)3 * D * D * 2, W_LIN = W_O + (size_t)D * D * 2, W_LO = W_LIN + (size_t)2 * D * D * 2;
constexpr size_t W_GR = W_LO + (size_t)D * D * 2, W_GI = W_GR + 16 * 64 * 64 * 2, W_END = W_GI + 16 * 64 * 64 * 2;
constexpr size_t WS_XN = 84 * MiB;
constexpr size_t WS_ACT = 116 * MiB;
constexpr size_t WS_END = WS_ACT + 96 * MiB;
static_assert(W_END <= WS_XN && WS_XN + (size_t)M * D * 2 <= WS_ACT && WS_END <= 256 * MiB && (size_t)M * FF * 2 <= 96 * MiB, "d_ws map");
constexpr int LDS_BYTES = 147456;

#define LAS __attribute__((address_space(3)))
typedef unsigned short bf16;
typedef unsigned v4u __attribute__((ext_vector_type(4)));
typedef unsigned v2u __attribute__((ext_vector_type(2)));
typedef float f32x4 __attribute__((ext_vector_type(4)));
typedef float f32x16 __attribute__((ext_vector_type(16)));
typedef short bf16x8 __attribute__((ext_vector_type(8)));
using pg8::pk_bf16;
__device__ __forceinline__ float bf_lo(unsigned u) { return __uint_as_float(u << 16); }
__device__ __forceinline__ float bf_hi(unsigned u) { return __uint_as_float(u & 0xffff0000u); }
__device__ __forceinline__ float wave_sum(float v) {
#pragma unroll
    for (int o = 1; o < 64; o <<= 1) v += __shfl_xor(v, o);
    return v;
}
#define LOG2E 1.44269504089f
#define LN2 0.69314718056f

__device__ __forceinline__ void transpose_tile(const float* W, const float* gain, int K, int N, int k0, int n0, bf16* WT, int drow0, LAS float* scr, int lane) {
    f32x4 v[8]; float gv[8];
    const int r0 = lane >> 3, c4 = lane & 7;
#pragma unroll
    for (int i = 0; i < 8; ++i) { v[i] = *(const f32x4*)(W + (size_t)(k0 + r0 + 8 * i) * N + n0 + 4 * c4); gv[i] = gain ? gain[k0 + r0 + 8 * i] : 1.0f; }
#pragma unroll
    for (int i = 0; i < 8; ++i) { LAS float* d = scr + (r0 + 8 * i) * 33 + 4 * c4; d[0] = v[i][0] * gv[i]; d[1] = v[i][1] * gv[i]; d[2] = v[i][2] * gv[i]; d[3] = v[i][3] * gv[i]; }
    asm volatile("s_waitcnt lgkmcnt(0)" ::: "memory");
    const int c = lane & 7;
#pragma unroll
    for (int j = 0; j < 4; ++j) { const int n = (lane >> 3) + 8 * j; const LAS float* s = scr + (8 * c) * 33 + n;
        v4u o; o.x = pk_bf16(s[0 * 33], s[1 * 33]); o.y = pk_bf16(s[2 * 33], s[3 * 33]); o.z = pk_bf16(s[4 * 33], s[5 * 33]); o.w = pk_bf16(s[6 * 33], s[7 * 33]);
        *(v4u*)(WT + (size_t)(drow0 + n) * K + k0 + 8 * c) = o; }
    asm volatile("s_waitcnt lgkmcnt(0)" ::: "memory");
}
template <bool SWIGLU> __device__ __forceinline__ void transpose_item(const float* W, const float* gain, int K, int N, bf16* WT, LAS float* scr, int item, int lane) {
    const int nblk = N / 32, kb = item / nblk, nb = item % nblk, n0 = 32 * nb;
    int drow0 = n0;
    if (SWIGLU) { const int up = n0 >= FF, f = up ? n0 - FF : n0; drow0 = 256 * (f >> 7) + (up ? 128 : 0) + (f & 127); }
    transpose_tile(W, gain, K, N, 64 * kb, n0, WT, drow0, scr, lane);
}

__device__ __forceinline__ void cvt_phase(const float* x, bf16* xn, float* ssq, int gw, int ngw, int lane) {
    for (int m = gw; m < M; m += ngw) {
        const f32x4* xr = (const f32x4*)(x + (size_t)m * D) + lane;
        f32x4 v[4]; float s = 0.f;
#pragma unroll
        for (int j = 0; j < 4; ++j) { v[j] = xr[64 * j]; s += (v[j].x * v[j].x + v[j].y * v[j].y) + (v[j].z * v[j].z + v[j].w * v[j].w); }
        s = wave_sum(s);
        if (lane == 0) ssq[m] = s;
        v2u* o = (v2u*)(xn + (size_t)m * D) + lane;
#pragma unroll
        for (int j = 0; j < 4; ++j) { v2u w; w.x = pk_bf16(v[j].x, v[j].y); w.y = pk_bf16(v[j].z, v[j].w); o[64 * j] = w; }
    }
}

constexpr int KP = 72;
constexpr float SB_EXIT = 40.0f * 1.44269504089f;
typedef short v4i16_t __attribute__((ext_vector_type(4)));
__device__ __forceinline__ v2u vtr(const LAS bf16* p) { return __builtin_bit_cast(v2u, __builtin_amdgcn_ds_read_tr16_b64_v4i16((LAS v4i16_t*)p)); }
__device__ __forceinline__ void attn_phase(LAS unsigned char* lds, const bf16* Q, const bf16* K, const bf16* V, bf16* O, const float* qg, const float* kg, int gw, int ngw, int wave_s) {
    int tid_ = wave_s * 64 + lane_id_(); asm volatile("" : "+v"(tid_));
    const int lane = tid_ & 63, w = __builtin_amdgcn_readfirstlane(tid_ >> 6), hi = lane >> 5, ql = lane & 31;
    LAS bf16* Ks = (LAS bf16*)(lds + w * (64 * KP * 2));
    LAS bf16* Vs = Ks + 32 * KP;
    const int skey = lane >> 3, sch = lane & 7;
    const LAS bf16* vtb = Vs + (4 * hi + ((lane & 15) >> 2)) * KP + 16 * ((lane >> 4) & 1) + 4 * (lane & 3);
    for (int wu = gw; wu < BATCH * NH * 64; wu += ngw) {
        const int qblk = wu & 63, bh = wu >> 6, b = bh >> 4, h = bh & 15;
        const int tq = 32 * qblk + ql;
        bf16x8 qf[4];
        {
            const bf16* qp = Q + (size_t)(b * SEQ + tq) * D + h * HD + 8 * hi;
            float qv[4][8]; float ss = 0.f;
#pragma unroll
            for (int s = 0; s < 4; ++s) { const v4u r = *(const v4u*)(qp + 16 * s);
                qv[s][0] = bf_lo(r.x); qv[s][1] = bf_hi(r.x); qv[s][2] = bf_lo(r.y); qv[s][3] = bf_hi(r.y); qv[s][4] = bf_lo(r.z); qv[s][5] = bf_hi(r.z); qv[s][6] = bf_lo(r.w); qv[s][7] = bf_hi(r.w);
#pragma unroll
                for (int j = 0; j < 8; ++j) ss += qv[s][j] * qv[s][j]; }
            ss += __shfl_xor(ss, 32);
            const float rs = (0.125f * LOG2E) * __builtin_amdgcn_rsqf(ss * (1.f / HD) + EPS);
#pragma unroll
            for (int s = 0; s < 4; ++s) { float gp[8];
#pragma unroll
                for (int j = 0; j < 8; ++j) gp[j] = qg[16 * s + 8 * hi + j] * kg[16 * s + 8 * hi + j];
                v4u p;
                p.x = pk_bf16(qv[s][0] * rs * gp[0], qv[s][1] * rs * gp[1]); p.y = pk_bf16(qv[s][2] * rs * gp[2], qv[s][3] * rs * gp[3]);
                p.z = pk_bf16(qv[s][4] * rs * gp[4], qv[s][5] * rs * gp[5]); p.w = pk_bf16(qv[s][6] * rs * gp[6], qv[s][7] * rs * gp[7]);
                qf[s] = __builtin_bit_cast(bf16x8, p); }
        }
        f32x16 o0, o1;
#pragma unroll
        for (int i = 0; i < 16; ++i) { o0[i] = 0.f; o1[i] = 0.f; }
        float R = 0.f;
        v4u krA[4], vrA[4], krB[4], vrB[4];
        int kb = qblk;
        const bf16* kbase = K + (size_t)(b * SEQ + skey) * D + h * HD + 8 * sch;
        const bf16* vbase = V + (size_t)(b * SEQ + skey) * D + h * HD + 8 * sch;
#define ATT_LOAD(KR, VR, KBL) do { _Pragma("unroll") for (int i = 0; i < 4; ++i) { KR[i] = *(const v4u*)(kbase + (size_t)(32 * (KBL) + 8 * i) * D); VR[i] = *(const v4u*)(vbase + (size_t)(32 * (KBL) + 8 * i) * D); } } while (0)
#define ATT_BLOCK(KR, VR, KBC) do { \
            _Pragma("unroll") for (int i = 0; i < 4; ++i) { \
                float kf[8] = {bf_lo(KR[i].x), bf_hi(KR[i].x), bf_lo(KR[i].y), bf_hi(KR[i].y), bf_lo(KR[i].z), bf_hi(KR[i].z), bf_lo(KR[i].w), bf_hi(KR[i].w)}; \
                float ss = 0.f; \
                _Pragma("unroll") for (int j = 0; j < 8; ++j) ss += kf[j] * kf[j]; \
                ss += __uint_as_float(__builtin_amdgcn_mov_dpp(__float_as_uint(ss), 0xB1, 0xF, 0xF, true)); ss += __uint_as_float(__builtin_amdgcn_mov_dpp(__float_as_uint(ss), 0x4E, 0xF, 0xF, true)); ss += __uint_as_float(__builtin_amdgcn_mov_dpp(__float_as_uint(ss), 0x141, 0xF, 0xF, true)); \
                const float rs = __builtin_amdgcn_rsqf(ss * (1.f / HD) + EPS); \
                v4u p_; p_.x = pk_bf16(kf[0] * rs, kf[1] * rs); p_.y = pk_bf16(kf[2] * rs, kf[3] * rs); \
                p_.z = pk_bf16(kf[4] * rs, kf[5] * rs); p_.w = pk_bf16(kf[6] * rs, kf[7] * rs); \
                *(LAS v4u*)(Ks + (skey + 8 * i) * KP + 8 * sch) = p_; \
                *(LAS v4u*)(Vs + (skey + 8 * i) * KP + 8 * sch) = VR[i]; \
            } \
            if ((KBC) >= 2) ATT_LOAD(KR, VR, (KBC) - 2); \
            f32x16 p; \
            _Pragma("unroll") for (int i = 0; i < 16; ++i) p[i] = 0.f; \
            _Pragma("unroll") for (int s = 0; s < 4; ++s) { const bf16x8 kf = *(const LAS bf16x8*)(Ks + ql * KP + 16 * s + 8 * hi); \
                p = __builtin_amdgcn_mfma_f32_32x32x16_bf16(kf, qf[s], p, 0, 0, 0); } \
            const bool diag = ((KBC) == qblk); \
            { \
                float sp[16], lb[16]; \
                _Pragma("unroll") for (int i = 0; i < 16; ++i) { \
                    const float z = p[i]; \
                    const float e = __builtin_amdgcn_exp2f(-fabsf(z)); \
                    const float l = __builtin_amdgcn_logf(1.0f + e); \
                    const int kl = 8 * (i >> 2) + 4 * hi + (i & 3); \
                    const bool valid = !diag || (kl < ql); \
                    sp[i] = valid ? fmaxf(z, 0.f) + l : 0.f; \
                    lb[i] = valid ? fminf(z, 0.f) - l : -1e30f; \
                } \
                float run = R; \
                _Pragma("unroll") for (int g = 3; g >= 0; --g) { \
                    const float Gm = (sp[4 * g] + sp[4 * g + 1]) + (sp[4 * g + 2] + sp[4 * g + 3]); \
                    const float Go = __shfl_xor(Gm, 32); \
                    const float aft = hi ? run : run + Go; \
                    const float e3 = aft, e2 = e3 + sp[4 * g + 3], e1 = e2 + sp[4 * g + 2], e0 = e1 + sp[4 * g + 1]; \
                    p[4 * g + 3] = __builtin_amdgcn_exp2f(lb[4 * g + 3] - e3); \
                    p[4 * g + 2] = __builtin_amdgcn_exp2f(lb[4 * g + 2] - e2); \
                    p[4 * g + 1] = __builtin_amdgcn_exp2f(lb[4 * g + 1] - e1); \
                    p[4 * g + 0] = __builtin_amdgcn_exp2f(lb[4 * g + 0] - e0); \
                    run += Gm + Go; \
                } \
                R = run; \
            } \
            _Pragma("unroll") for (int s2 = 0; s2 < 2; ++s2) { \
                v4u pa; pa.x = pk_bf16(p[8 * s2 + 0], p[8 * s2 + 1]); pa.y = pk_bf16(p[8 * s2 + 2], p[8 * s2 + 3]); \
                pa.z = pk_bf16(p[8 * s2 + 4], p[8 * s2 + 5]); pa.w = pk_bf16(p[8 * s2 + 6], p[8 * s2 + 7]); \
                const bf16x8 pav = __builtin_bit_cast(bf16x8, pa); \
                const LAS bf16* vp = vtb + (16 * s2) * KP; \
                v4u vb; { const v2u a_ = vtr(vp), c_ = vtr(vp + 8 * KP); vb.x = a_.x; vb.y = a_.y; vb.z = c_.x; vb.w = c_.y; } \
                o0 = __builtin_amdgcn_mfma_f32_32x32x16_bf16(pav, __builtin_bit_cast(bf16x8, vb), o0, 0, 0, 0); \
                { const v2u a_ = vtr(vp + 32), c_ = vtr(vp + 8 * KP + 32); vb.x = a_.x; vb.y = a_.y; vb.z = c_.x; vb.w = c_.y; } \
                o1 = __builtin_amdgcn_mfma_f32_32x32x16_bf16(pav, __builtin_bit_cast(bf16x8, vb), o1, 0, 0, 0); \
            } \
            done = ((KBC) == 0) || (__builtin_amdgcn_ballot_w64(R < SB_EXIT) == 0ull); \
        } while (0)
        ATT_LOAD(krA, vrA, kb);
        if (kb >= 1) ATT_LOAD(krB, vrB, kb - 1);
        for (;;) {
            bool done;
            ATT_BLOCK(krA, vrA, kb);
            if (done) break;
            ATT_BLOCK(krB, vrB, kb - 1);
            if (done) break;
            kb -= 2;
        }
#undef ATT_LOAD
#undef ATT_BLOCK
        {
            LAS bf16* Ot = Ks;
#pragma unroll
            for (int i = 0; i < 16; ++i) { const int r = 8 * (i >> 2) + 4 * hi + (i & 3);
                Ot[r * KP + ql] = (bf16)(pk_bf16(o0[i], 0.f) & 0xffffu); Ot[r * KP + 32 + ql] = (bf16)(pk_bf16(o1[i], 0.f) & 0xffffu); }
            bf16* op = O + (size_t)(b * SEQ + 32 * qblk + skey) * D + h * HD + 8 * sch;
#pragma unroll
            for (int i = 0; i < 4; ++i) *(v4u*)(op + (size_t)(8 * i) * D) = *(const LAS v4u*)(Ot + (skey + 8 * i) * KP + 8 * sch);
        }
    }
}

constexpr int LT = 128, NCH = SEQ / LT;
#define LDS_BARRIER() do { asm volatile("s_waitcnt lgkmcnt(0)" ::: "memory"); __builtin_amdgcn_s_barrier(); asm volatile("" ::: "memory"); } while (0)
__device__ __forceinline__ void lru_phase(LAS unsigned char* lds, const bf16* XB, const bf16* Y, bf16* HY, const bf16* WRt, const bf16* WIt,
        const float* convw, const float* convb, const float* br, const float* bi, const float* lam, unsigned long long* gran, int G, int bid, int wave_s) {
    int tid = wave_s * 64 + lane_id_(); asm volatile("" : "+v"(tid));
    const int lane = tid & 63, w = __builtin_amdgcn_readfirstlane(tid >> 6), hi = lane >> 5, ql = lane & 31;
    LAS float* xcF = (LAS float*)lds;
    LAS bf16* wL = (LAS bf16*)(lds + 32768);
    LAS bf16* xcB = (LAS bf16*)(lds + 65536);
    LAS float* segA = (LAS float*)(lds + 65536 + 128 * KP * 2);
    LAS float* segH = segA + 512;
    LAS float* pA = segH + 512;
    LAS float* pH = pA + 1024;
    LAS bf16* yL = (LAS bf16*)(lds + 65536 + 128 * KP * 2 + 16384);
    const int st = tid >> 3, cc = 8 * (tid & 7);
    LAS float* parL = (LAS float*)(lds + 118784);
    int n_loaded = -1;
    const int rb = w >> 1, cbk = w & 1, d = 32 * cbk + ql;
    v4u xt[2][4], yv[2];
#define LRU_LOAD_X(u_) do { const int ch_ = (u_) >> 7, bn_ = (u_) & 127, b_ = bn_ >> 4, n_ = bn_ & 15, t0_ = ch_ * LT, c0_ = 64 * n_; \
        _Pragma("unroll") for (int r = 0; r < 2; ++r) { yv[r] = *(const v4u*)(Y + (size_t)(b_ * SEQ + t0_ + st + 64 * r) * D + c0_ + cc); \
            _Pragma("unroll") for (int j = 0; j < 4; ++j) { const int ts = t0_ + st + 64 * r + j - 3; xt[r][j] = ts >= 0 ? *(const v4u*)(XB + (size_t)(b_ * SEQ + ts) * D + c0_ + cc) : (v4u){0u, 0u, 0u, 0u}; } } } while (0)
    if (bid < BATCH * 16 * NCH) LRU_LOAD_X(bid);
    for (int unit = bid; unit < BATCH * 16 * NCH; unit += G) {
        const int ch = unit >> 7, bn = unit & 127, b = bn >> 4, n = bn & 15;
        const int t0 = ch * LT, c0 = 64 * n;
        if (n != n_loaded) {
            LDS_BARRIER();
            if (tid < 256) parL[tid] = convw[(tid >> 6) * D + c0 + (tid & 63)];
            else if (tid < 320) parL[tid] = convb[c0 + tid - 256];
            else if (tid < 384) parL[tid] = br[c0 + tid - 320];
            else if (tid < 448) parL[tid] = bi[c0 + tid - 384];
            else { const float lm = lam[c0 + tid - 448]; parL[tid] = -8.0f * (fmaxf(-lm, 0.f) + __builtin_amdgcn_logf(1.0f + __builtin_amdgcn_exp2f(-fabsf(lm) * LOG2E)) * LN2); }
#pragma unroll
            for (int r = 0; r < 2; ++r) { const int e = tid + 512 * r, gate = e >> 9, row = (e >> 3) & 63, chk = e & 7;
                *(LAS v4u*)(wL + (gate * 64 + row) * KP + 8 * chk) = *(const v4u*)((gate ? WIt : WRt) + (size_t)n * 4096 + row * 64 + 8 * chk); }
            n_loaded = n;
        }
        LDS_BARRIER();
        {
            float cw[4][8], cb[8];
#pragma unroll
            for (int j = 0; j < 4; ++j) { const f32x4 c0v = *(const LAS f32x4*)(parL + j * 64 + cc), c1v = *(const LAS f32x4*)(parL + j * 64 + cc + 4);
                cw[j][0] = c0v[0]; cw[j][1] = c0v[1]; cw[j][2] = c0v[2]; cw[j][3] = c0v[3]; cw[j][4] = c1v[0]; cw[j][5] = c1v[1]; cw[j][6] = c1v[2]; cw[j][7] = c1v[3]; }
            { const f32x4 c0v = *(const LAS f32x4*)(parL + 256 + cc), c1v = *(const LAS f32x4*)(parL + 256 + cc + 4);
                cb[0] = c0v[0]; cb[1] = c0v[1]; cb[2] = c0v[2]; cb[3] = c0v[3]; cb[4] = c1v[0]; cb[5] = c1v[1]; cb[6] = c1v[2]; cb[7] = c1v[3]; }
#pragma unroll
            for (int r = 0; r < 2; ++r) {
                const int t = st + 64 * r;
                float acc[8];
#pragma unroll
                for (int e = 0; e < 8; ++e) acc[e] = cb[e];
#pragma unroll
                for (int j = 0; j < 4; ++j) {
                    const v4u x = xt[r][j];
                    acc[0] += cw[j][0] * bf_lo(x.x); acc[1] += cw[j][1] * bf_hi(x.x); acc[2] += cw[j][2] * bf_lo(x.y); acc[3] += cw[j][3] * bf_hi(x.y);
                    acc[4] += cw[j][4] * bf_lo(x.z); acc[5] += cw[j][5] * bf_hi(x.z); acc[6] += cw[j][6] * bf_lo(x.w); acc[7] += cw[j][7] * bf_hi(x.w);
                }
                *(LAS f32x4*)(xcF + t * 64 + cc) = (f32x4){acc[0], acc[1], acc[2], acc[3]}; *(LAS f32x4*)(xcF + t * 64 + cc + 4) = (f32x4){acc[4], acc[5], acc[6], acc[7]};
                v4u p; p.x = pk_bf16(acc[0], acc[1]); p.y = pk_bf16(acc[2], acc[3]); p.z = pk_bf16(acc[4], acc[5]); p.w = pk_bf16(acc[6], acc[7]);
                *(LAS v4u*)(xcB + t * KP + cc) = p;
                *(LAS v4u*)(yL + t * KP + cc) = yv[r];
            }
        }
        if (unit + G < BATCH * 16 * NCH) LRU_LOAD_X(unit + G);
        LDS_BARRIER();
        unsigned xa[2] = {0u, 0u}, xh[2] = {0u, 0u}, xt_[2] = {0u, 0u};
#pragma unroll
        for (int q = 0; q < 2; ++q) { const int kk = w + 8 * q;
            if (kk < ch) { const unsigned long long* g = gran + ((size_t)(b * NCH + kk) * D + c0 + lane) * 2;
                const unsigned long long ya = __hip_atomic_load(g, __ATOMIC_RELAXED, __HIP_MEMORY_SCOPE_AGENT), yh = __hip_atomic_load(g + 1, __ATOMIC_RELAXED, __HIP_MEMORY_SCOPE_AGENT);
                xa[q] = (unsigned)ya; xh[q] = (unsigned)yh; xt_[q] = (unsigned)(ya >> 32) & (unsigned)(yh >> 32); } }
        float av[16], uv[16];
        const int c = lane, sg = 2 * rb + hi, tb = 32 * rb + 16 * hi;
        {
            f32x16 pr, pi;
#pragma unroll
            for (int i = 0; i < 16; ++i) { pr[i] = 0.f; pi[i] = 0.f; }
            const int trow = 32 * rb + 16 * ((ql >> 2) & 1) + 4 * (ql >> 3) + (ql & 3);
#pragma unroll
            for (int s = 0; s < 4; ++s) {
                const bf16x8 af = *(const LAS bf16x8*)(xcB + trow * KP + 16 * s + 8 * hi);
                const bf16x8 wr_ = *(const LAS bf16x8*)(wL + d * KP + 16 * s + 8 * hi), wi_ = *(const LAS bf16x8*)(wL + (64 + d) * KP + 16 * s + 8 * hi);
                pr = __builtin_amdgcn_mfma_f32_32x32x16_bf16(af, wr_, pr, 0, 0, 0);
                pi = __builtin_amdgcn_mfma_f32_32x32x16_bf16(af, wi_, pi, 0, 0, 0);
            }
            const float brv = parL[320 + d], biv = parL[384 + d], ls8 = parL[448 + d];
            float A = 1.f, H = 0.f;
#pragma unroll
            for (int i = 0; i < 16; ++i) {
                const float r = pg8::fast_sigmoid(pr[i] + brv), ig = pg8::fast_sigmoid(pi[i] + biv);
                const float la = ls8 * r;
                const float a = __builtin_amdgcn_exp2f(la * LOG2E);
                const float mult = __builtin_amdgcn_sqrtf(fmaxf(1.0f - a * a, 0.f));
                const float u = mult * ig * xcF[(tb + i) * 64 + d];
                av[i] = a; uv[i] = u; H = a * H + u; A *= a;
            }
            segA[sg * 64 + d] = A; segH[sg * 64 + d] = H;
        }
        LDS_BARRIER();
        if (w == 0 && ch < NCH - 1) {
            float At = 1.f, Ht = 0.f;
#pragma unroll
            for (int s = 0; s < 8; ++s) { const float a = segA[s * 64 + c], hh = segH[s * 64 + c]; Ht = a * Ht + hh; At *= a; }
            unsigned long long* g = gran + ((size_t)(b * NCH + ch) * D + c0 + c) * 2;
            __hip_atomic_store(g, (1ull << 32) | (unsigned long long)__float_as_uint(At), __ATOMIC_RELAXED, __HIP_MEMORY_SCOPE_AGENT);
            __hip_atomic_store(g + 1, (1ull << 32) | (unsigned long long)__float_as_uint(Ht), __ATOMIC_RELAXED, __HIP_MEMORY_SCOPE_AGENT);
        }
#pragma unroll
        for (int q = 0; q < 2; ++q) { const int kk = w + 8 * q;
            if (kk < ch) {
                const unsigned long long* g = gran + ((size_t)(b * NCH + kk) * D + c0 + c) * 2;
                for (unsigned spins = 0; spins < (1u << 22); ++spins) {
                    if (__all(xt_[q] == 1u)) break;
                    __builtin_amdgcn_s_sleep(1);
                    const unsigned long long ya = __hip_atomic_load(g, __ATOMIC_RELAXED, __HIP_MEMORY_SCOPE_AGENT), yh = __hip_atomic_load(g + 1, __ATOMIC_RELAXED, __HIP_MEMORY_SCOPE_AGENT);
                    xa[q] = (unsigned)ya; xh[q] = (unsigned)yh; xt_[q] = (unsigned)(ya >> 32) & (unsigned)(yh >> 32); }
                pA[kk * 64 + c] = __uint_as_float(xa[q]); pH[kk * 64 + c] = __uint_as_float(xh[q]);
            } }
        LDS_BARRIER();
        {
            float h = 0.f;
            for (int kk = 0; kk < ch; ++kk) h = pA[kk * 64 + d] * h + pH[kk * 64 + d];
            for (int s = 0; s < 7; ++s) { if (s < sg) h = segA[s * 64 + d] * h + segH[s * 64 + d]; }
#pragma unroll
            for (int i = 0; i < 16; ++i) { const int t = tb + i; h = av[i] * h + uv[i];
                const float yv_ = __uint_as_float((unsigned)yL[t * KP + d] << 16);
                xcB[t * KP + d] = (bf16)(pk_bf16(h * yv_, 0.f) & 0xffffu); }
        }
        LDS_BARRIER();
#pragma unroll
        for (int r = 0; r < 2; ++r) *(v4u*)(HY + (size_t)(b * SEQ + t0 + st + 64 * r) * D + c0 + cc) = *(const LAS v4u*)(xcB + (st + 64 * r) * KP + cc);
    }
}

#define RLX_AGENT __ATOMIC_RELAXED, __HIP_MEMORY_SCOPE_AGENT
#define XB_TMO      128
#define XB_XCNT(j)  (256  + 64 * (j))
#define XB_XSUB(j)  (1280 + 64 * (j))
#define XB_XGEN(j)  (2304 + 64 * (j))
#define XB_TOP      3328
#define XB_TOPGEN   3392
#define XCD_BAR_WORDS 3456
#define XB_SPIN_CAP (1u << 18)

__device__ __forceinline__ unsigned xb_ld(unsigned* p)              { return __hip_atomic_load(p, __ATOMIC_RELAXED, __HIP_MEMORY_SCOPE_AGENT); }
__device__ __forceinline__ unsigned xb_add(unsigned* p, unsigned v) { return __hip_atomic_fetch_add(p, v, __ATOMIC_RELAXED, __HIP_MEMORY_SCOPE_AGENT); }
__device__ __forceinline__ unsigned xb_xcc_id() { return (unsigned)__builtin_amdgcn_s_getreg((3 << 11) | 20) & 0xFu; }
#define XB_SPIN(cond, bar) do { unsigned _sp = 0; while (cond) { __builtin_amdgcn_s_sleep(1); \
    if ((++_sp & 255u) == 0u) { if (xb_ld(&(bar)[XB_TMO])) break; if (_sp > XB_SPIN_CAP) { atomicAdd(&(bar)[XB_TMO], 1u); break; } } } } while (0)

struct XcdBarrier {
    unsigned* bar; unsigned x;
    volatile LAS unsigned* st;
};

__device__ __forceinline__ XcdBarrier xcd_barrier_post(unsigned* bar, volatile LAS unsigned* st, bool is_t0) {
    XcdBarrier b; b.bar = bar; b.x = xb_xcc_id(); b.st = st;
    if (is_t0) (void)xb_add(&bar[XB_XCNT(b.x)], 1u);
    return b;
}
__device__ __forceinline__ void xcd_barrier_complete(unsigned* bar, unsigned x, unsigned& nloc, unsigned& nx) {
    const unsigned G = gridDim.x * gridDim.y * gridDim.z;
    unsigned sum, cnt, mine, sp = 0u;
    for (;;) {
        sum = 0u; cnt = 0u; mine = 0u;
#pragma unroll
        for (unsigned j = 0; j < 16; ++j) { const unsigned c = xb_ld(&bar[XB_XCNT(j)]); sum += c; cnt += (c > 0u) ? 1u : 0u; mine = (j == x) ? c : mine; }
        if (sum == G) break;
        __builtin_amdgcn_s_sleep(1);
        if ((++sp & 255u) == 0u) { if (xb_ld(&bar[XB_TMO])) break; if (sp > XB_SPIN_CAP) { atomicAdd(&bar[XB_TMO], 1u); break; } }
    }
    nloc = mine > 0u ? mine : 1u; nx = cnt > 0u ? cnt : 1u;
}

__device__ __forceinline__ void xcd_barrier(const XcdBarrier& b, int wave_s) {
    asm volatile("s_waitcnt vmcnt(0)" ::: "memory");
    __syncthreads();
    if (wave_s == 0 && lane_id_() == 0) {
        unsigned* bar = b.bar;
        __builtin_amdgcn_s_waitcnt(0);
        unsigned nloc = b.st[0], nx = b.st[1];
        if (nloc == 0u) { xcd_barrier_complete(bar, b.x, nloc, nx); b.st[0] = nloc; b.st[1] = nx; }
        const unsigned old = xb_add(&bar[XB_XSUB(b.x)], 1u);
        const unsigned gen = old / nloc;
        if (old + 1u == (gen + 1u) * nloc) {
            __builtin_amdgcn_fence(__ATOMIC_RELEASE, "agent");
            asm volatile("s_waitcnt vmcnt(0)" ::: "memory");
            const unsigned og = xb_add(&bar[XB_TOP], 1u);
            const unsigned tg = og / nx;
            if (og + 1u == (tg + 1u) * nx) xb_add(&bar[XB_TOPGEN], 1u);
            else XB_SPIN(xb_ld(&bar[XB_TOPGEN]) == tg, bar);
            __builtin_amdgcn_fence(__ATOMIC_ACQUIRE, "agent");
            xb_add(&bar[XB_XGEN(b.x)], 1u);
            asm volatile("s_waitcnt vmcnt(0)" ::: "memory");
        } else {
            XB_SPIN(xb_ld(&bar[XB_XGEN(b.x)]) == gen, bar);
            __builtin_amdgcn_fence(__ATOMIC_ACQUIRE, "agent");
            asm volatile("s_waitcnt vmcnt(0)" ::: "memory");
        }
    }
    __syncthreads();
}

struct Args { const float* in[28]; float* out; unsigned char* ws; };
__global__ void __launch_bounds__(512, 2) fwd_megakernel(Args a) {
    extern __shared__ __attribute__((aligned(16))) unsigned char lds_raw[];
    cg::grid_group grid = cg::this_grid();
    LAS unsigned char* lds = (LAS unsigned char*)lds_raw;
    const int tid = threadIdx.x, lane = tid & 63, wave = __builtin_amdgcn_readfirstlane(tid >> 6);
    const int G = gridDim.x, bid = blockIdx.x;
    const int gw = bid * 8 + wave, ngw = G * 8;
    unsigned char* ws = a.ws;
    bf16* XN = (bf16*)(ws + WS_XN); bf16* ACT = (bf16*)(ws + WS_ACT);
    bf16* QB = ACT; bf16* KB = ACT + (size_t)M * D; bf16* VB = ACT + (size_t)2 * M * D;
    volatile LAS unsigned* MISC = (volatile LAS unsigned*)(lds + 131072 + 4096);
    if (tid < 2) MISC[tid] = 0u;
    __syncthreads();
    const XcdBarrier xbar = xcd_barrier_post((unsigned*)(ws + WS_CTL), MISC, tid == 0);

    float* SSQ = (float*)(ws + WS_SSQ);
#define SSQ_AT(s) (SSQ + (size_t)(s) * M)
    constexpr int I_IN = (D / 64) * (2 * FF / 32), I_OUT = (FF / 64) * (D / 32), I_QKV = (D / 64) * (3 * D / 32), I_SQ = (D / 64) * (D / 32), I_LIN = (D / 64) * (2 * D / 32), I_G = 16 * 2;
    constexpr int SEG0 = I_IN, SEG1 = SEG0 + I_OUT + I_QKV + I_SQ + I_IN, SEG2 = SEG1 + I_OUT + I_IN + I_OUT, SEG3 = SEG2 + I_LIN + I_SQ + 2 * I_G + I_IN + I_OUT;
#define FFW(f) (ws + W_FF0 + (size_t)(f) * (SZ_WIN + SZ_WOUT))
#define CONVERT_ITEMS(lo_, hi_, wk_, nwk_) do { LAS float* scr = (LAS float*)(lds + wave * 16384); int tl_ = lane_id_(); asm volatile("" : "+v"(tl_)); const int lane = tl_; \
        for (int it = (lo_) + (wk_); it < (hi_); it += (nwk_)) { int r = it; \
            if (r < I_IN) { transpose_item<true>(a.in[2], a.in[1], D, 2 * FF, (bf16*)FFW(0), scr, r, lane); continue; } r -= I_IN; \
            if (r < I_OUT) { transpose_item<false>(a.in[3], nullptr, FF, D, (bf16*)(FFW(0) + SZ_WIN), scr, r, lane); continue; } r -= I_OUT; \
            if (r < I_QKV) { transpose_item<false>(a.in[5], a.in[4], D, 3 * D, (bf16*)(ws + W_QKV), scr, r, lane); continue; } r -= I_QKV; \
            if (r < I_SQ) { transpose_item<false>(a.in[8], nullptr, D, D, (bf16*)(ws + W_O), scr, r, lane); continue; } r -= I_SQ; \
            if (r < I_IN) { transpose_item<true>(a.in[10], a.in[9], D, 2 * FF, (bf16*)FFW(1), scr, r, lane); continue; } r -= I_IN; \
            if (r < I_OUT) { transpose_item<false>(a.in[11], nullptr, FF, D, (bf16*)(FFW(1) + SZ_WIN), scr, r, lane); continue; } r -= I_OUT; \
            if (r < I_IN) { transpose_item<true>(a.in[13], a.in[12], D, 2 * FF, (bf16*)FFW(2), scr, r, lane); continue; } r -= I_IN; \
            if (r < I_OUT) { transpose_item<false>(a.in[14], nullptr, FF, D, (bf16*)(FFW(2) + SZ_WIN), scr, r, lane); continue; } r -= I_OUT; \
            if (r < I_LIN) { transpose_item<false>(a.in[16], a.in[15], D, 2 * D, (bf16*)(ws + W_LIN), scr, r, lane); continue; } r -= I_LIN; \
            if (r < I_SQ) { transpose_item<false>(a.in[24], nullptr, D, D, (bf16*)(ws + W_LO), scr, r, lane); continue; } r -= I_SQ; \
            if (r < I_G) { transpose_item<false>(a.in[19] + (size_t)(r >> 1) * 4096, nullptr, 64, 64, (bf16*)(ws + W_GR) + (size_t)(r >> 1) * 4096, scr, r & 1, lane); continue; } r -= I_G; \
            if (r < I_G) { transpose_item<false>(a.in[21] + (size_t)(r >> 1) * 4096, nullptr, 64, 64, (bf16*)(ws + W_GI) + (size_t)(r >> 1) * 4096, scr, r & 1, lane); continue; } r -= I_G; \
            if (r < I_IN) { transpose_item<true>(a.in[26], a.in[25], D, 2 * FF, (bf16*)FFW(3), scr, r, lane); continue; } r -= I_IN; \
            transpose_item<false>(a.in[27], nullptr, FF, D, (bf16*)(FFW(3) + SZ_WIN), scr, r, lane); } } while (0)
    const int ffn_units = (M / 256) * (2 * FF / 256), ffn_rounds = (ffn_units + G - 1) / G, idle_from = ffn_units - (ffn_rounds - 1) * G;
#define CONVERT_IN_TAIL(lo_, hi_) do { if (idle_from < G) { if (bid >= idle_from) CONVERT_ITEMS(lo_, hi_, (bid - idle_from) * 8 + wave, (G - idle_from) * 8); } \
        else CONVERT_ITEMS(lo_, hi_, gw, ngw); } while (0)
    {
        CONVERT_ITEMS(0, SEG0, gw, ngw);
        cvt_phase(a.in[0], XN, SSQ_AT(0), gw, ngw, lane);
        for (int i = bid * 512 + tid; i < 2 * BATCH * NCH * D; i += G * 512) ((unsigned long long*)(ws + WS_SUM))[i] = 0ull;
    }
#define SEAM() xcd_barrier(xbar, wave)
    if (a.ws == nullptr) grid.sync();
    SEAM();
#define GEMM(EPI, Aptr, Wptr, NN, KK, E) do { pg8::Gemm g{(Aptr), (const bf16*)(Wptr), M, (NN), (KK)}; pg8::StaticOrder S; S.init(M, (NN), G, bid); \
        pg8::gemm_phase<EPI, pg8::StaticOrder, true, true>(lds, g, S, (E), wave); } while (0)
#define FFN(widx, s_in, FIRST, LAST, TLO, THI) do { \
        { pg8::EpiSwiglu E{ACT, FF, SSQ_AT(s_in)}; GEMM(pg8::EpiSwiglu, XN, ws + W_FF0 + (size_t)(widx) * (SZ_WIN + SZ_WOUT), 2 * FF, D, E); } \
        if ((TLO) < (THI)) CONVERT_IN_TAIL(TLO, THI); \
        SEAM(); \
        { typedef pg8::EpiResid<FIRST, LAST, true> EpiR; EpiR E{a.in[0], a.out, XN, SSQ_AT((s_in) + 1)}; GEMM(EpiR, ACT, ws + W_FF0 + (size_t)(widx) * (SZ_WIN + SZ_WOUT) + SZ_WIN, D, FF, E); } \
        } while (0)

    FFN(0, 0, true, false, SEG0, SEG1);
    SEAM();
    { pg8::EpiSplit<99> E{ACT, (size_t)M * D, SSQ_AT(1)}; GEMM(pg8::EpiSplit<99>, XN, ws + W_QKV, 3 * D, D, E); }
    SEAM();
    { const int vcu = (G % 8 == 0) ? (bid % 8) * (G / 8) + bid / 8 : bid;
      attn_phase(lds, QB, KB, VB, QB, a.in[6], a.in[7], vcu * 8 + wave, ngw, wave); }
    SEAM();
    { typedef pg8::EpiResid<false, false, false> EpiR; EpiR E{a.in[0], a.out, XN, SSQ_AT(2)}; GEMM(EpiR, QB, ws + W_O, D, D, E); }
    SEAM();
    FFN(1, 2, false, false, SEG1, SEG2);
    SEAM();
    FFN(2, 3, false, false, SEG2, SEG3);
    SEAM();
    { pg8::EpiSplit<1> E{ACT, (size_t)M * D, SSQ_AT(4)}; GEMM(pg8::EpiSplit<1>, XN, ws + W_LIN, 2 * D, D, E); }
    SEAM();
    lru_phase(lds, QB, KB, VB, (const bf16*)(ws + W_GR), (const bf16*)(ws + W_GI), a.in[17], a.in[18], a.in[20], a.in[22], a.in[23], (unsigned long long*)(ws + WS_SUM), G, bid, wave);
    SEAM();
    { typedef pg8::EpiResid<false, false, false> EpiR; EpiR E{a.in[0], a.out, XN, SSQ_AT(5)}; GEMM(EpiR, VB, ws + W_LO, D, D, E); }
    SEAM();
    FFN(3, 5, false, true, 0, 0);
}

extern "C" void kernel_launch(void* const* d_in, const int* in_sizes, int n_in, void* d_out, int out_size, void* d_ws, size_t ws_size, hipStream_t stream) {
    static int grid = 0;
    if (grid == 0) {
        if (n_in != 28 || out_size != M * D || ws_size < WS_END) { fprintf(stderr, "kernel_launch: unexpected problem (n_in %d out %d ws %zu)\n", n_in, out_size, ws_size); grid = -1; return; }
        int dev = 0, cus = 0, per_cu = 0;
        hipGetDevice(&dev); hipDeviceGetAttribute(&cus, hipDeviceAttributeMultiprocessorCount, dev);
        if (hipFuncSetAttribute((const void*)fwd_megakernel, hipFuncAttributeMaxDynamicSharedMemorySize, LDS_BYTES) != hipSuccess) { fprintf(stderr, "kernel_launch: hipFuncSetAttribute failed\n"); grid = -1; return; }
        if (hipOccupancyMaxActiveBlocksPerMultiprocessor(&per_cu, (const void*)fwd_megakernel, 512, LDS_BYTES) != hipSuccess || per_cu < 1) { fprintf(stderr, "kernel_launch: occupancy query says %d\n", per_cu); per_cu = 1; }
        (void)hipGetLastError();
        grid = cus * per_cu;
    }
    if (grid < 0) return;
    if (hipMemsetAsync((char*)d_ws + WS_CTL, 0, CTL_ZERO_BYTES, stream) != hipSuccess) { fprintf(stderr, "memset failed\n"); return; }
    Args a{};
    for (int i = 0; i < 28; ++i) a.in[i] = (const float*)d_in[i];
    a.out = (float*)d_out; a.ws = (unsigned char*)d_ws;
    void* args[] = {&a};
    hipError_t e = hipLaunchCooperativeKernel((const void*)fwd_megakernel, dim3(grid), dim3(512), args, LDS_BYTES, stream);
    if (e != hipSuccess) fprintf(stderr, "cooperative launch failed: %s (grid %d)\n", hipGetErrorString(e), grid);
}
```

```cpp
#include <hip/hip_runtime.h>
#include <hip/hip_cooperative_groups.h>
#include <cstdio>
#include <cstdint>
namespace cg = cooperative_groups;
__device__ __forceinline__ int lane_id_() { int l; asm volatile("v_mbcnt_lo_u32_b32 %0, -1, 0\n\tv_mbcnt_hi_u32_b32 %0, -1, %0" : "=v"(l)); return l; }
namespace pg8 {
#define PG8_LAS __attribute__((address_space(3)))
typedef unsigned short bf16_t;
typedef short bf16x8 __attribute__((ext_vector_type(8)));
typedef float f32x4 __attribute__((ext_vector_type(4)));
typedef unsigned u32x4 __attribute__((ext_vector_type(4)));
constexpr int BM = 256, BK = 64, HALF = 128, HTB = HALF * BK * 2  , STAGE_BYTES = 8 * HTB, NXCD = 8, WGM = 8;

__host__ __device__ __forceinline__ int lds_byte(int r, int c) { const int st = (r >> 4) * 2 + (c >> 5), rr = r & 15, cc = c & 31, ob = rr * 64 + cc * 2; return st * 1024 + (ob ^ (((ob >> 9) & 1) << 5)); }
__host__ __device__ __forceinline__ void stage_rc(int b, int& R, int& C) { const int st = b / 1024, sb = b % 1024, swz = sb ^ (((sb >> 9) & 1) << 5); R = (st >> 1) * 16 + swz / 64; C = (st & 1) * 32 + (swz % 64) / 2; }
__host__ __device__ __forceinline__ int perm32(int rho) { const int n = rho >> 4, i = rho & 15; return 8 * (i >> 2) + 4 * n + (i & 3); }

struct Unit { int pm, pn; };
struct Gemm { const bf16_t* A; const bf16_t* Bt; int M, N, K; };

struct StaticOrder {
    int nM, nN, nwg, G, c;
    __host__ __device__ void init(int M, int N, int G_, int c_) { nM = M / BM; nN = N / BM; nwg = nM * nN; G = G_; c = c_; }
    __host__ __device__ bool next(int i, Unit& u) const {
        const long L = (long)i * G + c; if (L >= nwg) return false;
        int wgid = (int)L; { const int q = nwg / NXCD, r = nwg % NXCD, xcd = wgid % NXCD, off = wgid / NXCD; wgid = (xcd < r ? xcd * (q + 1) : r * (q + 1) + (xcd - r) * q) + off; }
        const int nig = WGM * nN, gid = wgid / nig, fm = gid * WGM, gsz = (nM - fm) < WGM ? (nM - fm) : WGM;
        u.pm = fm + ((wgid % nig) % gsz); u.pn = (wgid % nig) / gsz; return true;
    }
    __device__ __forceinline__ void a_ready(const Unit&) const {}
    __device__ __forceinline__ void done(const Unit&) const {}
};

__device__ __forceinline__ unsigned cvt_pk_bf16(float lo, float hi) { unsigned r; asm volatile("v_cvt_pk_bf16_f32 %0, %1, %2" : "=v"(r) : "v"(lo), "v"(hi)); return r; }
typedef float f32x2 __attribute__((ext_vector_type(2)));
__device__ __forceinline__ unsigned pk_bf16(float lo, float hi) { typedef __bf16 b2_t __attribute__((ext_vector_type(2))); f32x2 v = {lo, hi}; b2_t b = __builtin_convertvector(v, b2_t); return __builtin_bit_cast(unsigned, b); }
__device__ __forceinline__ float fast_sigmoid(float v) { return __builtin_amdgcn_rcpf(1.0f + __builtin_amdgcn_exp2f(-1.44269504089f * v)); }
struct EpiSwiglu {
    static constexpr bool PERM = true, AFTER_DRAIN = false; static constexpr int NSTORES = 8;
    bf16_t* H; int ldh; const float* ssq;
    __device__ __forceinline__ void operator()(const f32x4 (&acc)[2][2][4][2], const Unit& u, int wr, int wc, int fr, int fq) const {
        const int row0 = u.pm * BM + wr * 64 + fr, col0 = u.pn * HALF + wc * 32 + 8 * fq;
#pragma unroll
        for (int ai = 0; ai < 2; ++ai)
#pragma unroll
            for (int m = 0; m < 4; ++m) {
                bf16_t* p = H + (size_t)(row0 + ai * HALF + m * 16) * ldh + col0;
                const float rstd = __builtin_amdgcn_rsqf(ssq[row0 + ai * HALF + m * 16] * (1.0f / 1024.0f) + 1e-6f);
                float h[8];
#pragma unroll
                for (int n = 0; n < 2; ++n)
#pragma unroll
                    for (int j = 0; j < 4; ++j) { const float g = acc[ai][0][m][n][j] * rstd, up = acc[ai][1][m][n][j] * rstd; h[4 * n + j] = g * fast_sigmoid(g) * up; }
                u32x4 w; w.x = pk_bf16(h[0], h[1]); w.y = pk_bf16(h[2], h[3]); w.z = pk_bf16(h[4], h[5]); w.w = pk_bf16(h[6], h[7]);
                *(u32x4*)p = w;
            }
    }
};
template <bool FIRST, bool LAST, bool HALF_ALPHA> struct EpiResid {
    static constexpr bool PERM = true, AFTER_DRAIN = false; static constexpr int NSTORES = 0;
    const float* base32; float* out32; bf16_t* xn; float* ssq;
    __device__ __forceinline__ void operator()(const f32x4 (&acc)[2][2][4][2], const Unit& u, int wr, int wc, int fr, int fq) const {
        const int row0 = u.pm * BM + wr * 64 + fr, col0 = u.pn * BM + wc * 32 + 8 * fq;
        constexpr float alpha = HALF_ALPHA ? 0.5f : 1.0f;
#pragma unroll
        for (int ai = 0; ai < 2; ++ai)
#pragma unroll
            for (int m = 0; m < 4; ++m) {
                float s = 0.f;
#pragma unroll
                for (int bj = 0; bj < 2; ++bj) {
                    const size_t off = (size_t)(row0 + ai * HALF + m * 16) * 1024 + col0 + bj * HALF;
                    f32x4 b0, b1;
                    if (FIRST) { b0 = *(const f32x4*)(base32 + off); b1 = *(const f32x4*)(base32 + off + 4); }
                    else { const u32x4 r = *(const u32x4*)(xn + off);
                        b0 = (f32x4){__uint_as_float(r.x << 16), __uint_as_float(r.x & 0xffff0000u), __uint_as_float(r.y << 16), __uint_as_float(r.y & 0xffff0000u)};
                        b1 = (f32x4){__uint_as_float(r.z << 16), __uint_as_float(r.z & 0xffff0000u), __uint_as_float(r.w << 16), __uint_as_float(r.w & 0xffff0000u)}; }
                    const f32x4 v0 = b0 + alpha * acc[ai][bj][m][0], v1 = b1 + alpha * acc[ai][bj][m][1];
                    if (LAST) { *(f32x4*)(out32 + off) = v0; *(f32x4*)(out32 + off + 4) = v1; }
                    else {
                        u32x4 w; w.x = pk_bf16(v0[0], v0[1]); w.y = pk_bf16(v0[2], v0[3]); w.z = pk_bf16(v1[0], v1[1]); w.w = pk_bf16(v1[2], v1[3]);
                        *(u32x4*)(xn + off) = w;
                        const float r0 = __uint_as_float(w.x << 16), r1 = __uint_as_float(w.x & 0xffff0000u), r2 = __uint_as_float(w.y << 16), r3 = __uint_as_float(w.y & 0xffff0000u);
                        const float r4 = __uint_as_float(w.z << 16), r5 = __uint_as_float(w.z & 0xffff0000u), r6 = __uint_as_float(w.w << 16), r7 = __uint_as_float(w.w & 0xffff0000u);
                        s += (r0 * r0 + r1 * r1) + (r2 * r2 + r3 * r3) + (r4 * r4 + r5 * r5) + (r6 * r6 + r7 * r7);
                    }
                }
                if (!LAST) { s += __shfl_xor(s, 16); s += __shfl_xor(s, 32); if (fq == 0) __hip_atomic_fetch_add(ssq + row0 + ai * HALF + m * 16, s, __ATOMIC_RELAXED, __HIP_MEMORY_SCOPE_AGENT); }
            }
    }
};
template <int GELU_FROM> struct EpiSplit {
    static constexpr bool PERM = true, AFTER_DRAIN = false; static constexpr int NSTORES = 16;
    bf16_t* O; size_t split_stride; const float* ssq;
    __device__ __forceinline__ void operator()(const f32x4 (&acc)[2][2][4][2], const Unit& u, int wr, int wc, int fr, int fq) const {
        const int t = u.pn >> 2; bf16_t* basep = O + (size_t)t * split_stride;
        const int row0 = u.pm * BM + wr * 64 + fr, col0 = (u.pn & 3) * BM + wc * 32 + 8 * fq;
        const bool act = t >= GELU_FROM;
#pragma unroll
        for (int ai = 0; ai < 2; ++ai)
#pragma unroll
            for (int m = 0; m < 4; ++m) {
                const float rstd = __builtin_amdgcn_rsqf(ssq[row0 + ai * HALF + m * 16] * (1.0f / 1024.0f) + 1e-6f);
#pragma unroll
                for (int bj = 0; bj < 2; ++bj) {
                    float h[8];
#pragma unroll
                    for (int n = 0; n < 2; ++n)
#pragma unroll
                        for (int j = 0; j < 4; ++j) { float v = acc[ai][bj][m][n][j] * rstd;
                            if (act) { const float z = 1.5957691216f * (v + 0.044715f * v * v * v); v = v * fast_sigmoid(z); }
                            h[4 * n + j] = v; }
                    u32x4 w; w.x = pk_bf16(h[0], h[1]); w.y = pk_bf16(h[2], h[3]); w.z = pk_bf16(h[4], h[5]); w.w = pk_bf16(h[6], h[7]);
                    *(u32x4*)(basep + (size_t)(row0 + ai * HALF + m * 16) * 1024 + col0 + bj * HALF) = w;
                }
            }
    }
};
template <class Epi, class Sched, bool ALIGN_EPI = false, bool SP2 = false>
__device__ __forceinline__ void gemm_phase(PG8_LAS unsigned char* lds, const Gemm g, const Sched& S, const Epi& E, int wave_s) {
    int tid = wave_s * 64 + lane_id_(); asm volatile("" : "+v"(tid));
    const int wid = __builtin_amdgcn_readfirstlane(tid >> 6), lane = tid & 63, wr = wid >> 2, wc = wid & 3, fr = lane & 15, fq = lane >> 4;
    const int K = g.K, nt = K / BK;
    unsigned voffA[2], voffB[2];
#pragma unroll
    for (int i = 0; i < 2; ++i) { int R, C; stage_rc(tid * 16 + i * 8192, R, C); const int Rb = Epi::PERM ? ((R & ~31) + perm32(R & 31)) : R;
        voffA[i] = (unsigned)(R * K + C) * 2u; voffB[i] = (unsigned)(Rb * K + C) * 2u; }
    const size_t kstep = (size_t)(BK * 2);
    const size_t hstep = (size_t)HALF * K * 2;
    const size_t tstep = 2 * hstep;
    const unsigned ldsw = (unsigned)wid * 1024u;
    const int aoff = lds_byte(wr * 64 + fr, fq * 8), boff = lds_byte(wc * 32 + fr, fq * 8);
#define PG8_SA(b, h) (((b) * 2 + (h)) * HTB)
#define PG8_SB(b, h) ((4 + (b) * 2 + (h)) * HTB)
#define PG8_STAGE(bufoff, gbase, voff) do { _Pragma("unroll") for (int _i = 0; _i < 2; ++_i) \
        __builtin_amdgcn_global_load_lds((const unsigned*)((const char*)(gbase) + (voff)[_i]), (PG8_LAS unsigned*)(lds + (bufoff) + ldsw + _i * 8192), 16, 0, 0); } while (0)
#define PG8_LDA(dst, b, h) do { _Pragma("unroll") for (int m = 0; m < 4; ++m) _Pragma("unroll") for (int k = 0; k < 2; ++k) dst[m][k] = *(const PG8_LAS bf16x8*)(lds + PG8_SA(b, h) + aoff + m * 2048 + k * 1024); } while (0)
#define PG8_LDB(dst, b, h) do { _Pragma("unroll") for (int n = 0; n < 2; ++n) _Pragma("unroll") for (int k = 0; k < 2; ++k) dst[n][k] = *(const PG8_LAS bf16x8*)(lds + PG8_SB(b, h) + boff + n * 2048 + k * 1024); } while (0)
#define PG8_MMA(ai, bj, At, Bt) do { __builtin_amdgcn_s_setprio(1); _Pragma("unroll") for (int m = 0; m < 4; ++m) _Pragma("unroll") for (int n = 0; n < 2; ++n) _Pragma("unroll") for (int k = 0; k < 2; ++k) \
        acc[ai][bj][m][n] = __builtin_amdgcn_mfma_f32_16x16x32_bf16(Bt[n][k], At[m][k], acc[ai][bj][m][n], 0, 0, 0); __builtin_amdgcn_s_setprio(0); } while (0)
#define PG8_WAIT_V(n) asm volatile("s_waitcnt vmcnt(" #n ")" ::: "memory")
#define PG8_WAIT_L(n) asm volatile("s_waitcnt lgkmcnt(" #n ")" ::: "memory")
#define PG8_WAIT_V8_STRICT() asm volatile("s_waitcnt vmcnt(8)" ::: "memory")
#define PG8_WAIT_V8_RELAX() do { if constexpr (Epi::NSTORES == 8) asm volatile("s_waitcnt vmcnt(16)" ::: "memory"); else if constexpr (Epi::NSTORES == 16) asm volatile("s_waitcnt vmcnt(24)" ::: "memory"); else asm volatile("s_waitcnt vmcnt(8)" ::: "memory"); } while (0)
#define PG8_BAR __builtin_amdgcn_s_barrier()
#define PG8_SCHED __builtin_amdgcn_sched_barrier(0)
#define PG8_SP2_PAIR(WAITM) do { \
            PG8_LDB(B0, 0, 0); PG8_LDB(B1, 0, 1); PG8_SCHED; PG8_LDA(At, 0, 0); PG8_STAGE(PG8_SA(1, 1), a1 + hstep, voffA); \
            WAITM(); PG8_WAIT_L(0); PG8_BAR; PG8_MMA(0, 0, At, B0); PG8_MMA(0, 1, At, B1); PG8_BAR; PG8_SCHED; \
            PG8_LDA(At, 0, 1); PG8_STAGE(PG8_SB(0, 0), b2, voffB); PG8_STAGE(PG8_SB(0, 1), b2 + hstep, voffB); PG8_STAGE(PG8_SA(0, 0), a2, voffA); \
            WAITM(); PG8_WAIT_L(0); PG8_BAR; PG8_MMA(1, 0, At, B0); PG8_MMA(1, 1, At, B1); PG8_BAR; PG8_SCHED; \
            PG8_LDB(B0, 1, 0); PG8_LDB(B1, 1, 1); PG8_SCHED; PG8_LDA(At, 1, 0); PG8_STAGE(PG8_SA(0, 1), a2 + hstep, voffA); \
            WAITM(); PG8_WAIT_L(0); PG8_BAR; PG8_MMA(0, 0, At, B0); PG8_MMA(0, 1, At, B1); PG8_BAR; PG8_SCHED; \
            PG8_LDA(At, 1, 1); PG8_STAGE(PG8_SB(1, 0), b3, voffB); PG8_STAGE(PG8_SB(1, 1), b3 + hstep, voffB); PG8_STAGE(PG8_SA(1, 0), a3, voffA); \
            WAITM(); PG8_WAIT_L(0); PG8_BAR; PG8_MMA(1, 0, At, B0); PG8_MMA(1, 1, At, B1); PG8_BAR; PG8_SCHED; \
            } while (0)
    Unit cur, nxt; int ui = 0; bool peeled = false;
    if (!S.next(0, cur)) return;
    f32x4 acc[2][2][4][2];
#pragma unroll
    for (int a = 0; a < 2; ++a)
#pragma unroll
        for (int b = 0; b < 2; ++b)
#pragma unroll
            for (int m = 0; m < 4; ++m)
#pragma unroll
                for (int n = 0; n < 2; ++n) acc[a][b][m][n] = (f32x4){0.f, 0.f, 0.f, 0.f};
    bf16x8 At[4][2], B0[2][2], B1[2][2];
    const char* cA = (const char*)g.A + (size_t)cur.pm * tstep; const char* cB = (const char*)g.Bt + (size_t)cur.pn * tstep;
    S.a_ready(cur);
    if constexpr (SP2) {
        PG8_STAGE(PG8_SB(0, 0), cB, voffB); PG8_STAGE(PG8_SB(0, 1), cB + hstep, voffB); PG8_STAGE(PG8_SA(0, 0), cA, voffA); PG8_STAGE(PG8_SA(0, 1), cA + hstep, voffA);
        if (wr == 1) PG8_BAR;
        PG8_WAIT_V(2); PG8_BAR;
        PG8_STAGE(PG8_SB(1, 0), cB + kstep, voffB); PG8_STAGE(PG8_SA(1, 0), cA + kstep, voffA); PG8_STAGE(PG8_SB(1, 1), cB + hstep + kstep, voffB);
        PG8_WAIT_V(6); PG8_BAR;
    } else {
        PG8_STAGE(PG8_SB(0, 0), cB, voffB); PG8_STAGE(PG8_SA(0, 0), cA, voffA); PG8_STAGE(PG8_SB(0, 1), cB + hstep, voffB); PG8_STAGE(PG8_SA(0, 1), cA + hstep, voffA);
        if (wr == 1) PG8_BAR;
        PG8_WAIT_V(4); PG8_BAR;
        PG8_STAGE(PG8_SB(1, 0), cB + kstep, voffB); PG8_STAGE(PG8_SA(1, 0), cA + kstep, voffA); PG8_STAGE(PG8_SB(1, 1), cB + hstep + kstep, voffB);
        PG8_WAIT_V(6); PG8_BAR;
    }
    for (;;) {
        const bool has_next = S.next(ui + 1, nxt);
        const char* nA = has_next ? (const char*)g.A + (size_t)nxt.pm * tstep : cA; const char* nB = has_next ? (const char*)g.Bt + (size_t)nxt.pn * tstep : cB;
        for (int t = peeled ? 2 : 0; t < nt; t += 2) {
            const bool last = (t == nt - 2);
            const char* a1 = cA + (size_t)(t + 1) * kstep;
            const char* a2 = last ? nA : cA + (size_t)(t + 2) * kstep; const char* b2 = last ? nB : cB + (size_t)(t + 2) * kstep;
            const char* a3 = a2 + kstep; const char* b3 = b2 + kstep;
            if (last && has_next) S.a_ready(nxt);
            if constexpr (SP2) {
            PG8_SP2_PAIR(PG8_WAIT_V8_STRICT);
            } else {
            PG8_LDB(B0, 0, 0); PG8_SCHED; PG8_LDA(At, 0, 0); PG8_STAGE(PG8_SA(1, 1), a1 + hstep, voffA);
            PG8_WAIT_L(8); PG8_BAR; PG8_WAIT_L(0); PG8_MMA(0, 0, At, B0); PG8_BAR; PG8_SCHED;
            PG8_LDB(B1, 0, 1); PG8_STAGE(PG8_SB(0, 0), b2, voffB);
            PG8_BAR; PG8_WAIT_L(0); PG8_MMA(0, 1, At, B1); PG8_BAR;
            PG8_LDA(At, 0, 1); PG8_STAGE(PG8_SA(0, 0), a2, voffA);
            PG8_BAR; PG8_WAIT_L(0); PG8_MMA(1, 0, At, B0); PG8_BAR; PG8_SCHED;
            PG8_STAGE(PG8_SB(0, 1), b2 + hstep, voffB);
            PG8_WAIT_V(6); PG8_BAR; PG8_MMA(1, 1, At, B1); PG8_BAR;
            PG8_LDB(B0, 1, 0); PG8_SCHED; PG8_LDA(At, 1, 0); PG8_STAGE(PG8_SA(0, 1), a2 + hstep, voffA);
            PG8_WAIT_L(8); PG8_BAR; PG8_WAIT_L(0); PG8_MMA(0, 0, At, B0); PG8_BAR; PG8_SCHED;
            PG8_LDB(B1, 1, 1); PG8_STAGE(PG8_SB(1, 0), b3, voffB);
            PG8_BAR; PG8_WAIT_L(0); PG8_MMA(0, 1, At, B1); PG8_BAR;
            PG8_LDA(At, 1, 1); PG8_STAGE(PG8_SA(1, 0), a3, voffA);
            PG8_BAR; PG8_WAIT_L(0); PG8_MMA(1, 0, At, B0); PG8_BAR; PG8_SCHED;
            PG8_STAGE(PG8_SB(1, 1), b3 + hstep, voffB);
            PG8_WAIT_V(6); PG8_BAR; PG8_MMA(1, 1, At, B1); PG8_BAR;
            }
        }
        if constexpr (ALIGN_EPI) { if (wr == 0) PG8_BAR; }
        if constexpr (!Epi::AFTER_DRAIN) { E(acc, cur, wr, wc, fr, fq); S.done(cur); }
        if (!has_next) break;
#pragma unroll
        for (int a = 0; a < 2; ++a)
#pragma unroll
            for (int b = 0; b < 2; ++b)
#pragma unroll
                for (int m = 0; m < 4; ++m)
#pragma unroll
                    for (int n = 0; n < 2; ++n) acc[a][b][m][n] = (f32x4){0.f, 0.f, 0.f, 0.f};
        cur = nxt; cA = nA; cB = nB; ++ui;
        if constexpr (ALIGN_EPI) { if (wr == 1) PG8_BAR; }
        if constexpr (SP2 && Epi::NSTORES > 0 && !Epi::AFTER_DRAIN) {
            const char* a1 = cA + kstep; const char* a2 = cA + 2 * kstep; const char* b2 = cB + 2 * kstep; const char* a3 = a2 + kstep; const char* b3 = b2 + kstep;
            PG8_SP2_PAIR(PG8_WAIT_V8_RELAX);
            peeled = true;
        }
    }
    PG8_WAIT_V(0);
    if constexpr (!ALIGN_EPI) { if (wr == 0) PG8_BAR; }
    PG8_BAR;
    if constexpr (Epi::AFTER_DRAIN) { E.fused(acc, cur, wr, wc, fr, fq, lds, wid, lane); S.done(cur); }
#undef PG8_SA
#undef PG8_SB
#undef PG8_STAGE
#undef PG8_LDA
#undef PG8_LDB
#undef PG8_MMA
#undef PG8_WAIT_V
#undef PG8_WAIT_L
#undef PG8_SP2_PAIR
#undef PG8_BAR
#undef PG8_SCHED
}
}
constexpr int BATCH = 8, SEQ = 2048, D = 1024, M = BATCH * SEQ, FF = 2816, NH = 16, HD = 64;
constexpr float EPS = 1e-6f;
constexpr size_t MiB = 1u << 20;
constexpr size_t WS_CTL = 0, WS_SSQ = 65536, CTL_ZERO_BYTES = 65536 + 6 * 65536;
constexpr size_t WS_SUM = 1 * MiB;
constexpr size_t WS_W = 3 * MiB;
constexpr size_t SZ_WIN = (size_t)2 * FF * D * 2, SZ_WOUT = (size_t)D * FF * 2;
constexpr size_t W_FF0 = WS_W, W_FF1 = W_FF0 + SZ_WIN + SZ_WOUT, W_FF2 = W_FF1 + SZ_WIN + SZ_WOUT, W_FF3 = W_FF2 + SZ_WIN + SZ_WOUT;
constexpr size_t W_QKV = W_FF3 + SZ_WIN + SZ_WOUT, W_O = W_QKV + (size_t)3 * D * D * 2, W_LIN = W_O + (size_t)D * D * 2, W_LO = W_LIN + (size_t)2 * D * D * 2;
constexpr size_t W_GR = W_LO + (size_t)D * D * 2, W_GI = W_GR + 16 * 64 * 64 * 2, W_END = W_GI + 16 * 64 * 64 * 2;
constexpr size_t WS_XN = 84 * MiB;
constexpr size_t WS_ACT = 116 * MiB;
constexpr size_t WS_END = WS_ACT + 96 * MiB;
static_assert(W_END <= WS_XN && WS_XN + (size_t)M * D * 2 <= WS_ACT && WS_END <= 256 * MiB && (size_t)M * FF * 2 <= 96 * MiB, "d_ws map");
constexpr int LDS_BYTES = 147456;

#define LAS __attribute__((address_space(3)))
typedef unsigned short bf16;
typedef unsigned v4u __attribute__((ext_vector_type(4)));
typedef unsigned v2u __attribute__((ext_vector_type(2)));
typedef float f32x4 __attribute__((ext_vector_type(4)));
typedef float f32x16 __attribute__((ext_vector_type(16)));
typedef short bf16x8 __attribute__((ext_vector_type(8)));
using pg8::pk_bf16;
__device__ __forceinline__ float bf_lo(unsigned u) { return __uint_as_float(u << 16); }
__device__ __forceinline__ float bf_hi(unsigned u) { return __uint_as_float(u & 0xffff0000u); }
__device__ __forceinline__ float wave_sum(float v) {
#pragma unroll
    for (int o = 1; o < 64; o <<= 1) v += __shfl_xor(v, o);
    return v;
}
#define LOG2E 1.44269504089f
#define LN2 0.69314718056f

__device__ __forceinline__ void transpose_tile(const float* W, const float* gain, int K, int N, int k0, int n0, bf16* WT, int drow0, LAS float* scr, int lane) {
    f32x4 v[8]; float gv[8];
    const int r0 = lane >> 3, c4 = lane & 7;
#pragma unroll
    for (int i = 0; i < 8; ++i) { v[i] = *(const f32x4*)(W + (size_t)(k0 + r0 + 8 * i) * N + n0 + 4 * c4); gv[i] = gain ? gain[k0 + r0 + 8 * i] : 1.0f; }
#pragma unroll
    for (int i = 0; i < 8; ++i) { LAS float* d = scr + (r0 + 8 * i) * 33 + 4 * c4; d[0] = v[i][0] * gv[i]; d[1] = v[i][1] * gv[i]; d[2] = v[i][2] * gv[i]; d[3] = v[i][3] * gv[i]; }
    asm volatile("s_waitcnt lgkmcnt(0)" ::: "memory");
    const int c = lane & 7;
#pragma unroll
    for (int j = 0; j < 4; ++j) { const int n = (lane >> 3) + 8 * j; const LAS float* s = scr + (8 * c) * 33 + n;
        v4u o; o.x = pk_bf16(s[0 * 33], s[1 * 33]); o.y = pk_bf16(s[2 * 33], s[3 * 33]); o.z = pk_bf16(s[4 * 33], s[5 * 33]); o.w = pk_bf16(s[6 * 33], s[7 * 33]);
        *(v4u*)(WT + (size_t)(drow0 + n) * K + k0 + 8 * c) = o; }
    asm volatile("s_waitcnt lgkmcnt(0)" ::: "memory");
}
template <bool SWIGLU> __device__ __forceinline__ void transpose_item(const float* W, const float* gain, int K, int N, bf16* WT, LAS float* scr, int item, int lane) {
    const int nblk = N / 32, kb = item / nblk, nb = item % nblk, n0 = 32 * nb;
    int drow0 = n0;
    if (SWIGLU) { const int up = n0 >= FF, f = up ? n0 - FF : n0; drow0 = 256 * (f >> 7) + (up ? 128 : 0) + (f & 127); }
    transpose_tile(W, gain, K, N, 64 * kb, n0, WT, drow0, scr, lane);
}

__device__ __forceinline__ void cvt_phase(const float* x, bf16* xn, float* ssq, int gw, int ngw, int lane) {
    for (int m = gw; m < M; m += ngw) {
        const f32x4* xr = (const f32x4*)(x + (size_t)m * D) + lane;
        f32x4 v[4]; float s = 0.f;
#pragma unroll
        for (int j = 0; j < 4; ++j) { v[j] = xr[64 * j]; s += (v[j].x * v[j].x + v[j].y * v[j].y) + (v[j].z * v[j].z + v[j].w * v[j].w); }
        s = wave_sum(s);
        if (lane == 0) ssq[m] = s;
        v2u* o = (v2u*)(xn + (size_t)m * D) + lane;
#pragma unroll
        for (int j = 0; j < 4; ++j) { v2u w; w.x = pk_bf16(v[j].x, v[j].y); w.y = pk_bf16(v[j].z, v[j].w); o[64 * j] = w; }
    }
}

constexpr int KP = 72;
constexpr float SB_EXIT = 40.0f * 1.44269504089f;
typedef short v4i16_t __attribute__((ext_vector_type(4)));
__device__ __forceinline__ v2u vtr(const LAS bf16* p) { return __builtin_bit_cast(v2u, __builtin_amdgcn_ds_read_tr16_b64_v4i16((LAS v4i16_t*)p)); }
__device__ __forceinline__ void attn_phase(LAS unsigned char* lds, const bf16* Q, const bf16* K, const bf16* V, bf16* O, const float* qg, const float* kg, int gw, int ngw, int wave_s) {
    int tid_ = wave_s * 64 + lane_id_(); asm volatile("" : "+v"(tid_));
    const int lane = tid_ & 63, w = __builtin_amdgcn_readfirstlane(tid_ >> 6), hi = lane >> 5, ql = lane & 31;
    LAS bf16* Ks = (LAS bf16*)(lds + w * (64 * KP * 2));
    LAS bf16* Vs = Ks + 32 * KP;
    const int skey = lane >> 3, sch = lane & 7;
    const LAS bf16* vtb = Vs + (4 * hi + ((lane & 15) >> 2)) * KP + 16 * ((lane >> 4) & 1) + 4 * (lane & 3);
    for (int wu = gw; wu < BATCH * NH * 64; wu += ngw) {
        const int qblk = wu & 63, bh = wu >> 6, b = bh >> 4, h = bh & 15;
        const int tq = 32 * qblk + ql;
        bf16x8 qf[4];
        {
            const bf16* qp = Q + (size_t)(b * SEQ + tq) * D + h * HD + 8 * hi;
            float qv[4][8]; float ss = 0.f;
#pragma unroll
            for (int s = 0; s < 4; ++s) { const v4u r = *(const v4u*)(qp + 16 * s);
                qv[s][0] = bf_lo(r.x); qv[s][1] = bf_hi(r.x); qv[s][2] = bf_lo(r.y); qv[s][3] = bf_hi(r.y); qv[s][4] = bf_lo(r.z); qv[s][5] = bf_hi(r.z); qv[s][6] = bf_lo(r.w); qv[s][7] = bf_hi(r.w);
#pragma unroll
                for (int j = 0; j < 8; ++j) ss += qv[s][j] * qv[s][j]; }
            ss += __shfl_xor(ss, 32);
            const float rs = (0.125f * LOG2E) * __builtin_amdgcn_rsqf(ss * (1.f / HD) + EPS);
#pragma unroll
            for (int s = 0; s < 4; ++s) { float gp[8];
#pragma unroll
                for (int j = 0; j < 8; ++j) gp[j] = qg[16 * s + 8 * hi + j] * kg[16 * s + 8 * hi + j];
                v4u p;
                p.x = pk_bf16(qv[s][0] * rs * gp[0], qv[s][1] * rs * gp[1]); p.y = pk_bf16(qv[s][2] * rs * gp[2], qv[s][3] * rs * gp[3]);
                p.z = pk_bf16(qv[s][4] * rs * gp[4], qv[s][5] * rs * gp[5]); p.w = pk_bf16(qv[s][6] * rs * gp[6], qv[s][7] * rs * gp[7]);
                qf[s] = __builtin_bit_cast(bf16x8, p); }
        }
        f32x16 o0, o1;
#pragma unroll
        for (int i = 0; i < 16; ++i) { o0[i] = 0.f; o1[i] = 0.f; }
        float R = 0.f;
        v4u krA[4], vrA[4], krB[4], vrB[4];
        int kb = qblk;
        const bf16* kbase = K + (size_t)(b * SEQ + skey) * D + h * HD + 8 * sch;
        const bf16* vbase = V + (size_t)(b * SEQ + skey) * D + h * HD + 8 * sch;
#define ATT_LOAD(KR, VR, KBL) do { _Pragma("unroll") for (int i = 0; i < 4; ++i) { KR[i] = *(const v4u*)(kbase + (size_t)(32 * (KBL) + 8 * i) * D); VR[i] = *(const v4u*)(vbase + (size_t)(32 * (KBL) + 8 * i) * D); } } while (0)
#define ATT_BLOCK(KR, VR, KBC) do { \
            _Pragma("unroll") for (int i = 0; i < 4; ++i) { \
                float kf[8] = {bf_lo(KR[i].x), bf_hi(KR[i].x), bf_lo(KR[i].y), bf_hi(KR[i].y), bf_lo(KR[i].z), bf_hi(KR[i].z), bf_lo(KR[i].w), bf_hi(KR[i].w)}; \
                float ss = 0.f; \
                _Pragma("unroll") for (int j = 0; j < 8; ++j) ss += kf[j] * kf[j]; \
                ss += __uint_as_float(__builtin_amdgcn_mov_dpp(__float_as_uint(ss), 0xB1, 0xF, 0xF, true)); ss += __uint_as_float(__builtin_amdgcn_mov_dpp(__float_as_uint(ss), 0x4E, 0xF, 0xF, true)); ss += __uint_as_float(__builtin_amdgcn_mov_dpp(__float_as_uint(ss), 0x141, 0xF, 0xF, true)); \
                const float rs = __builtin_amdgcn_rsqf(ss * (1.f / HD) + EPS); \
                v4u p_; p_.x = pk_bf16(kf[0] * rs, kf[1] * rs); p_.y = pk_bf16(kf[2] * rs, kf[3] * rs); \
                p_.z = pk_bf16(kf[4] * rs, kf[5] * rs); p_.w = pk_bf16(kf[6] * rs, kf[7] * rs); \
                *(LAS v4u*)(Ks + (skey + 8 * i) * KP + 8 * sch) = p_; \
                *(LAS v4u*)(Vs + (skey + 8 * i) * KP + 8 * sch) = VR[i]; \
            } \
            if ((KBC) >= 2) ATT_LOAD(KR, VR, (KBC) - 2); \
            f32x16 p; \
            _Pragma("unroll") for (int i = 0; i < 16; ++i) p[i] = 0.f; \
            _Pragma("unroll") for (int s = 0; s < 4; ++s) { const bf16x8 kf = *(const LAS bf16x8*)(Ks + ql * KP + 16 * s + 8 * hi); \
                p = __builtin_amdgcn_mfma_f32_32x32x16_bf16(kf, qf[s], p, 0, 0, 0); } \
            const bool diag = ((KBC) == qblk); \
            { \
                float sp[16], lb[16]; \
                _Pragma("unroll") for (int i = 0; i < 16; ++i) { \
                    const float z = p[i]; \
                    const float e = __builtin_amdgcn_exp2f(-fabsf(z)); \
                    const float l = __builtin_amdgcn_logf(1.0f + e); \
                    const int kl = 8 * (i >> 2) + 4 * hi + (i & 3); \
                    const bool valid = !diag || (kl < ql); \
                    sp[i] = valid ? fmaxf(z, 0.f) + l : 0.f; \
                    lb[i] = valid ? fminf(z, 0.f) - l : -1e30f; \
                } \
                float run = R; \
                _Pragma("unroll") for (int g = 3; g >= 0; --g) { \
                    const float Gm = (sp[4 * g] + sp[4 * g + 1]) + (sp[4 * g + 2] + sp[4 * g + 3]); \
                    const float Go = __shfl_xor(Gm, 32); \
                    const float aft = hi ? run : run + Go; \
                    const float e3 = aft, e2 = e3 + sp[4 * g + 3], e1 = e2 + sp[4 * g + 2], e0 = e1 + sp[4 * g + 1]; \
                    p[4 * g + 3] = __builtin_amdgcn_exp2f(lb[4 * g + 3] - e3); \
                    p[4 * g + 2] = __builtin_amdgcn_exp2f(lb[4 * g + 2] - e2); \
                    p[4 * g + 1] = __builtin_amdgcn_exp2f(lb[4 * g + 1] - e1); \
                    p[4 * g + 0] = __builtin_amdgcn_exp2f(lb[4 * g + 0] - e0); \
                    run += Gm + Go; \
                } \
                R = run; \
            } \
            _Pragma("unroll") for (int s2 = 0; s2 < 2; ++s2) { \
                v4u pa; pa.x = pk_bf16(p[8 * s2 + 0], p[8 * s2 + 1]); pa.y = pk_bf16(p[8 * s2 + 2], p[8 * s2 + 3]); \
                pa.z = pk_bf16(p[8 * s2 + 4], p[8 * s2 + 5]); pa.w = pk_bf16(p[8 * s2 + 6], p[8 * s2 + 7]); \
                const bf16x8 pav = __builtin_bit_cast(bf16x8, pa); \
                const LAS bf16* vp = vtb + (16 * s2) * KP; \
                v4u vb; { const v2u a_ = vtr(vp), c_ = vtr(vp + 8 * KP); vb.x = a_.x; vb.y = a_.y; vb.z = c_.x; vb.w = c_.y; } \
                o0 = __builtin_amdgcn_mfma_f32_32x32x16_bf16(pav, __builtin_bit_cast(bf16x8, vb), o0, 0, 0, 0); \
                { const v2u a_ = vtr(vp + 32), c_ = vtr(vp + 8 * KP + 32); vb.x = a_.x; vb.y = a_.y; vb.z = c_.x; vb.w = c_.y; } \
                o1 = __builtin_amdgcn_mfma_f32_32x32x16_bf16(pav, __builtin_bit_cast(bf16x8, vb), o1, 0, 0, 0); \
            } \
            done = ((KBC) == 0) || (__builtin_amdgcn_ballot_w64(R < SB_EXIT) == 0ull); \
        } while (0)
        ATT_LOAD(krA, vrA, kb);
        if (kb >= 1) ATT_LOAD(krB, vrB, kb - 1);
        for (;;) {
            bool done;
            ATT_BLOCK(krA, vrA, kb);
            if (done) break;
            ATT_BLOCK(krB, vrB, kb - 1);
            if (done) break;
            kb -= 2;
        }
#undef ATT_LOAD
#undef ATT_BLOCK
        {
            LAS bf16* Ot = Ks;
#pragma unroll
            for (int i = 0; i < 16; ++i) { const int r = 8 * (i >> 2) + 4 * hi + (i & 3);
                Ot[r * KP + ql] = (bf16)(pk_bf16(o0[i], 0.f) & 0xffffu); Ot[r * KP + 32 + ql] = (bf16)(pk_bf16(o1[i], 0.f) & 0xffffu); }
            bf16* op = O + (size_t)(b * SEQ + 32 * qblk + skey) * D + h * HD + 8 * sch;
#pragma unroll
            for (int i = 0; i < 4; ++i) *(v4u*)(op + (size_t)(8 * i) * D) = *(const LAS v4u*)(Ot + (skey + 8 * i) * KP + 8 * sch);
        }
    }
}

__device__ __forceinline__ void attn_phase2(LAS unsigned char* lds, const bf16* Q, const bf16* K, const bf16* V, bf16* O, const float* qg, const float* kg, int gw, int ngw, int wave_s) {
    int tid_ = wave_s * 64 + lane_id_(); asm volatile("" : "+v"(tid_));
    const int lane = tid_ & 63, w = __builtin_amdgcn_readfirstlane(tid_ >> 6), hi = lane >> 5, ql = lane & 31;
    LAS bf16* Ks = (LAS bf16*)(lds + w * (64 * KP * 2));
    LAS bf16* Vs = Ks + 32 * KP;
    const int skey = lane >> 3, sch = lane & 7;
    const LAS bf16* vtb = Vs + (4 * hi + ((lane & 15) >> 2)) * KP + 16 * ((lane >> 4) & 1) + 4 * (lane & 3);
    for (int wu = gw; wu < BATCH * NH * 32; wu += ngw) {
        const int pq = wu & 31, bh = wu >> 5, b = bh >> 4, h = bh & 15;
        const int qblk0 = 2 * pq, qblk1 = 2 * pq + 1;
        bf16x8 qfa[4], qfb[4];
#define ATT_LOADQ(QF, QBLK) do { \
            const bf16* qp = Q + (size_t)(b * SEQ + 32 * (QBLK) + ql) * D + h * HD + 8 * hi; \
            float qv[4][8]; float ss = 0.f; \
            _Pragma("unroll") for (int s = 0; s < 4; ++s) { const v4u r = *(const v4u*)(qp + 16 * s); \
                qv[s][0] = bf_lo(r.x); qv[s][1] = bf_hi(r.x); qv[s][2] = bf_lo(r.y); qv[s][3] = bf_hi(r.y); qv[s][4] = bf_lo(r.z); qv[s][5] = bf_hi(r.z); qv[s][6] = bf_lo(r.w); qv[s][7] = bf_hi(r.w); \
                _Pragma("unroll") for (int j = 0; j < 8; ++j) ss += qv[s][j] * qv[s][j]; } \
            ss += __shfl_xor(ss, 32); \
            const float rs = (0.125f * LOG2E) * __builtin_amdgcn_rsqf(ss * (1.f / HD) + EPS); \
            _Pragma("unroll") for (int s = 0; s < 4; ++s) { float gp[8]; \
                _Pragma("unroll") for (int j = 0; j < 8; ++j) gp[j] = qg[16 * s + 8 * hi + j] * kg[16 * s + 8 * hi + j]; \
                v4u p; \
                p.x = pk_bf16(qv[s][0] * rs * gp[0], qv[s][1] * rs * gp[1]); p.y = pk_bf16(qv[s][2] * rs * gp[2], qv[s][3] * rs * gp[3]); \
                p.z = pk_bf16(qv[s][4] * rs * gp[4], qv[s][5] * rs * gp[5]); p.w = pk_bf16(qv[s][6] * rs * gp[6], qv[s][7] * rs * gp[7]); \
                QF[s] = __builtin_bit_cast(bf16x8, p); } } while (0)
        ATT_LOADQ(qfa, qblk0);
        ATT_LOADQ(qfb, qblk1);
        f32x16 oa0, oa1, ob0, ob1;
#pragma unroll
        for (int i = 0; i < 16; ++i) { oa0[i] = 0.f; oa1[i] = 0.f; ob0[i] = 0.f; ob1[i] = 0.f; }
        float Ra = 0.f, Rb = 0.f;
        bool da = false, db = false;
        v4u kr[4], vr[4];
        int kb = qblk1;
        const bf16* kbase = K + (size_t)(b * SEQ + skey) * D + h * HD + 8 * sch;
        const bf16* vbase = V + (size_t)(b * SEQ + skey) * D + h * HD + 8 * sch;
#pragma unroll
        for (int i = 0; i < 4; ++i) { kr[i] = *(const v4u*)(kbase + (size_t)(32 * kb + 8 * i) * D); vr[i] = *(const v4u*)(vbase + (size_t)(32 * kb + 8 * i) * D); }
#define ATT_TILE(QF, O0, O1, RR, DIAG) do { \
            f32x16 p; \
            _Pragma("unroll") for (int i = 0; i < 16; ++i) p[i] = 0.f; \
            _Pragma("unroll") for (int s = 0; s < 4; ++s) { const bf16x8 kf = *(const LAS bf16x8*)(Ks + ql * KP + 16 * s + 8 * hi); \
                p = __builtin_amdgcn_mfma_f32_32x32x16_bf16(kf, QF[s], p, 0, 0, 0); } \
            const bool diag = (DIAG); \
            { \
                float sp[16], lb[16]; \
                _Pragma("unroll") for (int i = 0; i < 16; ++i) { \
                    const float z = p[i]; \
                    const float e = __builtin_amdgcn_exp2f(-fabsf(z)); \
                    const float l = __builtin_amdgcn_logf(1.0f + e); \
                    const int kl = 8 * (i >> 2) + 4 * hi + (i & 3); \
                    const bool valid = !diag || (kl < ql); \
                    sp[i] = valid ? fmaxf(z, 0.f) + l : 0.f; \
                    lb[i] = valid ? fminf(z, 0.f) - l : -1e30f; \
                } \
                float run = RR; \
                _Pragma("unroll") for (int g = 3; g >= 0; --g) { \
                    const float Gm = (sp[4 * g] + sp[4 * g + 1]) + (sp[4 * g + 2] + sp[4 * g + 3]); \
                    const float Go = __shfl_xor(Gm, 32); \
                    const float aft = hi ? run : run + Go; \
                    const float e3 = aft, e2 = e3 + sp[4 * g + 3], e1 = e2 + sp[4 * g + 2], e0 = e1 + sp[4 * g + 1]; \
                    p[4 * g + 3] = __builtin_amdgcn_exp2f(lb[4 * g + 3] - e3); \
                    p[4 * g + 2] = __builtin_amdgcn_exp2f(lb[4 * g + 2] - e2); \
                    p[4 * g + 1] = __builtin_amdgcn_exp2f(lb[4 * g + 1] - e1); \
                    p[4 * g + 0] = __builtin_amdgcn_exp2f(lb[4 * g + 0] - e0); \
                    run += Gm + Go; \
                } \
                RR = run; \
            } \
            _Pragma("unroll") for (int s2 = 0; s2 < 2; ++s2) { \
                v4u pa; pa.x = pk_bf16(p[8 * s2 + 0], p[8 * s2 + 1]); pa.y = pk_bf16(p[8 * s2 + 2], p[8 * s2 + 3]); \
                pa.z = pk_bf16(p[8 * s2 + 4], p[8 * s2 + 5]); pa.w = pk_bf16(p[8 * s2 + 6], p[8 * s2 + 7]); \
                const bf16x8 pav = __builtin_bit_cast(bf16x8, pa); \
                const LAS bf16* vp = vtb + (16 * s2) * KP; \
                v4u vb; { const v2u a_ = vtr(vp), c_ = vtr(vp + 8 * KP); vb.x = a_.x; vb.y = a_.y; vb.z = c_.x; vb.w = c_.y; } \
                O0 = __builtin_amdgcn_mfma_f32_32x32x16_bf16(pav, __builtin_bit_cast(bf16x8, vb), O0, 0, 0, 0); \
                { const v2u a_ = vtr(vp + 32), c_ = vtr(vp + 8 * KP + 32); vb.x = a_.x; vb.y = a_.y; vb.z = c_.x; vb.w = c_.y; } \
                O1 = __builtin_amdgcn_mfma_f32_32x32x16_bf16(pav, __builtin_bit_cast(bf16x8, vb), O1, 0, 0, 0); \
            } \
        } while (0)
        for (;;) {
#pragma unroll
            for (int i = 0; i < 4; ++i) {
                float kf[8] = {bf_lo(kr[i].x), bf_hi(kr[i].x), bf_lo(kr[i].y), bf_hi(kr[i].y), bf_lo(kr[i].z), bf_hi(kr[i].z), bf_lo(kr[i].w), bf_hi(kr[i].w)};
                float ss = 0.f;
#pragma unroll
                for (int j = 0; j < 8; ++j) ss += kf[j] * kf[j];
                ss += __uint_as_float(__builtin_amdgcn_mov_dpp(__float_as_uint(ss), 0xB1, 0xF, 0xF, true)); ss += __uint_as_float(__builtin_amdgcn_mov_dpp(__float_as_uint(ss), 0x4E, 0xF, 0xF, true)); ss += __uint_as_float(__builtin_amdgcn_mov_dpp(__float_as_uint(ss), 0x141, 0xF, 0xF, true));
                const float rs = __builtin_amdgcn_rsqf(ss * (1.f / HD) + EPS);
                v4u p_; p_.x = pk_bf16(kf[0] * rs, kf[1] * rs); p_.y = pk_bf16(kf[2] * rs, kf[3] * rs); p_.z = pk_bf16(kf[4] * rs, kf[5] * rs); p_.w = pk_bf16(kf[6] * rs, kf[7] * rs);
                *(LAS v4u*)(Ks + (skey + 8 * i) * KP + 8 * sch) = p_;
                *(LAS v4u*)(Vs + (skey + 8 * i) * KP + 8 * sch) = vr[i];
            }
            if (kb > 0) {
#pragma unroll
                for (int i = 0; i < 4; ++i) { kr[i] = *(const v4u*)(kbase + (size_t)(32 * (kb - 1) + 8 * i) * D); vr[i] = *(const v4u*)(vbase + (size_t)(32 * (kb - 1) + 8 * i) * D); }
            }
            if (!db) { ATT_TILE(qfb, ob0, ob1, Rb, kb == qblk1); db = (__builtin_amdgcn_ballot_w64(Rb < SB_EXIT) == 0ull); }
            if (kb <= qblk0 && !da) { ATT_TILE(qfa, oa0, oa1, Ra, kb == qblk0); da = (__builtin_amdgcn_ballot_w64(Ra < SB_EXIT) == 0ull); }
            if (kb == 0 || (da && db)) break;
            --kb;
        }
#undef ATT_LOADQ
#undef ATT_TILE
#define ATT_STORE(O0, O1, QBLK) do { \
            LAS bf16* Ot = Ks; \
            _Pragma("unroll") for (int i = 0; i < 16; ++i) { const int r = 8 * (i >> 2) + 4 * hi + (i & 3); \
                Ot[r * KP + ql] = (bf16)(pk_bf16(O0[i], 0.f) & 0xffffu); Ot[r * KP + 32 + ql] = (bf16)(pk_bf16(O1[i], 0.f) & 0xffffu); } \
            bf16* op = O + (size_t)(b * SEQ + 32 * (QBLK) + skey) * D + h * HD + 8 * sch; \
            _Pragma("unroll") for (int i = 0; i < 4; ++i) *(v4u*)(op + (size_t)(8 * i) * D) = *(const LAS v4u*)(Ot + (skey + 8 * i) * KP + 8 * sch); } while (0)
        ATT_STORE(oa0, oa1, qblk0);
        ATT_STORE(ob0, ob1, qblk1);
#undef ATT_STORE
    }
}

constexpr int LT = 128, NCH = SEQ / LT;
#define LDS_BARRIER() do { asm volatile("s_waitcnt lgkmcnt(0)" ::: "memory"); __builtin_amdgcn_s_barrier(); asm volatile("" ::: "memory"); } while (0)
__device__ __forceinline__ void lru_phase(LAS unsigned char* lds, const bf16* XB, const bf16* Y, bf16* HY, const bf16* WRt, const bf16* WIt,
        const float* convw, const float* convb, const float* br, const float* bi, const float* lam, unsigned long long* gran, int G, int bid, int wave_s) {
    int tid = wave_s * 64 + lane_id_(); asm volatile("" : "+v"(tid));
    const int lane = tid & 63, w = __builtin_amdgcn_readfirstlane(tid >> 6), hi = lane >> 5, ql = lane & 31;
    LAS float* xcF = (LAS float*)lds;
    LAS bf16* wL = (LAS bf16*)(lds + 32768);
    LAS bf16* xcB = (LAS bf16*)(lds + 65536);
    LAS float* segA = (LAS float*)(lds + 65536 + 128 * KP * 2);
    LAS float* segH = segA + 512;
    LAS float* pA = segH + 512;
    LAS float* pH = pA + 1024;
    LAS bf16* yL = (LAS bf16*)(lds + 65536 + 128 * KP * 2 + 16384);
    const int st = tid >> 3, cc = 8 * (tid & 7);
    LAS float* parL = (LAS float*)(lds + 118784);
    int n_loaded = -1;
    const int rb = w >> 1, cbk = w & 1, d = 32 * cbk + ql;
    v4u xt[2][4], yv[2];
#define LRU_LOAD_X(u_) do { const int ch_ = (u_) >> 7, bn_ = (u_) & 127, b_ = bn_ >> 4, n_ = bn_ & 15, t0_ = ch_ * LT, c0_ = 64 * n_; \
        _Pragma("unroll") for (int r = 0; r < 2; ++r) { yv[r] = *(const v4u*)(Y + (size_t)(b_ * SEQ + t0_ + st + 64 * r) * D + c0_ + cc); \
            _Pragma("unroll") for (int j = 0; j < 4; ++j) { const int ts = t0_ + st + 64 * r + j - 3; xt[r][j] = ts >= 0 ? *(const v4u*)(XB + (size_t)(b_ * SEQ + ts) * D + c0_ + cc) : (v4u){0u, 0u, 0u, 0u}; } } } while (0)
    if (bid < BATCH * 16 * NCH) LRU_LOAD_X(bid);
    for (int unit = bid; unit < BATCH * 16 * NCH; unit += G) {
        const int ch = unit >> 7, bn = unit & 127, b = bn >> 4, n = bn & 15;
        const int t0 = ch * LT, c0 = 64 * n;
        if (n != n_loaded) {
            LDS_BARRIER();
            if (tid < 256) parL[tid] = convw[(tid >> 6) * D + c0 + (tid & 63)];
            else if (tid < 320) parL[tid] = convb[c0 + tid - 256];
            else if (tid < 384) parL[tid] = br[c0 + tid - 320];
            else if (tid < 448) parL[tid] = bi[c0 + tid - 384];
            else { const float lm = lam[c0 + tid - 448]; parL[tid] = -8.0f * (fmaxf(-lm, 0.f) + __builtin_amdgcn_logf(1.0f + __builtin_amdgcn_exp2f(-fabsf(lm) * LOG2E)) * LN2); }
#pragma unroll
            for (int r = 0; r < 2; ++r) { const int e = tid + 512 * r, gate = e >> 9, row = (e >> 3) & 63, chk = e & 7;
                *(LAS v4u*)(wL + (gate * 64 + row) * KP + 8 * chk) = *(const v4u*)((gate ? WIt : WRt) + (size_t)n * 4096 + row * 64 + 8 * chk); }
            n_loaded = n;
        }
        LDS_BARRIER();
        {
            float cw[4][8], cb[8];
#pragma unroll
            for (int j = 0; j < 4; ++j) { const f32x4 c0v = *(const LAS f32x4*)(parL + j * 64 + cc), c1v = *(const LAS f32x4*)(parL + j * 64 + cc + 4);
                cw[j][0] = c0v[0]; cw[j][1] = c0v[1]; cw[j][2] = c0v[2]; cw[j][3] = c0v[3]; cw[j][4] = c1v[0]; cw[j][5] = c1v[1]; cw[j][6] = c1v[2]; cw[j][7] = c1v[3]; }
            { const f32x4 c0v = *(const LAS f32x4*)(parL + 256 + cc), c1v = *(const LAS f32x4*)(parL + 256 + cc + 4);
                cb[0] = c0v[0]; cb[1] = c0v[1]; cb[2] = c0v[2]; cb[3] = c0v[3]; cb[4] = c1v[0]; cb[5] = c1v[1]; cb[6] = c1v[2]; cb[7] = c1v[3]; }
#pragma unroll
            for (int r = 0; r < 2; ++r) {
                const int t = st + 64 * r;
                float acc[8];
#pragma unroll
                for (int e = 0; e < 8; ++e) acc[e] = cb[e];
#pragma unroll
                for (int j = 0; j < 4; ++j) {
                    const v4u x = xt[r][j];
                    acc[0] += cw[j][0] * bf_lo(x.x); acc[1] += cw[j][1] * bf_hi(x.x); acc[2] += cw[j][2] * bf_lo(x.y); acc[3] += cw[j][3] * bf_hi(x.y);
                    acc[4] += cw[j][4] * bf_lo(x.z); acc[5] += cw[j][5] * bf_hi(x.z); acc[6] += cw[j][6] * bf_lo(x.w); acc[7] += cw[j][7] * bf_hi(x.w);
                }
                *(LAS f32x4*)(xcF + t * 64 + cc) = (f32x4){acc[0], acc[1], acc[2], acc[3]}; *(LAS f32x4*)(xcF + t * 64 + cc + 4) = (f32x4){acc[4], acc[5], acc[6], acc[7]};
                v4u p; p.x = pk_bf16(acc[0], acc[1]); p.y = pk_bf16(acc[2], acc[3]); p.z = pk_bf16(acc[4], acc[5]); p.w = pk_bf16(acc[6], acc[7]);
                *(LAS v4u*)(xcB + t * KP + cc) = p;
                *(LAS v4u*)(yL + t * KP + cc) = yv[r];
            }
        }
        if (unit + G < BATCH * 16 * NCH) LRU_LOAD_X(unit + G);
        LDS_BARRIER();
        unsigned xa[2] = {0u, 0u}, xh[2] = {0u, 0u}, xt_[2] = {0u, 0u};
#pragma unroll
        for (int q = 0; q < 2; ++q) { const int kk = w + 8 * q;
            if (kk < ch) { const unsigned long long* g = gran + ((size_t)(b * NCH + kk) * D + c0 + lane) * 2;
                const unsigned long long ya = __hip_atomic_load(g, __ATOMIC_RELAXED, __HIP_MEMORY_SCOPE_AGENT), yh = __hip_atomic_load(g + 1, __ATOMIC_RELAXED, __HIP_MEMORY_SCOPE_AGENT);
                xa[q] = (unsigned)ya; xh[q] = (unsigned)yh; xt_[q] = (unsigned)(ya >> 32) & (unsigned)(yh >> 32); } }
        float av[16], uv[16];
        const int c = lane, sg = 2 * rb + hi, tb = 32 * rb + 16 * hi;
        {
            f32x16 pr, pi;
#pragma unroll
            for (int i = 0; i < 16; ++i) { pr[i] = 0.f; pi[i] = 0.f; }
            const int trow = 32 * rb + 16 * ((ql >> 2) & 1) + 4 * (ql >> 3) + (ql & 3);
#pragma unroll
            for (int s = 0; s < 4; ++s) {
                const bf16x8 af = *(const LAS bf16x8*)(xcB + trow * KP + 16 * s + 8 * hi);
                const bf16x8 wr_ = *(const LAS bf16x8*)(wL + d * KP + 16 * s + 8 * hi), wi_ = *(const LAS bf16x8*)(wL + (64 + d) * KP + 16 * s + 8 * hi);
                pr = __builtin_amdgcn_mfma_f32_32x32x16_bf16(af, wr_, pr, 0, 0, 0);
                pi = __builtin_amdgcn_mfma_f32_32x32x16_bf16(af, wi_, pi, 0, 0, 0);
            }
            const float brv = parL[320 + d], biv = parL[384 + d], ls8 = parL[448 + d];
            float A = 1.f, H = 0.f;
#pragma unroll
            for (int i = 0; i < 16; ++i) {
                const float r = pg8::fast_sigmoid(pr[i] + brv), ig = pg8::fast_sigmoid(pi[i] + biv);
                const float la = ls8 * r;
                const float a = __builtin_amdgcn_exp2f(la * LOG2E);
                const float mult = __builtin_amdgcn_sqrtf(fmaxf(1.0f - a * a, 0.f));
                const float u = mult * ig * xcF[(tb + i) * 64 + d];
                av[i] = a; uv[i] = u; H = a * H + u; A *= a;
            }
            segA[sg * 64 + d] = A; segH[sg * 64 + d] = H;
        }
        LDS_BARRIER();
        if (w == 0 && ch < NCH - 1) {
            float At = 1.f, Ht = 0.f;
#pragma unroll
            for (int s = 0; s < 8; ++s) { const float a = segA[s * 64 + c], hh = segH[s * 64 + c]; Ht = a * Ht + hh; At *= a; }
            unsigned long long* g = gran + ((size_t)(b * NCH + ch) * D + c0 + c) * 2;
            __hip_atomic_store(g, (1ull << 32) | (unsigned long long)__float_as_uint(At), __ATOMIC_RELAXED, __HIP_MEMORY_SCOPE_AGENT);
            __hip_atomic_store(g + 1, (1ull << 32) | (unsigned long long)__float_as_uint(Ht), __ATOMIC_RELAXED, __HIP_MEMORY_SCOPE_AGENT);
        }
#pragma unroll
        for (int q = 0; q < 2; ++q) { const int kk = w + 8 * q;
            if (kk < ch) {
                const unsigned long long* g = gran + ((size_t)(b * NCH + kk) * D + c0 + c) * 2;
                for (unsigned spins = 0; spins < (1u << 22); ++spins) {
                    if (__all(xt_[q] == 1u)) break;
                    __builtin_amdgcn_s_sleep(1);
                    const unsigned long long ya = __hip_atomic_load(g, __ATOMIC_RELAXED, __HIP_MEMORY_SCOPE_AGENT), yh = __hip_atomic_load(g + 1, __ATOMIC_RELAXED, __HIP_MEMORY_SCOPE_AGENT);
                    xa[q] = (unsigned)ya; xh[q] = (unsigned)yh; xt_[q] = (unsigned)(ya >> 32) & (unsigned)(yh >> 32); }
                pA[kk * 64 + c] = __uint_as_float(xa[q]); pH[kk * 64 + c] = __uint_as_float(xh[q]);
            } }
        LDS_BARRIER();
        {
            float h = 0.f;
            for (int kk = 0; kk < ch; ++kk) h = pA[kk * 64 + d] * h + pH[kk * 64 + d];
            for (int s = 0; s < 7; ++s) { if (s < sg) h = segA[s * 64 + d] * h + segH[s * 64 + d]; }
#pragma unroll
            for (int i = 0; i < 16; ++i) { const int t = tb + i; h = av[i] * h + uv[i];
                const float yv_ = __uint_as_float((unsigned)yL[t * KP + d] << 16);
                xcB[t * KP + d] = (bf16)(pk_bf16(h * yv_, 0.f) & 0xffffu); }
        }
        LDS_BARRIER();
#pragma unroll
        for (int r = 0; r < 2; ++r) *(v4u*)(HY + (size_t)(b * SEQ + t0 + st + 64 * r) * D + c0 + cc) = *(const LAS v4u*)(xcB + (st + 64 * r) * KP + cc);
    }
}

#define RLX_AGENT __ATOMIC_RELAXED, __HIP_MEMORY_SCOPE_AGENT
#define XB_TMO      128
#define XB_XCNT(j)  (256  + 64 * (j))
#define XB_XSUB(j)  (1280 + 64 * (j))
#define XB_XGEN(j)  (2304 + 64 * (j))
#define XB_TOP      3328
#define XB_TOPGEN   3392
#define XCD_BAR_WORDS 3456
#define XB_SPIN_CAP (1u << 18)

__device__ __forceinline__ unsigned xb_ld(unsigned* p)              { return __hip_atomic_load(p, __ATOMIC_RELAXED, __HIP_MEMORY_SCOPE_AGENT); }
__device__ __forceinline__ unsigned xb_add(unsigned* p, unsigned v) { return __hip_atomic_fetch_add(p, v, __ATOMIC_RELAXED, __HIP_MEMORY_SCOPE_AGENT); }
__device__ __forceinline__ unsigned xb_xcc_id() { return (unsigned)__builtin_amdgcn_s_getreg((3 << 11) | 20) & 0xFu; }
#define XB_SPIN(cond, bar) do { unsigned _sp = 0; while (cond) { __builtin_amdgcn_s_sleep(1); \
    if ((++_sp & 255u) == 0u) { if (xb_ld(&(bar)[XB_TMO])) break; if (_sp > XB_SPIN_CAP) { atomicAdd(&(bar)[XB_TMO], 1u); break; } } } } while (0)

struct XcdBarrier {
    unsigned* bar; unsigned x;
    volatile LAS unsigned* st;
};

__device__ __forceinline__ XcdBarrier xcd_barrier_post(unsigned* bar, volatile LAS unsigned* st, bool is_t0) {
    XcdBarrier b; b.bar = bar; b.x = xb_xcc_id(); b.st = st;
    if (is_t0) (void)xb_add(&bar[XB_XCNT(b.x)], 1u);
    return b;
}
__device__ __forceinline__ void xcd_barrier_complete(unsigned* bar, unsigned x, unsigned& nloc, unsigned& nx) {
    const unsigned G = gridDim.x * gridDim.y * gridDim.z;
    unsigned sum, cnt, mine, sp = 0u;
    for (;;) {
        sum = 0u; cnt = 0u; mine = 0u;
#pragma unroll
        for (unsigned j = 0; j < 16; ++j) { const unsigned c = xb_ld(&bar[XB_XCNT(j)]); sum += c; cnt += (c > 0u) ? 1u : 0u; mine = (j == x) ? c : mine; }
        if (sum == G) break;
        __builtin_amdgcn_s_sleep(1);
        if ((++sp & 255u) == 0u) { if (xb_ld(&bar[XB_TMO])) break; if (sp > XB_SPIN_CAP) { atomicAdd(&bar[XB_TMO], 1u); break; } }
    }
    nloc = mine > 0u ? mine : 1u; nx = cnt > 0u ? cnt : 1u;
}

__device__ __forceinline__ void xcd_barrier(const XcdBarrier& b, int wave_s) {
    asm volatile("s_waitcnt vmcnt(0)" ::: "memory");
    __syncthreads();
    if (wave_s == 0 && lane_id_() == 0) {
        unsigned* bar = b.bar;
        __builtin_amdgcn_s_waitcnt(0);
        unsigned nloc = b.st[0], nx = b.st[1];
        if (nloc == 0u) { xcd_barrier_complete(bar, b.x, nloc, nx); b.st[0] = nloc; b.st[1] = nx; }
        const unsigned old = xb_add(&bar[XB_XSUB(b.x)], 1u);
        const unsigned gen = old / nloc;
        if (old + 1u == (gen + 1u) * nloc) {
            __builtin_amdgcn_fence(__ATOMIC_RELEASE, "agent");
            asm volatile("s_waitcnt vmcnt(0)" ::: "memory");
            const unsigned og = xb_add(&bar[XB_TOP], 1u);
            const unsigned tg = og / nx;
            if (og + 1u == (tg + 1u) * nx) xb_add(&bar[XB_TOPGEN], 1u);
            else XB_SPIN(xb_ld(&bar[XB_TOPGEN]) == tg, bar);
            __builtin_amdgcn_fence(__ATOMIC_ACQUIRE, "agent");
            xb_add(&bar[XB_XGEN(b.x)], 1u);
            asm volatile("s_waitcnt vmcnt(0)" ::: "memory");
        } else {
            XB_SPIN(xb_ld(&bar[XB_XGEN(b.x)]) == gen, bar);
            __builtin_amdgcn_fence(__ATOMIC_ACQUIRE, "agent");
            asm volatile("s_waitcnt vmcnt(0)" ::: "memory");
        }
    }
    __syncthreads();
}

__device__ __forceinline__ int launder_s_(int k) { asm volatile("" : "+s"(k)); return k; }
struct Args { const float* in[28]; float* out; unsigned char* ws; };
__global__ void __launch_bounds__(512, 2) fwd_megakernel(Args a) {
    const float* const* kin_ = (const float* const*)__builtin_amdgcn_kernarg_segment_ptr();
#define AIN(k) (kin_[launder_s_(k)])
    extern __shared__ __attribute__((aligned(16))) unsigned char lds_raw[];
    cg::grid_group grid = cg::this_grid();
    LAS unsigned char* lds = (LAS unsigned char*)lds_raw;
    const int tid = threadIdx.x, lane = tid & 63, wave = __builtin_amdgcn_readfirstlane(tid >> 6);
    const int G = gridDim.x, bid = blockIdx.x;
    const int gw = bid * 8 + wave, ngw = G * 8;
    unsigned char* ws = a.ws;
    bf16* XN = (bf16*)(ws + WS_XN); bf16* ACT = (bf16*)(ws + WS_ACT);
    bf16* QB = ACT; bf16* KB = ACT + (size_t)M * D; bf16* VB = ACT + (size_t)2 * M * D;
    volatile LAS unsigned* MISC = (volatile LAS unsigned*)(lds + 131072 + 4096);
    if (tid < 2) MISC[tid] = 0u;
    __syncthreads();
    const XcdBarrier xbar = xcd_barrier_post((unsigned*)(ws + WS_CTL), MISC, tid == 0);

    float* SSQ = (float*)(ws + WS_SSQ);
#define SSQ_AT(s) (SSQ + (size_t)(s) * M)
    constexpr int I_IN = (D / 64) * (2 * FF / 32), I_OUT = (FF / 64) * (D / 32), I_QKV = (D / 64) * (3 * D / 32), I_SQ = (D / 64) * (D / 32), I_LIN = (D / 64) * (2 * D / 32), I_G = 16 * 2;
    constexpr int SEG0 = I_IN, SEG1 = SEG0 + I_OUT + I_QKV + I_SQ + I_IN, SEG2 = SEG1 + I_OUT + I_IN + I_OUT, SEG3 = SEG2 + I_LIN + I_SQ + 2 * I_G + I_IN + I_OUT;
#define FFW(f) (ws + W_FF0 + (size_t)(f) * (SZ_WIN + SZ_WOUT))
#define CONVERT_ITEMS(lo_, hi_, wk_, nwk_) do { LAS float* scr = (LAS float*)(lds + wave * 16384); int tl_ = lane_id_(); asm volatile("" : "+v"(tl_)); const int lane = tl_; \
        for (int it = (lo_) + (wk_); it < (hi_); it += (nwk_)) { int r = it; \
            if (r < I_IN) { transpose_item<true>(AIN(2), AIN(1), D, 2 * FF, (bf16*)FFW(0), scr, r, lane); continue; } r -= I_IN; \
            if (r < I_OUT) { transpose_item<false>(AIN(3), nullptr, FF, D, (bf16*)(FFW(0) + SZ_WIN), scr, r, lane); continue; } r -= I_OUT; \
            if (r < I_QKV) { transpose_item<false>(AIN(5), AIN(4), D, 3 * D, (bf16*)(ws + W_QKV), scr, r, lane); continue; } r -= I_QKV; \
            if (r < I_SQ) { transpose_item<false>(AIN(8), nullptr, D, D, (bf16*)(ws + W_O), scr, r, lane); continue; } r -= I_SQ; \
            if (r < I_IN) { transpose_item<true>(AIN(10), AIN(9), D, 2 * FF, (bf16*)FFW(1), scr, r, lane); continue; } r -= I_IN; \
            if (r < I_OUT) { transpose_item<false>(AIN(11), nullptr, FF, D, (bf16*)(FFW(1) + SZ_WIN), scr, r, lane); continue; } r -= I_OUT; \
            if (r < I_IN) { transpose_item<true>(AIN(13), AIN(12), D, 2 * FF, (bf16*)FFW(2), scr, r, lane); continue; } r -= I_IN; \
            if (r < I_OUT) { transpose_item<false>(AIN(14), nullptr, FF, D, (bf16*)(FFW(2) + SZ_WIN), scr, r, lane); continue; } r -= I_OUT; \
            if (r < I_LIN) { transpose_item<false>(AIN(16), AIN(15), D, 2 * D, (bf16*)(ws + W_LIN), scr, r, lane); continue; } r -= I_LIN; \
            if (r < I_SQ) { transpose_item<false>(AIN(24), nullptr, D, D, (bf16*)(ws + W_LO), scr, r, lane); continue; } r -= I_SQ; \
            if (r < I_G) { transpose_item<false>(AIN(19) + (size_t)(r >> 1) * 4096, nullptr, 64, 64, (bf16*)(ws + W_GR) + (size_t)(r >> 1) * 4096, scr, r & 1, lane); continue; } r -= I_G; \
            if (r < I_G) { transpose_item<false>(AIN(21) + (size_t)(r >> 1) * 4096, nullptr, 64, 64, (bf16*)(ws + W_GI) + (size_t)(r >> 1) * 4096, scr, r & 1, lane); continue; } r -= I_G; \
            if (r < I_IN) { transpose_item<true>(AIN(26), AIN(25), D, 2 * FF, (bf16*)FFW(3), scr, r, lane); continue; } r -= I_IN; \
            transpose_item<false>(AIN(27), nullptr, FF, D, (bf16*)(FFW(3) + SZ_WIN), scr, r, lane); } } while (0)
    const int ffn_units = (M / 256) * (2 * FF / 256), ffn_rounds = (ffn_units + G - 1) / G, idle_from = ffn_units - (ffn_rounds - 1) * G;
#define CONVERT_IN_TAIL(lo_, hi_) do { if (idle_from < G) { if (bid >= idle_from) CONVERT_ITEMS(lo_, hi_, (bid - idle_from) * 8 + wave, (G - idle_from) * 8); } \
        else CONVERT_ITEMS(lo_, hi_, gw, ngw); } while (0)
    {
        CONVERT_ITEMS(0, SEG0, gw, ngw);
        cvt_phase(AIN(0), XN, SSQ_AT(0), gw, ngw, lane);
        for (int i = bid * 512 + tid; i < 2 * BATCH * NCH * D; i += G * 512) ((unsigned long long*)(ws + WS_SUM))[i] = 0ull;
    }
#define SEAM() xcd_barrier(xbar, wave)
    if (a.ws == nullptr) grid.sync();
    SEAM();
#define GEMM(EPI, Aptr, Wptr, NN, KK, E) do { pg8::Gemm g{(Aptr), (const bf16*)(Wptr), M, (NN), (KK)}; pg8::StaticOrder S; S.init(M, (NN), G, bid); \
        pg8::gemm_phase<EPI, pg8::StaticOrder, true, true>(lds, g, S, (E), wave); } while (0)
#define FFN(widx, s_in, FIRST, LAST, TLO, THI) do { \
        { pg8::EpiSwiglu E{ACT, FF, SSQ_AT(s_in)}; GEMM(pg8::EpiSwiglu, XN, ws + W_FF0 + (size_t)(widx) * (SZ_WIN + SZ_WOUT), 2 * FF, D, E); } \
        if ((TLO) < (THI)) CONVERT_IN_TAIL(TLO, THI); \
        SEAM(); \
        { typedef pg8::EpiResid<FIRST, LAST, true> EpiR; EpiR E{AIN(0), ((float*)AIN(28)), XN, SSQ_AT((s_in) + 1)}; GEMM(EpiR, ACT, ws + W_FF0 + (size_t)(widx) * (SZ_WIN + SZ_WOUT) + SZ_WIN, D, FF, E); } \
        } while (0)

    FFN(0, 0, true, false, SEG0, SEG1);
    SEAM();
    { pg8::EpiSplit<99> E{ACT, (size_t)M * D, SSQ_AT(1)}; GEMM(pg8::EpiSplit<99>, XN, ws + W_QKV, 3 * D, D, E); }
    SEAM();
    { const int vcu = (G % 8 == 0) ? (bid % 8) * (G / 8) + bid / 8 : bid;
      attn_phase2(lds, QB, KB, VB, QB, AIN(6), AIN(7), vcu * 8 + wave, ngw, wave); }
    SEAM();
    { typedef pg8::EpiResid<false, false, false> EpiR; EpiR E{AIN(0), ((float*)AIN(28)), XN, SSQ_AT(2)}; GEMM(EpiR, QB, ws + W_O, D, D, E); }
    SEAM();
    FFN(1, 2, false, false, SEG1, SEG2);
    SEAM();
    FFN(2, 3, false, false, SEG2, SEG3);
    SEAM();
    { pg8::EpiSplit<1> E{ACT, (size_t)M * D, SSQ_AT(4)}; GEMM(pg8::EpiSplit<1>, XN, ws + W_LIN, 2 * D, D, E); }
    SEAM();
    lru_phase(lds, QB, KB, VB, (const bf16*)(ws + W_GR), (const bf16*)(ws + W_GI), AIN(17), AIN(18), AIN(20), AIN(22), AIN(23), (unsigned long long*)(ws + WS_SUM), G, bid, wave);
    SEAM();
    { typedef pg8::EpiResid<false, false, false> EpiR; EpiR E{AIN(0), ((float*)AIN(28)), XN, SSQ_AT(5)}; GEMM(EpiR, VB, ws + W_LO, D, D, E); }
    SEAM();
    FFN(3, 5, false, true, 0, 0);
}

extern "C" void kernel_launch(void* const* d_in, const int* in_sizes, int n_in, void* d_out, int out_size, void* d_ws, size_t ws_size, hipStream_t stream) {
    static int grid = 0;
    if (grid == 0) {
        if (n_in != 28 || out_size != M * D || ws_size < WS_END) { fprintf(stderr, "kernel_launch: unexpected problem (n_in %d out %d ws %zu)\n", n_in, out_size, ws_size); grid = -1; return; }
        int dev = 0, cus = 0, per_cu = 0;
        hipGetDevice(&dev); hipDeviceGetAttribute(&cus, hipDeviceAttributeMultiprocessorCount, dev);
        if (hipFuncSetAttribute((const void*)fwd_megakernel, hipFuncAttributeMaxDynamicSharedMemorySize, LDS_BYTES) != hipSuccess) { fprintf(stderr, "kernel_launch: hipFuncSetAttribute failed\n"); grid = -1; return; }
        if (hipOccupancyMaxActiveBlocksPerMultiprocessor(&per_cu, (const void*)fwd_megakernel, 512, LDS_BYTES) != hipSuccess || per_cu < 1) { fprintf(stderr, "kernel_launch: occupancy query says %d\n", per_cu); per_cu = 1; }
        (void)hipGetLastError();
        grid = cus * per_cu;
    }
    if (grid < 0) return;
    if (hipMemsetAsync((char*)d_ws + WS_CTL, 0, CTL_ZERO_BYTES, stream) != hipSuccess) { fprintf(stderr, "memset failed\n"); return; }
    Args a{};
    for (int i = 0; i < 28; ++i) a.in[i] = (const float*)d_in[i];
    a.out = (float*)d_out; a.ws = (unsigned char*)d_ws;
    void* args[] = {&a};
    hipError_t e = hipLaunchCooperativeKernel((const void*)fwd_megakernel, dim3(grid), dim3(512), args, LDS_BYTES, stream);
    if (e != hipSuccess) fprintf(stderr, "cooperative launch failed: %s (grid %d)\n", hipGetErrorString(e), grid);
}
```

```cpp
#include <hip/hip_runtime.h>
#include <hip/hip_cooperative_groups.h>
#include <cstdio>
#include <cstdint>
namespace cg = cooperative_groups;
__device__ __forceinline__ int lane_id_() { int l; asm volatile("v_mbcnt_lo_u32_b32 %0, -1, 0\n\tv_mbcnt_hi_u32_b32 %0, -1, %0" : "=v"(l)); return l; }
namespace pg8 {
#define PG8_LAS __attribute__((address_space(3)))
typedef unsigned short bf16_t;
typedef short bf16x8 __attribute__((ext_vector_type(8)));
typedef float f32x4 __attribute__((ext_vector_type(4)));
typedef unsigned u32x4 __attribute__((ext_vector_type(4)));
constexpr int BM = 256, BK = 64, HALF = 128, HTB = HALF * BK * 2  , STAGE_BYTES = 8 * HTB, NXCD = 8, WGM = 8;

__host__ __device__ __forceinline__ int lds_byte(int r, int c) { const int st = (r >> 4) * 2 + (c >> 5), rr = r & 15, cc = c & 31, ob = rr * 64 + cc * 2; return st * 1024 + (ob ^ (((ob >> 9) & 1) << 5)); }
__host__ __device__ __forceinline__ void stage_rc(int b, int& R, int& C) { const int st = b / 1024, sb = b % 1024, swz = sb ^ (((sb >> 9) & 1) << 5); R = (st >> 1) * 16 + swz / 64; C = (st & 1) * 32 + (swz % 64) / 2; }
__host__ __device__ __forceinline__ int perm32(int rho) { const int n = rho >> 4, i = rho & 15; return 8 * (i >> 2) + 4 * n + (i & 3); }

struct Unit { int pm, pn; };
struct Gemm { const bf16_t* A; const bf16_t* Bt; int M, N, K; };

struct StaticOrder {
    int nM, nN, nwg, G, c;
    __host__ __device__ void init(int M, int N, int G_, int c_) { nM = M / BM; nN = N / BM; nwg = nM * nN; G = G_; c = c_; }
    __host__ __device__ bool next(int i, Unit& u) const {
        const long L = (long)i * G + c; if (L >= nwg) return false;
        int wgid = (int)L; { const int q = nwg / NXCD, r = nwg % NXCD, xcd = wgid % NXCD, off = wgid / NXCD; wgid = (xcd < r ? xcd * (q + 1) : r * (q + 1) + (xcd - r) * q) + off; }
        const int nig = WGM * nN, gid = wgid / nig, fm = gid * WGM, gsz = (nM - fm) < WGM ? (nM - fm) : WGM;
        u.pm = fm + ((wgid % nig) % gsz); u.pn = (wgid % nig) / gsz; return true;
    }
    __device__ __forceinline__ void a_ready(const Unit&) const {}
    __device__ __forceinline__ void done(const Unit&) const {}
};

__device__ __forceinline__ unsigned cvt_pk_bf16(float lo, float hi) { unsigned r; asm volatile("v_cvt_pk_bf16_f32 %0, %1, %2" : "=v"(r) : "v"(lo), "v"(hi)); return r; }
typedef float f32x2 __attribute__((ext_vector_type(2)));
__device__ __forceinline__ unsigned pk_bf16(float lo, float hi) { typedef __bf16 b2_t __attribute__((ext_vector_type(2))); f32x2 v = {lo, hi}; b2_t b = __builtin_convertvector(v, b2_t); return __builtin_bit_cast(unsigned, b); }
__device__ __forceinline__ float fast_sigmoid(float v) { return __builtin_amdgcn_rcpf(1.0f + __builtin_amdgcn_exp2f(-1.44269504089f * v)); }
struct EpiSwiglu {
    static constexpr bool PERM = true, AFTER_DRAIN = false; static constexpr int NSTORES = 8;
    bf16_t* H; int ldh; const float* ssq;
    __device__ __forceinline__ void operator()(const f32x4 (&acc)[2][2][4][2], const Unit& u, int wr, int wc, int fr, int fq) const {
        const int row0 = u.pm * BM + wr * 64 + fr, col0 = u.pn * HALF + wc * 32 + 8 * fq;
#pragma unroll
        for (int ai = 0; ai < 2; ++ai)
#pragma unroll
            for (int m = 0; m < 4; ++m) {
                bf16_t* p = H + (size_t)(row0 + ai * HALF + m * 16) * ldh + col0;
                const float rstd = __builtin_amdgcn_rsqf(ssq[row0 + ai * HALF + m * 16] * (1.0f / 1024.0f) + 1e-6f);
                float h[8];
#pragma unroll
                for (int n = 0; n < 2; ++n)
#pragma unroll
                    for (int j = 0; j < 4; ++j) { const float g = acc[ai][0][m][n][j] * rstd, up = acc[ai][1][m][n][j] * rstd; h[4 * n + j] = g * fast_sigmoid(g) * up; }
                u32x4 w; w.x = pk_bf16(h[0], h[1]); w.y = pk_bf16(h[2], h[3]); w.z = pk_bf16(h[4], h[5]); w.w = pk_bf16(h[6], h[7]);
                *(u32x4*)p = w;
            }
    }
};
template <bool FIRST, bool LAST, bool HALF_ALPHA> struct EpiResid {
    static constexpr bool PERM = true, AFTER_DRAIN = false; static constexpr int NSTORES = 0;
    const float* base32; float* out32; bf16_t* xn; float* ssq;
    __device__ __forceinline__ void operator()(const f32x4 (&acc)[2][2][4][2], const Unit& u, int wr, int wc, int fr, int fq) const {
        const int row0 = u.pm * BM + wr * 64 + fr, col0 = u.pn * BM + wc * 32 + 8 * fq;
        constexpr float alpha = HALF_ALPHA ? 0.5f : 1.0f;
#pragma unroll
        for (int ai = 0; ai < 2; ++ai)
#pragma unroll
            for (int m = 0; m < 4; ++m) {
                float s = 0.f;
#pragma unroll
                for (int bj = 0; bj < 2; ++bj) {
                    const size_t off = (size_t)(row0 + ai * HALF + m * 16) * 1024 + col0 + bj * HALF;
                    f32x4 b0, b1;
                    if (FIRST) { b0 = *(const f32x4*)(base32 + off); b1 = *(const f32x4*)(base32 + off + 4); }
                    else { const u32x4 r = *(const u32x4*)(xn + off);
                        b0 = (f32x4){__uint_as_float(r.x << 16), __uint_as_float(r.x & 0xffff0000u), __uint_as_float(r.y << 16), __uint_as_float(r.y & 0xffff0000u)};
                        b1 = (f32x4){__uint_as_float(r.z << 16), __uint_as_float(r.z & 0xffff0000u), __uint_as_float(r.w << 16), __uint_as_float(r.w & 0xffff0000u)}; }
                    const f32x4 v0 = b0 + alpha * acc[ai][bj][m][0], v1 = b1 + alpha * acc[ai][bj][m][1];
                    if (LAST) { *(f32x4*)(out32 + off) = v0; *(f32x4*)(out32 + off + 4) = v1; }
                    else {
                        u32x4 w; w.x = pk_bf16(v0[0], v0[1]); w.y = pk_bf16(v0[2], v0[3]); w.z = pk_bf16(v1[0], v1[1]); w.w = pk_bf16(v1[2], v1[3]);
                        *(u32x4*)(xn + off) = w;
                        const float r0 = __uint_as_float(w.x << 16), r1 = __uint_as_float(w.x & 0xffff0000u), r2 = __uint_as_float(w.y << 16), r3 = __uint_as_float(w.y & 0xffff0000u);
                        const float r4 = __uint_as_float(w.z << 16), r5 = __uint_as_float(w.z & 0xffff0000u), r6 = __uint_as_float(w.w << 16), r7 = __uint_as_float(w.w & 0xffff0000u);
                        s += (r0 * r0 + r1 * r1) + (r2 * r2 + r3 * r3) + (r4 * r4 + r5 * r5) + (r6 * r6 + r7 * r7);
                    }
                }
                if (!LAST) { s += __shfl_xor(s, 16); s += __shfl_xor(s, 32); if (fq == 0) __hip_atomic_fetch_add(ssq + row0 + ai * HALF + m * 16, s, __ATOMIC_RELAXED, __HIP_MEMORY_SCOPE_AGENT); }
            }
    }
};
template <int GELU_FROM> struct EpiSplit {
    static constexpr bool PERM = true, AFTER_DRAIN = false; static constexpr int NSTORES = 16;
    bf16_t* O; size_t split_stride; const float* ssq;
    __device__ __forceinline__ void operator()(const f32x4 (&acc)[2][2][4][2], const Unit& u, int wr, int wc, int fr, int fq) const {
        const int t = u.pn >> 2; bf16_t* basep = O + (size_t)t * split_stride;
        const int row0 = u.pm * BM + wr * 64 + fr, col0 = (u.pn & 3) * BM + wc * 32 + 8 * fq;
        const bool act = t >= GELU_FROM;
#pragma unroll
        for (int ai = 0; ai < 2; ++ai)
#pragma unroll
            for (int m = 0; m < 4; ++m) {
                const float rstd = __builtin_amdgcn_rsqf(ssq[row0 + ai * HALF + m * 16] * (1.0f / 1024.0f) + 1e-6f);
#pragma unroll
                for (int bj = 0; bj < 2; ++bj) {
                    float h[8];
#pragma unroll
                    for (int n = 0; n < 2; ++n)
#pragma unroll
                        for (int j = 0; j < 4; ++j) { float v = acc[ai][bj][m][n][j] * rstd;
                            if (act) { const float z = 1.5957691216f * (v + 0.044715f * v * v * v); v = v * fast_sigmoid(z); }
                            h[4 * n + j] = v; }
                    u32x4 w; w.x = pk_bf16(h[0], h[1]); w.y = pk_bf16(h[2], h[3]); w.z = pk_bf16(h[4], h[5]); w.w = pk_bf16(h[6], h[7]);
                    *(u32x4*)(basep + (size_t)(row0 + ai * HALF + m * 16) * 1024 + col0 + bj * HALF) = w;
                }
            }
    }
};
template <class Epi, class Sched, bool ALIGN_EPI = false, bool SP2 = false>
__device__ __forceinline__ void gemm_phase(PG8_LAS unsigned char* lds, const Gemm g, const Sched& S, const Epi& E, int wave_s) {
    int tid = wave_s * 64 + lane_id_(); asm volatile("" : "+v"(tid));
    const int wid = __builtin_amdgcn_readfirstlane(tid >> 6), lane = tid & 63, wr = wid >> 2, wc = wid & 3, fr = lane & 15, fq = lane >> 4;
    const int K = g.K, nt = K / BK;
    unsigned voffA[2], voffB[2];
#pragma unroll
    for (int i = 0; i < 2; ++i) { int R, C; stage_rc(tid * 16 + i * 8192, R, C); const int Rb = Epi::PERM ? ((R & ~31) + perm32(R & 31)) : R;
        voffA[i] = (unsigned)(R * K + C) * 2u; voffB[i] = (unsigned)(Rb * K + C) * 2u; }
    const size_t kstep = (size_t)(BK * 2);
    const size_t hstep = (size_t)HALF * K * 2;
    const size_t tstep = 2 * hstep;
    const unsigned ldsw = (unsigned)wid * 1024u;
    const int aoff = lds_byte(wr * 64 + fr, fq * 8), boff = lds_byte(wc * 32 + fr, fq * 8);
#define PG8_SA(b, h) (((b) * 2 + (h)) * HTB)
#define PG8_SB(b, h) ((4 + (b) * 2 + (h)) * HTB)
#define PG8_STAGE(bufoff, gbase, voff) do { _Pragma("unroll") for (int _i = 0; _i < 2; ++_i) \
        __builtin_amdgcn_global_load_lds((const unsigned*)((const char*)(gbase) + (voff)[_i]), (PG8_LAS unsigned*)(lds + (bufoff) + ldsw + _i * 8192), 16, 0, 0); } while (0)
#define PG8_LDA(dst, b, h) do { _Pragma("unroll") for (int m = 0; m < 4; ++m) _Pragma("unroll") for (int k = 0; k < 2; ++k) dst[m][k] = *(const PG8_LAS bf16x8*)(lds + PG8_SA(b, h) + aoff + m * 2048 + k * 1024); } while (0)
#define PG8_LDB(dst, b, h) do { _Pragma("unroll") for (int n = 0; n < 2; ++n) _Pragma("unroll") for (int k = 0; k < 2; ++k) dst[n][k] = *(const PG8_LAS bf16x8*)(lds + PG8_SB(b, h) + boff + n * 2048 + k * 1024); } while (0)
#define PG8_MMA(ai, bj, At, Bt) do { __builtin_amdgcn_s_setprio(1); _Pragma("unroll") for (int m = 0; m < 4; ++m) _Pragma("unroll") for (int n = 0; n < 2; ++n) _Pragma("unroll") for (int k = 0; k < 2; ++k) \
        acc[ai][bj][m][n] = __builtin_amdgcn_mfma_f32_16x16x32_bf16(Bt[n][k], At[m][k], acc[ai][bj][m][n], 0, 0, 0); __builtin_amdgcn_s_setprio(0); } while (0)
#define PG8_WAIT_V(n) asm volatile("s_waitcnt vmcnt(" #n ")" ::: "memory")
#define PG8_WAIT_L(n) asm volatile("s_waitcnt lgkmcnt(" #n ")" ::: "memory")
#define PG8_WAIT_V8_STRICT() asm volatile("s_waitcnt vmcnt(8)" ::: "memory")
#define PG8_WAIT_V8_RELAX() do { if constexpr (Epi::NSTORES == 8) asm volatile("s_waitcnt vmcnt(16)" ::: "memory"); else if constexpr (Epi::NSTORES == 16) asm volatile("s_waitcnt vmcnt(24)" ::: "memory"); else asm volatile("s_waitcnt vmcnt(8)" ::: "memory"); } while (0)
#define PG8_BAR __builtin_amdgcn_s_barrier()
#define PG8_SCHED __builtin_amdgcn_sched_barrier(0)
#define PG8_SP2_PAIR(WAITM) do { \
            PG8_LDB(B0, 0, 0); PG8_LDB(B1, 0, 1); PG8_SCHED; PG8_LDA(At, 0, 0); PG8_STAGE(PG8_SA(1, 1), a1 + hstep, voffA); \
            WAITM(); PG8_WAIT_L(0); PG8_BAR; PG8_MMA(0, 0, At, B0); PG8_MMA(0, 1, At, B1); PG8_BAR; PG8_SCHED; \
            PG8_LDA(At, 0, 1); PG8_STAGE(PG8_SB(0, 0), b2, voffB); PG8_STAGE(PG8_SB(0, 1), b2 + hstep, voffB); PG8_STAGE(PG8_SA(0, 0), a2, voffA); \
            WAITM(); PG8_WAIT_L(0); PG8_BAR; PG8_MMA(1, 0, At, B0); PG8_MMA(1, 1, At, B1); PG8_BAR; PG8_SCHED; \
            PG8_LDB(B0, 1, 0); PG8_LDB(B1, 1, 1); PG8_SCHED; PG8_LDA(At, 1, 0); PG8_STAGE(PG8_SA(0, 1), a2 + hstep, voffA); \
            WAITM(); PG8_WAIT_L(0); PG8_BAR; PG8_MMA(0, 0, At, B0); PG8_MMA(0, 1, At, B1); PG8_BAR; PG8_SCHED; \
            PG8_LDA(At, 1, 1); PG8_STAGE(PG8_SB(1, 0), b3, voffB); PG8_STAGE(PG8_SB(1, 1), b3 + hstep, voffB); PG8_STAGE(PG8_SA(1, 0), a3, voffA); \
            WAITM(); PG8_WAIT_L(0); PG8_BAR; PG8_MMA(1, 0, At, B0); PG8_MMA(1, 1, At, B1); PG8_BAR; PG8_SCHED; \
            } while (0)
    Unit cur, nxt; int ui = 0; bool peeled = false;
    if (!S.next(0, cur)) return;
    f32x4 acc[2][2][4][2];
#pragma unroll
    for (int a = 0; a < 2; ++a)
#pragma unroll
        for (int b = 0; b < 2; ++b)
#pragma unroll
            for (int m = 0; m < 4; ++m)
#pragma unroll
                for (int n = 0; n < 2; ++n) acc[a][b][m][n] = (f32x4){0.f, 0.f, 0.f, 0.f};
    bf16x8 At[4][2], B0[2][2], B1[2][2];
    const char* cA = (const char*)g.A + (size_t)cur.pm * tstep; const char* cB = (const char*)g.Bt + (size_t)cur.pn * tstep;
    S.a_ready(cur);
    if constexpr (SP2) {
        PG8_STAGE(PG8_SB(0, 0), cB, voffB); PG8_STAGE(PG8_SB(0, 1), cB + hstep, voffB); PG8_STAGE(PG8_SA(0, 0), cA, voffA); PG8_STAGE(PG8_SA(0, 1), cA + hstep, voffA);
        if (wr == 1) PG8_BAR;
        PG8_WAIT_V(2); PG8_BAR;
        PG8_STAGE(PG8_SB(1, 0), cB + kstep, voffB); PG8_STAGE(PG8_SA(1, 0), cA + kstep, voffA); PG8_STAGE(PG8_SB(1, 1), cB + hstep + kstep, voffB);
        PG8_WAIT_V(6); PG8_BAR;
    } else {
        PG8_STAGE(PG8_SB(0, 0), cB, voffB); PG8_STAGE(PG8_SA(0, 0), cA, voffA); PG8_STAGE(PG8_SB(0, 1), cB + hstep, voffB); PG8_STAGE(PG8_SA(0, 1), cA + hstep, voffA);
        if (wr == 1) PG8_BAR;
        PG8_WAIT_V(4); PG8_BAR;
        PG8_STAGE(PG8_SB(1, 0), cB + kstep, voffB); PG8_STAGE(PG8_SA(1, 0), cA + kstep, voffA); PG8_STAGE(PG8_SB(1, 1), cB + hstep + kstep, voffB);
        PG8_WAIT_V(6); PG8_BAR;
    }
    for (;;) {
        const bool has_next = S.next(ui + 1, nxt);
        const char* nA = has_next ? (const char*)g.A + (size_t)nxt.pm * tstep : cA; const char* nB = has_next ? (const char*)g.Bt + (size_t)nxt.pn * tstep : cB;
        for (int t = peeled ? 2 : 0; t < nt; t += 2) {
            const bool last = (t == nt - 2);
            const char* a1 = cA + (size_t)(t + 1) * kstep;
            const char* a2 = last ? nA : cA + (size_t)(t + 2) * kstep; const char* b2 = last ? nB : cB + (size_t)(t + 2) * kstep;
            const char* a3 = a2 + kstep; const char* b3 = b2 + kstep;
            if (last && has_next) S.a_ready(nxt);
            if constexpr (SP2) {
            PG8_SP2_PAIR(PG8_WAIT_V8_STRICT);
            } else {
            PG8_LDB(B0, 0, 0); PG8_SCHED; PG8_LDA(At, 0, 0); PG8_STAGE(PG8_SA(1, 1), a1 + hstep, voffA);
            PG8_WAIT_L(8); PG8_BAR; PG8_WAIT_L(0); PG8_MMA(0, 0, At, B0); PG8_BAR; PG8_SCHED;
            PG8_LDB(B1, 0, 1); PG8_STAGE(PG8_SB(0, 0), b2, voffB);
            PG8_BAR; PG8_WAIT_L(0); PG8_MMA(0, 1, At, B1); PG8_BAR;
            PG8_LDA(At, 0, 1); PG8_STAGE(PG8_SA(0, 0), a2, voffA);
            PG8_BAR; PG8_WAIT_L(0); PG8_MMA(1, 0, At, B0); PG8_BAR; PG8_SCHED;
            PG8_STAGE(PG8_SB(0, 1), b2 + hstep, voffB);
            PG8_WAIT_V(6); PG8_BAR; PG8_MMA(1, 1, At, B1); PG8_BAR;
            PG8_LDB(B0, 1, 0); PG8_SCHED; PG8_LDA(At, 1, 0); PG8_STAGE(PG8_SA(0, 1), a2 + hstep, voffA);
            PG8_WAIT_L(8); PG8_BAR; PG8_WAIT_L(0); PG8_MMA(0, 0, At, B0); PG8_BAR; PG8_SCHED;
            PG8_LDB(B1, 1, 1); PG8_STAGE(PG8_SB(1, 0), b3, voffB);
            PG8_BAR; PG8_WAIT_L(0); PG8_MMA(0, 1, At, B1); PG8_BAR;
            PG8_LDA(At, 1, 1); PG8_STAGE(PG8_SA(1, 0), a3, voffA);
            PG8_BAR; PG8_WAIT_L(0); PG8_MMA(1, 0, At, B0); PG8_BAR; PG8_SCHED;
            PG8_STAGE(PG8_SB(1, 1), b3 + hstep, voffB);
            PG8_WAIT_V(6); PG8_BAR; PG8_MMA(1, 1, At, B1); PG8_BAR;
            }
        }
        if constexpr (ALIGN_EPI) { if (wr == 0) PG8_BAR; }
        if constexpr (!Epi::AFTER_DRAIN) { E(acc, cur, wr, wc, fr, fq); S.done(cur); }
        if (!has_next) break;
#pragma unroll
        for (int a = 0; a < 2; ++a)
#pragma unroll
            for (int b = 0; b < 2; ++b)
#pragma unroll
                for (int m = 0; m < 4; ++m)
#pragma unroll
                    for (int n = 0; n < 2; ++n) acc[a][b][m][n] = (f32x4){0.f, 0.f, 0.f, 0.f};
        cur = nxt; cA = nA; cB = nB; ++ui;
        if constexpr (ALIGN_EPI) { if (wr == 1) PG8_BAR; }
        if constexpr (SP2 && Epi::NSTORES > 0 && !Epi::AFTER_DRAIN) {
            const char* a1 = cA + kstep; const char* a2 = cA + 2 * kstep; const char* b2 = cB + 2 * kstep; const char* a3 = a2 + kstep; const char* b3 = b2 + kstep;
            PG8_SP2_PAIR(PG8_WAIT_V8_RELAX);
            peeled = true;
        }
    }
    PG8_WAIT_V(0);
    if constexpr (!ALIGN_EPI) { if (wr == 0) PG8_BAR; }
    PG8_BAR;
    if constexpr (Epi::AFTER_DRAIN) { E.fused(acc, cur, wr, wc, fr, fq, lds, wid, lane); S.done(cur); }
#undef PG8_SA
#undef PG8_SB
#undef PG8_STAGE
#undef PG8_LDA
#undef PG8_LDB
#undef PG8_MMA
#undef PG8_WAIT_V
#undef PG8_WAIT_L
#undef PG8_SP2_PAIR
#undef PG8_BAR
#undef PG8_SCHED
}
}
constexpr int BATCH = 8, SEQ = 2048, D = 1024, M = BATCH * SEQ, FF = 2816, NH = 16, HD = 64;
constexpr float EPS = 1e-6f;
constexpr size_t MiB = 1u << 20;
constexpr size_t WS_CTL = 0, WS_SSQ = 65536, CTL_ZERO_BYTES = 65536 + 6 * 65536;
constexpr size_t WS_SUM = 1 * MiB;
constexpr size_t WS_W = 3 * MiB;
constexpr size_t SZ_WIN = (size_t)2 * FF * D * 2, SZ_WOUT = (size_t)D * FF * 2;
constexpr size_t W_FF0 = WS_W, W_FF1 = W_FF0 + SZ_WIN + SZ_WOUT, W_FF2 = W_FF1 + SZ_WIN + SZ_WOUT, W_FF3 = W_FF2 + SZ_WIN + SZ_WOUT;
constexpr size_t W_QKV = W_FF3 + SZ_WIN + SZ_WOUT, W_O = W_QKV + (size_t)3 * D * D * 2, W_LIN = W_O + (size_t)D * D * 2, W_LO = W_LIN + (size_t)2 * D * D * 2;
constexpr size_t W_GR = W_LO + (size_t)D * D * 2, W_GI = W_GR + 16 * 64 * 64 * 2, W_END = W_GI + 16 * 64 * 64 * 2;
constexpr size_t WS_XN = 84 * MiB;
constexpr size_t WS_ACT = 116 * MiB;
constexpr size_t WS_END = WS_ACT + 96 * MiB;
static_assert(W_END <= WS_XN && WS_XN + (size_t)M * D * 2 <= WS_ACT && WS_END <= 256 * MiB && (size_t)M * FF * 2 <= 96 * MiB, "d_ws map");
constexpr int LDS_BYTES = 147456;

#define LAS __attribute__((address_space(3)))
typedef unsigned short bf16;
typedef unsigned v4u __attribute__((ext_vector_type(4)));
typedef unsigned v2u __attribute__((ext_vector_type(2)));
typedef float f32x4 __attribute__((ext_vector_type(4)));
typedef float f32x16 __attribute__((ext_vector_type(16)));
typedef short bf16x8 __attribute__((ext_vector_type(8)));
using pg8::pk_bf16;
__device__ __forceinline__ float bf_lo(unsigned u) { return __uint_as_float(u << 16); }
__device__ __forceinline__ float bf_hi(unsigned u) { return __uint_as_float(u & 0xffff0000u); }
__device__ __forceinline__ float wave_sum(float v) {
#pragma unroll
    for (int o = 1; o < 64; o <<= 1) v += __shfl_xor(v, o);
    return v;
}
#define LOG2E 1.44269504089f
#define LN2 0.69314718056f

__device__ __forceinline__ void transpose_tile(const float* W, const float* gain, int K, int N, int k0, int n0, bf16* WT, int drow0, LAS float* scr, int lane) {
    f32x4 v[8]; float gv[8];
    const int r0 = lane >> 3, c4 = lane & 7;
#pragma unroll
    for (int i = 0; i < 8; ++i) { v[i] = *(const f32x4*)(W + (size_t)(k0 + r0 + 8 * i) * N + n0 + 4 * c4); gv[i] = gain ? gain[k0 + r0 + 8 * i] : 1.0f; }
#pragma unroll
    for (int i = 0; i < 8; ++i) { LAS float* d = scr + (r0 + 8 * i) * 33 + 4 * c4; d[0] = v[i][0] * gv[i]; d[1] = v[i][1] * gv[i]; d[2] = v[i][2] * gv[i]; d[3] = v[i][3] * gv[i]; }
    asm volatile("s_waitcnt lgkmcnt(0)" ::: "memory");
    const int c = lane & 7;
#pragma unroll
    for (int j = 0; j < 4; ++j) { const int n = (lane >> 3) + 8 * j; const LAS float* s = scr + (8 * c) * 33 + n;
        v4u o; o.x = pk_bf16(s[0 * 33], s[1 * 33]); o.y = pk_bf16(s[2 * 33], s[3 * 33]); o.z = pk_bf16(s[4 * 33], s[5 * 33]); o.w = pk_bf16(s[6 * 33], s[7 * 33]);
        *(v4u*)(WT + (size_t)(drow0 + n) * K + k0 + 8 * c) = o; }
    asm volatile("s_waitcnt lgkmcnt(0)" ::: "memory");
}
template <bool SWIGLU> __device__ __forceinline__ void transpose_item(const float* W, const float* gain, int K, int N, bf16* WT, LAS float* scr, int item, int lane) {
    const int nblk = N / 32, kb = item / nblk, nb = item % nblk, n0 = 32 * nb;
    int drow0 = n0;
    if (SWIGLU) { const int up = n0 >= FF, f = up ? n0 - FF : n0; drow0 = 256 * (f >> 7) + (up ? 128 : 0) + (f & 127); }
    transpose_tile(W, gain, K, N, 64 * kb, n0, WT, drow0, scr, lane);
}

__device__ __forceinline__ void cvt_phase(const float* x, bf16* xn, float* ssq, int gw, int ngw, int lane) {
    for (int m = gw; m < M; m += ngw) {
        const f32x4* xr = (const f32x4*)(x + (size_t)m * D) + lane;
        f32x4 v[4]; float s = 0.f;
#pragma unroll
        for (int j = 0; j < 4; ++j) { v[j] = xr[64 * j]; s += (v[j].x * v[j].x + v[j].y * v[j].y) + (v[j].z * v[j].z + v[j].w * v[j].w); }
        s = wave_sum(s);
        if (lane == 0) ssq[m] = s;
        v2u* o = (v2u*)(xn + (size_t)m * D) + lane;
#pragma unroll
        for (int j = 0; j < 4; ++j) { v2u w; w.x = pk_bf16(v[j].x, v[j].y); w.y = pk_bf16(v[j].z, v[j].w); o[64 * j] = w; }
    }
}

constexpr int KP = 72;
constexpr float SB_EXIT = 40.0f * 1.44269504089f;
typedef short v4i16_t __attribute__((ext_vector_type(4)));
__device__ __forceinline__ v2u vtr(const LAS bf16* p) { return __builtin_bit_cast(v2u, __builtin_amdgcn_ds_read_tr16_b64_v4i16((LAS v4i16_t*)p)); }
__device__ __forceinline__ void attn_phase(LAS unsigned char* lds, const bf16* Q, const bf16* K, const bf16* V, bf16* O, const float* qg, const float* kg, int gw, int ngw, int wave_s) {
    int tid_ = wave_s * 64 + lane_id_(); asm volatile("" : "+v"(tid_));
    const int lane = tid_ & 63, w = __builtin_amdgcn_readfirstlane(tid_ >> 6), hi = lane >> 5, ql = lane & 31;
    LAS bf16* Ks = (LAS bf16*)(lds + w * (64 * KP * 2));
    LAS bf16* Vs = Ks + 32 * KP;
    const int skey = lane >> 3, sch = lane & 7;
    const LAS bf16* vtb = Vs + (4 * hi + ((lane & 15) >> 2)) * KP + 16 * ((lane >> 4) & 1) + 4 * (lane & 3);
    for (int wu = gw; wu < BATCH * NH * 64; wu += ngw) {
        const int qblk = wu & 63, bh = wu >> 6, b = bh >> 4, h = bh & 15;
        const int tq = 32 * qblk + ql;
        bf16x8 qf[4];
        {
            const bf16* qp = Q + (size_t)(b * SEQ + tq) * D + h * HD + 8 * hi;
            float qv[4][8]; float ss = 0.f;
#pragma unroll
            for (int s = 0; s < 4; ++s) { const v4u r = *(const v4u*)(qp + 16 * s);
                qv[s][0] = bf_lo(r.x); qv[s][1] = bf_hi(r.x); qv[s][2] = bf_lo(r.y); qv[s][3] = bf_hi(r.y); qv[s][4] = bf_lo(r.z); qv[s][5] = bf_hi(r.z); qv[s][6] = bf_lo(r.w); qv[s][7] = bf_hi(r.w);
#pragma unroll
                for (int j = 0; j < 8; ++j) ss += qv[s][j] * qv[s][j]; }
            ss += __shfl_xor(ss, 32);
            const float rs = (0.125f * LOG2E) * __builtin_amdgcn_rsqf(ss * (1.f / HD) + EPS);
#pragma unroll
            for (int s = 0; s < 4; ++s) { float gp[8];
#pragma unroll
                for (int j = 0; j < 8; ++j) gp[j] = qg[16 * s + 8 * hi + j] * kg[16 * s + 8 * hi + j];
                v4u p;
                p.x = pk_bf16(qv[s][0] * rs * gp[0], qv[s][1] * rs * gp[1]); p.y = pk_bf16(qv[s][2] * rs * gp[2], qv[s][3] * rs * gp[3]);
                p.z = pk_bf16(qv[s][4] * rs * gp[4], qv[s][5] * rs * gp[5]); p.w = pk_bf16(qv[s][6] * rs * gp[6], qv[s][7] * rs * gp[7]);
                qf[s] = __builtin_bit_cast(bf16x8, p); }
        }
        f32x16 o0, o1;
#pragma unroll
        for (int i = 0; i < 16; ++i) { o0[i] = 0.f; o1[i] = 0.f; }
        float R = 0.f;
        v4u krA[4], vrA[4], krB[4], vrB[4];
        int kb = qblk;
        const bf16* kbase = K + (size_t)(b * SEQ + skey) * D + h * HD + 8 * sch;
        const bf16* vbase = V + (size_t)(b * SEQ + skey) * D + h * HD + 8 * sch;
#define ATT_LOAD(KR, VR, KBL) do { _Pragma("unroll") for (int i = 0; i < 4; ++i) { KR[i] = *(const v4u*)(kbase + (size_t)(32 * (KBL) + 8 * i) * D); VR[i] = *(const v4u*)(vbase + (size_t)(32 * (KBL) + 8 * i) * D); } } while (0)
#define ATT_BLOCK(KR, VR, KBC) do { \
            _Pragma("unroll") for (int i = 0; i < 4; ++i) { \
                float kf[8] = {bf_lo(KR[i].x), bf_hi(KR[i].x), bf_lo(KR[i].y), bf_hi(KR[i].y), bf_lo(KR[i].z), bf_hi(KR[i].z), bf_lo(KR[i].w), bf_hi(KR[i].w)}; \
                float ss = 0.f; \
                _Pragma("unroll") for (int j = 0; j < 8; ++j) ss += kf[j] * kf[j]; \
                ss += __uint_as_float(__builtin_amdgcn_mov_dpp(__float_as_uint(ss), 0xB1, 0xF, 0xF, true)); ss += __uint_as_float(__builtin_amdgcn_mov_dpp(__float_as_uint(ss), 0x4E, 0xF, 0xF, true)); ss += __uint_as_float(__builtin_amdgcn_mov_dpp(__float_as_uint(ss), 0x141, 0xF, 0xF, true)); \
                const float rs = __builtin_amdgcn_rsqf(ss * (1.f / HD) + EPS); \
                v4u p_; p_.x = pk_bf16(kf[0] * rs, kf[1] * rs); p_.y = pk_bf16(kf[2] * rs, kf[3] * rs); \
                p_.z = pk_bf16(kf[4] * rs, kf[5] * rs); p_.w = pk_bf16(kf[6] * rs, kf[7] * rs); \
                *(LAS v4u*)(Ks + (skey + 8 * i) * KP + 8 * sch) = p_; \
                *(LAS v4u*)(Vs + (skey + 8 * i) * KP + 8 * sch) = VR[i]; \
            } \
            if ((KBC) >= 2) ATT_LOAD(KR, VR, (KBC) - 2); \
            f32x16 p; \
            _Pragma("unroll") for (int i = 0; i < 16; ++i) p[i] = 0.f; \
            _Pragma("unroll") for (int s = 0; s < 4; ++s) { const bf16x8 kf = *(const LAS bf16x8*)(Ks + ql * KP + 16 * s + 8 * hi); \
                p = __builtin_amdgcn_mfma_f32_32x32x16_bf16(kf, qf[s], p, 0, 0, 0); } \
            const bool diag = ((KBC) == qblk); \
            { \
                float sp[16], lb[16]; \
                _Pragma("unroll") for (int i = 0; i < 16; ++i) { \
                    const float z = p[i]; \
                    const float e = __builtin_amdgcn_exp2f(-fabsf(z)); \
                    const float l = __builtin_amdgcn_logf(1.0f + e); \
                    const int kl = 8 * (i >> 2) + 4 * hi + (i & 3); \
                    const bool valid = !diag || (kl < ql); \
                    sp[i] = valid ? fmaxf(z, 0.f) + l : 0.f; \
                    lb[i] = valid ? fminf(z, 0.f) - l : -1e30f; \
                } \
                float run = R; \
                _Pragma("unroll") for (int g = 3; g >= 0; --g) { \
                    const float Gm = (sp[4 * g] + sp[4 * g + 1]) + (sp[4 * g + 2] + sp[4 * g + 3]); \
                    const float Go = __shfl_xor(Gm, 32); \
                    const float aft = hi ? run : run + Go; \
                    const float e3 = aft, e2 = e3 + sp[4 * g + 3], e1 = e2 + sp[4 * g + 2], e0 = e1 + sp[4 * g + 1]; \
                    p[4 * g + 3] = __builtin_amdgcn_exp2f(lb[4 * g + 3] - e3); \
                    p[4 * g + 2] = __builtin_amdgcn_exp2f(lb[4 * g + 2] - e2); \
                    p[4 * g + 1] = __builtin_amdgcn_exp2f(lb[4 * g + 1] - e1); \
                    p[4 * g + 0] = __builtin_amdgcn_exp2f(lb[4 * g + 0] - e0); \
                    run += Gm + Go; \
                } \
                R = run; \
            } \
            _Pragma("unroll") for (int s2 = 0; s2 < 2; ++s2) { \
                v4u pa; pa.x = pk_bf16(p[8 * s2 + 0], p[8 * s2 + 1]); pa.y = pk_bf16(p[8 * s2 + 2], p[8 * s2 + 3]); \
                pa.z = pk_bf16(p[8 * s2 + 4], p[8 * s2 + 5]); pa.w = pk_bf16(p[8 * s2 + 6], p[8 * s2 + 7]); \
                const bf16x8 pav = __builtin_bit_cast(bf16x8, pa); \
                const LAS bf16* vp = vtb + (16 * s2) * KP; \
                v4u vb; { const v2u a_ = vtr(vp), c_ = vtr(vp + 8 * KP); vb.x = a_.x; vb.y = a_.y; vb.z = c_.x; vb.w = c_.y; } \
                o0 = __builtin_amdgcn_mfma_f32_32x32x16_bf16(pav, __builtin_bit_cast(bf16x8, vb), o0, 0, 0, 0); \
                { const v2u a_ = vtr(vp + 32), c_ = vtr(vp + 8 * KP + 32); vb.x = a_.x; vb.y = a_.y; vb.z = c_.x; vb.w = c_.y; } \
                o1 = __builtin_amdgcn_mfma_f32_32x32x16_bf16(pav, __builtin_bit_cast(bf16x8, vb), o1, 0, 0, 0); \
            } \
            done = ((KBC) == 0) || (__builtin_amdgcn_ballot_w64(R < SB_EXIT) == 0ull); \
        } while (0)
        ATT_LOAD(krA, vrA, kb);
        if (kb >= 1) ATT_LOAD(krB, vrB, kb - 1);
        for (;;) {
            bool done;
            ATT_BLOCK(krA, vrA, kb);
            if (done) break;
            ATT_BLOCK(krB, vrB, kb - 1);
            if (done) break;
            kb -= 2;
        }
#undef ATT_LOAD
#undef ATT_BLOCK
        {
            LAS bf16* Ot = Ks;
#pragma unroll
            for (int i = 0; i < 16; ++i) { const int r = 8 * (i >> 2) + 4 * hi + (i & 3);
                Ot[r * KP + ql] = (bf16)(pk_bf16(o0[i], 0.f) & 0xffffu); Ot[r * KP + 32 + ql] = (bf16)(pk_bf16(o1[i], 0.f) & 0xffffu); }
            bf16* op = O + (size_t)(b * SEQ + 32 * qblk + skey) * D + h * HD + 8 * sch;
#pragma unroll
            for (int i = 0; i < 4; ++i) *(v4u*)(op + (size_t)(8 * i) * D) = *(const LAS v4u*)(Ot + (skey + 8 * i) * KP + 8 * sch);
        }
    }
}

__device__ __forceinline__ void attn_phase2(LAS unsigned char* lds, const bf16* Q, const bf16* K, const bf16* V, bf16* O, const float* qg, const float* kg, int gw, int ngw, int wave_s) {
    int tid_ = wave_s * 64 + lane_id_(); asm volatile("" : "+v"(tid_));
    const int lane = tid_ & 63, w = __builtin_amdgcn_readfirstlane(tid_ >> 6), hi = lane >> 5, ql = lane & 31;
    LAS bf16* Ks = (LAS bf16*)(lds + w * (64 * KP * 2));
    LAS bf16* Vs = Ks + 32 * KP;
    const int skey = lane >> 3, sch = lane & 7;
    const LAS bf16* vtb = Vs + (4 * hi + ((lane & 15) >> 2)) * KP + 16 * ((lane >> 4) & 1) + 4 * (lane & 3);
    for (int wu = gw; wu < BATCH * NH * 32; wu += ngw) {
        const int pq = wu & 31, bh = wu >> 5, b = bh >> 4, h = bh & 15;
        const int qblk0 = 2 * pq, qblk1 = 2 * pq + 1;
        bf16x8 qfa[4], qfb[4];
#define ATT_LOADQ(QF, QBLK) do { \
            const bf16* qp = Q + (size_t)(b * SEQ + 32 * (QBLK) + ql) * D + h * HD + 8 * hi; \
            float qv[4][8]; float ss = 0.f; \
            _Pragma("unroll") for (int s = 0; s < 4; ++s) { const v4u r = *(const v4u*)(qp + 16 * s); \
                qv[s][0] = bf_lo(r.x); qv[s][1] = bf_hi(r.x); qv[s][2] = bf_lo(r.y); qv[s][3] = bf_hi(r.y); qv[s][4] = bf_lo(r.z); qv[s][5] = bf_hi(r.z); qv[s][6] = bf_lo(r.w); qv[s][7] = bf_hi(r.w); \
                _Pragma("unroll") for (int j = 0; j < 8; ++j) ss += qv[s][j] * qv[s][j]; } \
            ss += __shfl_xor(ss, 32); \
            const float rs = (0.125f * LOG2E) * __builtin_amdgcn_rsqf(ss * (1.f / HD) + EPS); \
            _Pragma("unroll") for (int s = 0; s < 4; ++s) { float gp[8]; \
                _Pragma("unroll") for (int j = 0; j < 8; ++j) gp[j] = qg[16 * s + 8 * hi + j] * kg[16 * s + 8 * hi + j]; \
                v4u p; \
                p.x = pk_bf16(qv[s][0] * rs * gp[0], qv[s][1] * rs * gp[1]); p.y = pk_bf16(qv[s][2] * rs * gp[2], qv[s][3] * rs * gp[3]); \
                p.z = pk_bf16(qv[s][4] * rs * gp[4], qv[s][5] * rs * gp[5]); p.w = pk_bf16(qv[s][6] * rs * gp[6], qv[s][7] * rs * gp[7]); \
                QF[s] = __builtin_bit_cast(bf16x8, p); } } while (0)
        ATT_LOADQ(qfa, qblk0);
        ATT_LOADQ(qfb, qblk1);
        f32x16 oa0, oa1, ob0, ob1;
#pragma unroll
        for (int i = 0; i < 16; ++i) { oa0[i] = 0.f; oa1[i] = 0.f; ob0[i] = 0.f; ob1[i] = 0.f; }
        float Ra = 0.f, Rb = 0.f;
        bool da = false, db = false;
        v4u kr[4], vr[4];
        int kb = qblk1;
        const bf16* kbase = K + (size_t)(b * SEQ + skey) * D + h * HD + 8 * sch;
        const bf16* vbase = V + (size_t)(b * SEQ + skey) * D + h * HD + 8 * sch;
#pragma unroll
        for (int i = 0; i < 4; ++i) { kr[i] = *(const v4u*)(kbase + (size_t)(32 * kb + 8 * i) * D); vr[i] = *(const v4u*)(vbase + (size_t)(32 * kb + 8 * i) * D); }
#define ATT_TILE(QF, O0, O1, RR, DIAG) do { \
            f32x16 p; \
            _Pragma("unroll") for (int i = 0; i < 16; ++i) p[i] = 0.f; \
            _Pragma("unroll") for (int s = 0; s < 4; ++s) { const bf16x8 kf = *(const LAS bf16x8*)(Ks + ql * KP + 16 * s + 8 * hi); \
                p = __builtin_amdgcn_mfma_f32_32x32x16_bf16(kf, QF[s], p, 0, 0, 0); } \
            const bool diag = (DIAG); \
            { \
                float sp[16], lb[16]; \
                _Pragma("unroll") for (int i = 0; i < 16; ++i) { \
                    const float z = p[i]; \
                    const float e = __builtin_amdgcn_exp2f(-fabsf(z)); \
                    const float l = __builtin_amdgcn_logf(1.0f + e); \
                    const int kl = 8 * (i >> 2) + 4 * hi + (i & 3); \
                    const bool valid = !diag || (kl < ql); \
                    sp[i] = valid ? fmaxf(z, 0.f) + l : 0.f; \
                    lb[i] = valid ? fminf(z, 0.f) - l : -1e30f; \
                } \
                float run = RR; \
                _Pragma("unroll") for (int g = 3; g >= 0; --g) { \
                    const float Gm = (sp[4 * g] + sp[4 * g + 1]) + (sp[4 * g + 2] + sp[4 * g + 3]); \
                    const float Go = __shfl_xor(Gm, 32); \
                    const float aft = hi ? run : run + Go; \
                    const float e3 = aft, e2 = e3 + sp[4 * g + 3], e1 = e2 + sp[4 * g + 2], e0 = e1 + sp[4 * g + 1]; \
                    p[4 * g + 3] = __builtin_amdgcn_exp2f(lb[4 * g + 3] - e3); \
                    p[4 * g + 2] = __builtin_amdgcn_exp2f(lb[4 * g + 2] - e2); \
                    p[4 * g + 1] = __builtin_amdgcn_exp2f(lb[4 * g + 1] - e1); \
                    p[4 * g + 0] = __builtin_amdgcn_exp2f(lb[4 * g + 0] - e0); \
                    run += Gm + Go; \
                } \
                RR = run; \
            } \
            _Pragma("unroll") for (int s2 = 0; s2 < 2; ++s2) { \
                v4u pa; pa.x = pk_bf16(p[8 * s2 + 0], p[8 * s2 + 1]); pa.y = pk_bf16(p[8 * s2 + 2], p[8 * s2 + 3]); \
                pa.z = pk_bf16(p[8 * s2 + 4], p[8 * s2 + 5]); pa.w = pk_bf16(p[8 * s2 + 6], p[8 * s2 + 7]); \
                const bf16x8 pav = __builtin_bit_cast(bf16x8, pa); \
                const LAS bf16* vp = vtb + (16 * s2) * KP; \
                v4u vb; { const v2u a_ = vtr(vp), c_ = vtr(vp + 8 * KP); vb.x = a_.x; vb.y = a_.y; vb.z = c_.x; vb.w = c_.y; } \
                O0 = __builtin_amdgcn_mfma_f32_32x32x16_bf16(pav, __builtin_bit_cast(bf16x8, vb), O0, 0, 0, 0); \
                { const v2u a_ = vtr(vp + 32), c_ = vtr(vp + 8 * KP + 32); vb.x = a_.x; vb.y = a_.y; vb.z = c_.x; vb.w = c_.y; } \
                O1 = __builtin_amdgcn_mfma_f32_32x32x16_bf16(pav, __builtin_bit_cast(bf16x8, vb), O1, 0, 0, 0); \
            } \
        } while (0)
        for (;;) {
#pragma unroll
            for (int i = 0; i < 4; ++i) {
                float kf[8] = {bf_lo(kr[i].x), bf_hi(kr[i].x), bf_lo(kr[i].y), bf_hi(kr[i].y), bf_lo(kr[i].z), bf_hi(kr[i].z), bf_lo(kr[i].w), bf_hi(kr[i].w)};
                float ss = 0.f;
#pragma unroll
                for (int j = 0; j < 8; ++j) ss += kf[j] * kf[j];
                ss += __uint_as_float(__builtin_amdgcn_mov_dpp(__float_as_uint(ss), 0xB1, 0xF, 0xF, true)); ss += __uint_as_float(__builtin_amdgcn_mov_dpp(__float_as_uint(ss), 0x4E, 0xF, 0xF, true)); ss += __uint_as_float(__builtin_amdgcn_mov_dpp(__float_as_uint(ss), 0x141, 0xF, 0xF, true));
                const float rs = __builtin_amdgcn_rsqf(ss * (1.f / HD) + EPS);
                v4u p_; p_.x = pk_bf16(kf[0] * rs, kf[1] * rs); p_.y = pk_bf16(kf[2] * rs, kf[3] * rs); p_.z = pk_bf16(kf[4] * rs, kf[5] * rs); p_.w = pk_bf16(kf[6] * rs, kf[7] * rs);
                *(LAS v4u*)(Ks + (skey + 8 * i) * KP + 8 * sch) = p_;
                *(LAS v4u*)(Vs + (skey + 8 * i) * KP + 8 * sch) = vr[i];
            }
            if (kb > 0) {
#pragma unroll
                for (int i = 0; i < 4; ++i) { kr[i] = *(const v4u*)(kbase + (size_t)(32 * (kb - 1) + 8 * i) * D); vr[i] = *(const v4u*)(vbase + (size_t)(32 * (kb - 1) + 8 * i) * D); }
            }
            if (!db) { ATT_TILE(qfb, ob0, ob1, Rb, kb == qblk1); db = (__builtin_amdgcn_ballot_w64(Rb < SB_EXIT) == 0ull); }
            if (kb <= qblk0 && !da) { ATT_TILE(qfa, oa0, oa1, Ra, kb == qblk0); da = (__builtin_amdgcn_ballot_w64(Ra < SB_EXIT) == 0ull); }
            if (kb == 0 || (da && db)) break;
            --kb;
        }
#undef ATT_LOADQ
#undef ATT_TILE
#define ATT_STORE(O0, O1, QBLK) do { \
            LAS bf16* Ot = Ks; \
            _Pragma("unroll") for (int i = 0; i < 16; ++i) { const int r = 8 * (i >> 2) + 4 * hi + (i & 3); \
                Ot[r * KP + ql] = (bf16)(pk_bf16(O0[i], 0.f) & 0xffffu); Ot[r * KP + 32 + ql] = (bf16)(pk_bf16(O1[i], 0.f) & 0xffffu); } \
            bf16* op = O + (size_t)(b * SEQ + 32 * (QBLK) + skey) * D + h * HD + 8 * sch; \
            _Pragma("unroll") for (int i = 0; i < 4; ++i) *(v4u*)(op + (size_t)(8 * i) * D) = *(const LAS v4u*)(Ot + (skey + 8 * i) * KP + 8 * sch); } while (0)
        ATT_STORE(oa0, oa1, qblk0);
        ATT_STORE(ob0, ob1, qblk1);
#undef ATT_STORE
    }
}

constexpr int LT = 128, NCH = SEQ / LT;
#define LDS_BARRIER() do { asm volatile("s_waitcnt lgkmcnt(0)" ::: "memory"); __builtin_amdgcn_s_barrier(); asm volatile("" ::: "memory"); } while (0)
__device__ __forceinline__ void lru_phase(LAS unsigned char* lds, const bf16* XB, const bf16* Y, bf16* HY, const bf16* WRt, const bf16* WIt,
        const float* convw, const float* convb, const float* br, const float* bi, const float* lam, unsigned long long* gran, int G, int bid, int wave_s) {
    int tid = wave_s * 64 + lane_id_(); asm volatile("" : "+v"(tid));
    const int lane = tid & 63, w = __builtin_amdgcn_readfirstlane(tid >> 6), hi = lane >> 5, ql = lane & 31;
    LAS float* xcF = (LAS float*)lds;
    LAS bf16* wL = (LAS bf16*)(lds + 32768);
    LAS bf16* xcB = (LAS bf16*)(lds + 65536);
    LAS float* segA = (LAS float*)(lds + 65536 + 128 * KP * 2);
    LAS float* segH = segA + 512;
    LAS float* pA = segH + 512;
    LAS float* pH = pA + 1024;
    LAS bf16* yL = (LAS bf16*)(lds + 65536 + 128 * KP * 2 + 16384);
    const int st = tid >> 3, cc = 8 * (tid & 7);
    LAS float* parL = (LAS float*)(lds + 118784);
    int n_loaded = -1;
    const int rb = w >> 1, cbk = w & 1, d = 32 * cbk + ql;
    v4u xt[2][4], yv[2];
#define LRU_LOAD_X(u_) do { const int ch_ = (u_) >> 7, bn_ = (u_) & 127, b_ = bn_ >> 4, n_ = bn_ & 15, t0_ = ch_ * LT, c0_ = 64 * n_; \
        _Pragma("unroll") for (int r = 0; r < 2; ++r) { yv[r] = *(const v4u*)(Y + (size_t)(b_ * SEQ + t0_ + st + 64 * r) * D + c0_ + cc); \
            _Pragma("unroll") for (int j = 0; j < 4; ++j) { const int ts = t0_ + st + 64 * r + j - 3; xt[r][j] = ts >= 0 ? *(const v4u*)(XB + (size_t)(b_ * SEQ + ts) * D + c0_ + cc) : (v4u){0u, 0u, 0u, 0u}; } } } while (0)
    if (bid < BATCH * 16 * NCH) LRU_LOAD_X(bid);
    for (int unit = bid; unit < BATCH * 16 * NCH; unit += G) {
        const int ch = unit >> 7, bn = unit & 127, b = bn >> 4, n = bn & 15;
        const int t0 = ch * LT, c0 = 64 * n;
        if (n != n_loaded) {
            LDS_BARRIER();
            if (tid < 256) parL[tid] = convw[(tid >> 6) * D + c0 + (tid & 63)];
            else if (tid < 320) parL[tid] = convb[c0 + tid - 256];
            else if (tid < 384) parL[tid] = br[c0 + tid - 320];
            else if (tid < 448) parL[tid] = bi[c0 + tid - 384];
            else { const float lm = lam[c0 + tid - 448]; parL[tid] = -8.0f * (fmaxf(-lm, 0.f) + __builtin_amdgcn_logf(1.0f + __builtin_amdgcn_exp2f(-fabsf(lm) * LOG2E)) * LN2); }
#pragma unroll
            for (int r = 0; r < 2; ++r) { const int e = tid + 512 * r, gate = e >> 9, row = (e >> 3) & 63, chk = e & 7;
                *(LAS v4u*)(wL + (gate * 64 + row) * KP + 8 * chk) = *(const v4u*)((gate ? WIt : WRt) + (size_t)n * 4096 + row * 64 + 8 * chk); }
            n_loaded = n;
        }
        LDS_BARRIER();
        {
            float cw[4][8], cb[8];
#pragma unroll
            for (int j = 0; j < 4; ++j) { const f32x4 c0v = *(const LAS f32x4*)(parL + j * 64 + cc), c1v = *(const LAS f32x4*)(parL + j * 64 + cc + 4);
                cw[j][0] = c0v[0]; cw[j][1] = c0v[1]; cw[j][2] = c0v[2]; cw[j][3] = c0v[3]; cw[j][4] = c1v[0]; cw[j][5] = c1v[1]; cw[j][6] = c1v[2]; cw[j][7] = c1v[3]; }
            { const f32x4 c0v = *(const LAS f32x4*)(parL + 256 + cc), c1v = *(const LAS f32x4*)(parL + 256 + cc + 4);
                cb[0] = c0v[0]; cb[1] = c0v[1]; cb[2] = c0v[2]; cb[3] = c0v[3]; cb[4] = c1v[0]; cb[5] = c1v[1]; cb[6] = c1v[2]; cb[7] = c1v[3]; }
#pragma unroll
            for (int r = 0; r < 2; ++r) {
                const int t = st + 64 * r;
                float acc[8];
#pragma unroll
                for (int e = 0; e < 8; ++e) acc[e] = cb[e];
#pragma unroll
                for (int j = 0; j < 4; ++j) {
                    const v4u x = xt[r][j];
                    acc[0] += cw[j][0] * bf_lo(x.x); acc[1] += cw[j][1] * bf_hi(x.x); acc[2] += cw[j][2] * bf_lo(x.y); acc[3] += cw[j][3] * bf_hi(x.y);
                    acc[4] += cw[j][4] * bf_lo(x.z); acc[5] += cw[j][5] * bf_hi(x.z); acc[6] += cw[j][6] * bf_lo(x.w); acc[7] += cw[j][7] * bf_hi(x.w);
                }
                *(LAS f32x4*)(xcF + t * 64 + cc) = (f32x4){acc[0], acc[1], acc[2], acc[3]}; *(LAS f32x4*)(xcF + t * 64 + cc + 4) = (f32x4){acc[4], acc[5], acc[6], acc[7]};
                v4u p; p.x = pk_bf16(acc[0], acc[1]); p.y = pk_bf16(acc[2], acc[3]); p.z = pk_bf16(acc[4], acc[5]); p.w = pk_bf16(acc[6], acc[7]);
                *(LAS v4u*)(xcB + t * KP + cc) = p;
                *(LAS v4u*)(yL + t * KP + cc) = yv[r];
            }
        }
        if (unit + G < BATCH * 16 * NCH) LRU_LOAD_X(unit + G);
        LDS_BARRIER();
        unsigned xa[2] = {0u, 0u}, xh[2] = {0u, 0u}, xt_[2] = {0u, 0u};
#pragma unroll
        for (int q = 0; q < 2; ++q) { const int kk = w + 8 * q;
            if (kk < ch) { const unsigned long long* g = gran + ((size_t)(b * NCH + kk) * D + c0 + lane) * 2;
                const unsigned long long ya = __hip_atomic_load(g, __ATOMIC_RELAXED, __HIP_MEMORY_SCOPE_AGENT), yh = __hip_atomic_load(g + 1, __ATOMIC_RELAXED, __HIP_MEMORY_SCOPE_AGENT);
                xa[q] = (unsigned)ya; xh[q] = (unsigned)yh; xt_[q] = (unsigned)(ya >> 32) & (unsigned)(yh >> 32); } }
        float av[16], uv[16];
        const int c = lane, sg = 2 * rb + hi, tb = 32 * rb + 16 * hi;
        {
            f32x16 pr, pi;
#pragma unroll
            for (int i = 0; i < 16; ++i) { pr[i] = 0.f; pi[i] = 0.f; }
            const int trow = 32 * rb + 16 * ((ql >> 2) & 1) + 4 * (ql >> 3) + (ql & 3);
#pragma unroll
            for (int s = 0; s < 4; ++s) {
                const bf16x8 af = *(const LAS bf16x8*)(xcB + trow * KP + 16 * s + 8 * hi);
                const bf16x8 wr_ = *(const LAS bf16x8*)(wL + d * KP + 16 * s + 8 * hi), wi_ = *(const LAS bf16x8*)(wL + (64 + d) * KP + 16 * s + 8 * hi);
                pr = __builtin_amdgcn_mfma_f32_32x32x16_bf16(af, wr_, pr, 0, 0, 0);
                pi = __builtin_amdgcn_mfma_f32_32x32x16_bf16(af, wi_, pi, 0, 0, 0);
            }
            const float brv = parL[320 + d], biv = parL[384 + d], ls8 = parL[448 + d];
            float A = 1.f, H = 0.f;
#pragma unroll
            for (int i = 0; i < 16; ++i) {
                const float r = pg8::fast_sigmoid(pr[i] + brv), ig = pg8::fast_sigmoid(pi[i] + biv);
                const float la = ls8 * r;
                const float a = __builtin_amdgcn_exp2f(la * LOG2E);
                const float mult = __builtin_amdgcn_sqrtf(fmaxf(1.0f - a * a, 0.f));
                const float u = mult * ig * xcF[(tb + i) * 64 + d];
                av[i] = a; uv[i] = u; H = a * H + u; A *= a;
            }
            segA[sg * 64 + d] = A; segH[sg * 64 + d] = H;
        }
        LDS_BARRIER();
        if (w == 0 && ch < NCH - 1) {
            float At = 1.f, Ht = 0.f;
#pragma unroll
            for (int s = 0; s < 8; ++s) { const float a = segA[s * 64 + c], hh = segH[s * 64 + c]; Ht = a * Ht + hh; At *= a; }
            unsigned long long* g = gran + ((size_t)(b * NCH + ch) * D + c0 + c) * 2;
            __hip_atomic_store(g, (1ull << 32) | (unsigned long long)__float_as_uint(At), __ATOMIC_RELAXED, __HIP_MEMORY_SCOPE_AGENT);
            __hip_atomic_store(g + 1, (1ull << 32) | (unsigned long long)__float_as_uint(Ht), __ATOMIC_RELAXED, __HIP_MEMORY_SCOPE_AGENT);
        }
#pragma unroll
        for (int q = 0; q < 2; ++q) { const int kk = w + 8 * q;
            if (kk < ch) {
                const unsigned long long* g = gran + ((size_t)(b * NCH + kk) * D + c0 + c) * 2;
                for (unsigned spins = 0; spins < (1u << 22); ++spins) {
                    if (__all(xt_[q] == 1u)) break;
                    __builtin_amdgcn_s_sleep(1);
                    const unsigned long long ya = __hip_atomic_load(g, __ATOMIC_RELAXED, __HIP_MEMORY_SCOPE_AGENT), yh = __hip_atomic_load(g + 1, __ATOMIC_RELAXED, __HIP_MEMORY_SCOPE_AGENT);
                    xa[q] = (unsigned)ya; xh[q] = (unsigned)yh; xt_[q] = (unsigned)(ya >> 32) & (unsigned)(yh >> 32); }
                pA[kk * 64 + c] = __uint_as_float(xa[q]); pH[kk * 64 + c] = __uint_as_float(xh[q]);
            } }
        LDS_BARRIER();
        {
            float h = 0.f;
            for (int kk = 0; kk < ch; ++kk) h = pA[kk * 64 + d] * h + pH[kk * 64 + d];
            for (int s = 0; s < 7; ++s) { if (s < sg) h = segA[s * 64 + d] * h + segH[s * 64 + d]; }
#pragma unroll
            for (int i = 0; i < 16; ++i) { const int t = tb + i; h = av[i] * h + uv[i];
                const float yv_ = __uint_as_float((unsigned)yL[t * KP + d] << 16);
                xcB[t * KP + d] = (bf16)(pk_bf16(h * yv_, 0.f) & 0xffffu); }
        }
        LDS_BARRIER();
#pragma unroll
        for (int r = 0; r < 2; ++r) *(v4u*)(HY + (size_t)(b * SEQ + t0 + st + 64 * r) * D + c0 + cc) = *(const LAS v4u*)(xcB + (st + 64 * r) * KP + cc);
    }
}

#define RLX_AGENT __ATOMIC_RELAXED, __HIP_MEMORY_SCOPE_AGENT
#define XB_TMO      128
#define XB_XCNT(j)  (256  + 64 * (j))
#define XB_XSUB(j)  (1280 + 64 * (j))
#define XB_XGEN(j)  (2304 + 64 * (j))
#define XB_TOP      3328
#define XB_TOPGEN   3392
#define XCD_BAR_WORDS 3456
#define XB_SPIN_CAP (1u << 18)

__device__ __forceinline__ unsigned xb_ld(unsigned* p)              { return __hip_atomic_load(p, __ATOMIC_RELAXED, __HIP_MEMORY_SCOPE_AGENT); }
__device__ __forceinline__ unsigned xb_add(unsigned* p, unsigned v) { return __hip_atomic_fetch_add(p, v, __ATOMIC_RELAXED, __HIP_MEMORY_SCOPE_AGENT); }
__device__ __forceinline__ unsigned xb_xcc_id() { return (unsigned)__builtin_amdgcn_s_getreg((3 << 11) | 20) & 0xFu; }
#define XB_SPIN(cond, bar) do { unsigned _sp = 0; while (cond) { __builtin_amdgcn_s_sleep(1); \
    if ((++_sp & 255u) == 0u) { if (xb_ld(&(bar)[XB_TMO])) break; if (_sp > XB_SPIN_CAP) { atomicAdd(&(bar)[XB_TMO], 1u); break; } } } } while (0)

struct XcdBarrier {
    unsigned* bar; unsigned x;
    volatile LAS unsigned* st;
};

__device__ __forceinline__ XcdBarrier xcd_barrier_post(unsigned* bar, volatile LAS unsigned* st, bool is_t0) {
    XcdBarrier b; b.bar = bar; b.x = xb_xcc_id(); b.st = st;
    if (is_t0) (void)xb_add(&bar[XB_XCNT(b.x)], 1u);
    return b;
}
__device__ __forceinline__ void xcd_barrier_complete(unsigned* bar, unsigned x, unsigned& nloc, unsigned& nx) {
    const unsigned G = gridDim.x * gridDim.y * gridDim.z;
    unsigned sum, cnt, mine, sp = 0u;
    for (;;) {
        sum = 0u; cnt = 0u; mine = 0u;
#pragma unroll
        for (unsigned j = 0; j < 16; ++j) { const unsigned c = xb_ld(&bar[XB_XCNT(j)]); sum += c; cnt += (c > 0u) ? 1u : 0u; mine = (j == x) ? c : mine; }
        if (sum == G) break;
        __builtin_amdgcn_s_sleep(1);
        if ((++sp & 255u) == 0u) { if (xb_ld(&bar[XB_TMO])) break; if (sp > XB_SPIN_CAP) { atomicAdd(&bar[XB_TMO], 1u); break; } }
    }
    nloc = mine > 0u ? mine : 1u; nx = cnt > 0u ? cnt : 1u;
}

__device__ __forceinline__ void xcd_barrier(const XcdBarrier& b, int wave_s) {
    asm volatile("s_waitcnt vmcnt(0)" ::: "memory");
    __syncthreads();
    if (wave_s == 0 && lane_id_() == 0) {
        unsigned* bar = b.bar;
        __builtin_amdgcn_s_waitcnt(0);
        unsigned nloc = b.st[0], nx = b.st[1];
        if (nloc == 0u) { xcd_barrier_complete(bar, b.x, nloc, nx); b.st[0] = nloc; b.st[1] = nx; }
        const unsigned old = xb_add(&bar[XB_XSUB(b.x)], 1u);
        const unsigned gen = old / nloc;
        if (old + 1u == (gen + 1u) * nloc) {
            __builtin_amdgcn_fence(__ATOMIC_RELEASE, "agent");
            asm volatile("s_waitcnt vmcnt(0)" ::: "memory");
            const unsigned og = xb_add(&bar[XB_TOP], 1u);
            const unsigned tg = og / nx;
            if (og + 1u == (tg + 1u) * nx) xb_add(&bar[XB_TOPGEN], 1u);
            else XB_SPIN(xb_ld(&bar[XB_TOPGEN]) == tg, bar);
            __builtin_amdgcn_fence(__ATOMIC_ACQUIRE, "agent");
            xb_add(&bar[XB_XGEN(b.x)], 1u);
            asm volatile("s_waitcnt vmcnt(0)" ::: "memory");
        } else {
            XB_SPIN(xb_ld(&bar[XB_XGEN(b.x)]) == gen, bar);
            __builtin_amdgcn_fence(__ATOMIC_ACQUIRE, "agent");
            asm volatile("s_waitcnt vmcnt(0)" ::: "memory");
        }
    }
    __syncthreads();
}

__device__ __forceinline__ int launder_s_(int k) { asm volatile("" : "+s"(k)); return k; }
struct Args { const float* in[28]; float* out; unsigned char* ws; };
__global__ void __launch_bounds__(512, 2) fwd_megakernel(Args a) {
    const float* const* kin_ = (const float* const*)__builtin_amdgcn_kernarg_segment_ptr();
#define AIN(k) (kin_[launder_s_(k)])
    extern __shared__ __attribute__((aligned(16))) unsigned char lds_raw[];
    cg::grid_group grid = cg::this_grid();
    LAS unsigned char* lds = (LAS unsigned char*)lds_raw;
    const int tid = threadIdx.x, lane = tid & 63, wave = __builtin_amdgcn_readfirstlane(tid >> 6);
    const int G = gridDim.x, bid = blockIdx.x;
    const int gw = bid * 8 + wave, ngw = G * 8;
    unsigned char* ws = a.ws;
    bf16* XN = (bf16*)(ws + WS_XN); bf16* ACT = (bf16*)(ws + WS_ACT);
    bf16* QB = ACT; bf16* KB = ACT + (size_t)M * D; bf16* VB = ACT + (size_t)2 * M * D;
    volatile LAS unsigned* MISC = (volatile LAS unsigned*)(lds + 131072 + 4096);
    if (tid < 2) MISC[tid] = 0u;
    __syncthreads();
    const XcdBarrier xbar = xcd_barrier_post((unsigned*)(ws + WS_CTL), MISC, tid == 0);

    float* SSQ = (float*)(ws + WS_SSQ);
#define SSQ_AT(s) (SSQ + (size_t)(s) * M)
    constexpr int I_IN = (D / 64) * (2 * FF / 32), I_OUT = (FF / 64) * (D / 32), I_QKV = (D / 64) * (3 * D / 32), I_SQ = (D / 64) * (D / 32), I_LIN = (D / 64) * (2 * D / 32), I_G = 16 * 2;
    constexpr int SEG0 = I_IN, SEG1 = SEG0 + I_OUT + I_QKV + I_SQ + I_IN, SEG2 = SEG1 + I_OUT + I_IN + I_OUT, SEG3 = SEG2 + I_LIN + I_SQ + 2 * I_G + I_IN + I_OUT;
#define FFW(f) (ws + W_FF0 + (size_t)(f) * (SZ_WIN + SZ_WOUT))
#define CONVERT_ITEMS(lo_, hi_, wk_, nwk_) do { LAS float* scr = (LAS float*)(lds + wave * 16384); int tl_ = lane_id_(); asm volatile("" : "+v"(tl_)); const int lane = tl_; \
        for (int it = (lo_) + (wk_); it < (hi_); it += (nwk_)) { int r = it; \
            if (r < I_IN) { transpose_item<true>(AIN(2), AIN(1), D, 2 * FF, (bf16*)FFW(0), scr, r, lane); continue; } r -= I_IN; \
            if (r < I_OUT) { transpose_item<false>(AIN(3), nullptr, FF, D, (bf16*)(FFW(0) + SZ_WIN), scr, r, lane); continue; } r -= I_OUT; \
            if (r < I_QKV) { transpose_item<false>(AIN(5), AIN(4), D, 3 * D, (bf16*)(ws + W_QKV), scr, r, lane); continue; } r -= I_QKV; \
            if (r < I_SQ) { transpose_item<false>(AIN(8), nullptr, D, D, (bf16*)(ws + W_O), scr, r, lane); continue; } r -= I_SQ; \
            if (r < I_IN) { transpose_item<true>(AIN(10), AIN(9), D, 2 * FF, (bf16*)FFW(1), scr, r, lane); continue; } r -= I_IN; \
            if (r < I_OUT) { transpose_item<false>(AIN(11), nullptr, FF, D, (bf16*)(FFW(1) + SZ_WIN), scr, r, lane); continue; } r -= I_OUT; \
            if (r < I_IN) { transpose_item<true>(AIN(13), AIN(12), D, 2 * FF, (bf16*)FFW(2), scr, r, lane); continue; } r -= I_IN; \
            if (r < I_OUT) { transpose_item<false>(AIN(14), nullptr, FF, D, (bf16*)(FFW(2) + SZ_WIN), scr, r, lane); continue; } r -= I_OUT; \
            if (r < I_LIN) { transpose_item<false>(AIN(16), AIN(15), D, 2 * D, (bf16*)(ws + W_LIN), scr, r, lane); continue; } r -= I_LIN; \
            if (r < I_SQ) { transpose_item<false>(AIN(24), nullptr, D, D, (bf16*)(ws + W_LO), scr, r, lane); continue; } r -= I_SQ; \
            if (r < I_G) { transpose_item<false>(AIN(19) + (size_t)(r >> 1) * 4096, nullptr, 64, 64, (bf16*)(ws + W_GR) + (size_t)(r >> 1) * 4096, scr, r & 1, lane); continue; } r -= I_G; \
            if (r < I_G) { transpose_item<false>(AIN(21) + (size_t)(r >> 1) * 4096, nullptr, 64, 64, (bf16*)(ws + W_GI) + (size_t)(r >> 1) * 4096, scr, r & 1, lane); continue; } r -= I_G; \
            if (r < I_IN) { transpose_item<true>(AIN(26), AIN(25), D, 2 * FF, (bf16*)FFW(3), scr, r, lane); continue; } r -= I_IN; \
            transpose_item<false>(AIN(27), nullptr, FF, D, (bf16*)(FFW(3) + SZ_WIN), scr, r, lane); } } while (0)
    const int ffn_units = (M / 256) * (2 * FF / 256), ffn_rounds = (ffn_units + G - 1) / G, idle_from = ffn_units - (ffn_rounds - 1) * G;
#define CONVERT_IN_TAIL(lo_, hi_) do { if (idle_from < G) { if (bid >= idle_from) CONVERT_ITEMS(lo_, hi_, (bid - idle_from) * 8 + wave, (G - idle_from) * 8); } \
        else CONVERT_ITEMS(lo_, hi_, gw, ngw); } while (0)
    {
        CONVERT_ITEMS(0, SEG0, gw, ngw);
        cvt_phase(AIN(0), XN, SSQ_AT(0), gw, ngw, lane);
        for (int i = bid * 512 + tid; i < 2 * BATCH * NCH * D; i += G * 512) ((unsigned long long*)(ws + WS_SUM))[i] = 0ull;
    }
#define SEAM() xcd_barrier(xbar, wave)
    if (a.ws == nullptr) grid.sync();
    SEAM();
#define GEMM(EPI, Aptr, Wptr, NN, KK, E) do { pg8::Gemm g{(Aptr), (const bf16*)(Wptr), M, (NN), (KK)}; pg8::StaticOrder S; S.init(M, (NN), G, bid); \
        pg8::gemm_phase<EPI, pg8::StaticOrder, true, true>(lds, g, S, (E), wave); } while (0)
#define FFN(widx, s_in, FIRST, LAST, TLO, THI) do { \
        { pg8::EpiSwiglu E{ACT, FF, SSQ_AT(s_in)}; GEMM(pg8::EpiSwiglu, XN, ws + W_FF0 + (size_t)(widx) * (SZ_WIN + SZ_WOUT), 2 * FF, D, E); } \
        if ((TLO) < (THI)) CONVERT_IN_TAIL(TLO, THI); \
        SEAM(); \
        { typedef pg8::EpiResid<FIRST, LAST, true> EpiR; EpiR E{AIN(0), ((float*)AIN(28)), XN, SSQ_AT((s_in) + 1)}; GEMM(EpiR, ACT, ws + W_FF0 + (size_t)(widx) * (SZ_WIN + SZ_WOUT) + SZ_WIN, D, FF, E); } \
        } while (0)

    FFN(0, 0, false, false, SEG0, SEG1);
    SEAM();
    { pg8::EpiSplit<99> E{ACT, (size_t)M * D, SSQ_AT(1)}; GEMM(pg8::EpiSplit<99>, XN, ws + W_QKV, 3 * D, D, E); }
    SEAM();
    { const int vcu = (G % 8 == 0) ? (bid % 8) * (G / 8) + bid / 8 : bid;
      attn_phase2(lds, QB, KB, VB, QB, AIN(6), AIN(7), vcu * 8 + wave, ngw, wave); }
    SEAM();
    { typedef pg8::EpiResid<false, false, false> EpiR; EpiR E{AIN(0), ((float*)AIN(28)), XN, SSQ_AT(2)}; GEMM(EpiR, QB, ws + W_O, D, D, E); }
    SEAM();
    FFN(1, 2, false, false, SEG1, SEG2);
    SEAM();
    FFN(2, 3, false, false, SEG2, SEG3);
    SEAM();
    { pg8::EpiSplit<1> E{ACT, (size_t)M * D, SSQ_AT(4)}; GEMM(pg8::EpiSplit<1>, XN, ws + W_LIN, 2 * D, D, E); }
    SEAM();
    lru_phase(lds, QB, KB, VB, (const bf16*)(ws + W_GR), (const bf16*)(ws + W_GI), AIN(17), AIN(18), AIN(20), AIN(22), AIN(23), (unsigned long long*)(ws + WS_SUM), G, bid, wave);
    SEAM();
    { typedef pg8::EpiResid<false, false, false> EpiR; EpiR E{AIN(0), ((float*)AIN(28)), XN, SSQ_AT(5)}; GEMM(EpiR, VB, ws + W_LO, D, D, E); }
    SEAM();
    FFN(3, 5, false, true, 0, 0);
}

extern "C" void kernel_launch(void* const* d_in, const int* in_sizes, int n_in, void* d_out, int out_size, void* d_ws, size_t ws_size, hipStream_t stream) {
    static int grid = 0;
    if (grid == 0) {
        if (n_in != 28 || out_size != M * D || ws_size < WS_END) { fprintf(stderr, "kernel_launch: unexpected problem (n_in %d out %d ws %zu)\n", n_in, out_size, ws_size); grid = -1; return; }
        int dev = 0, cus = 0, per_cu = 0;
        hipGetDevice(&dev); hipDeviceGetAttribute(&cus, hipDeviceAttributeMultiprocessorCount, dev);
        if (hipFuncSetAttribute((const void*)fwd_megakernel, hipFuncAttributeMaxDynamicSharedMemorySize, LDS_BYTES) != hipSuccess) { fprintf(stderr, "kernel_launch: hipFuncSetAttribute failed\n"); grid = -1; return; }
        if (hipOccupancyMaxActiveBlocksPerMultiprocessor(&per_cu, (const void*)fwd_megakernel, 512, LDS_BYTES) != hipSuccess || per_cu < 1) { fprintf(stderr, "kernel_launch: occupancy query says %d\n", per_cu); per_cu = 1; }
        (void)hipGetLastError();
        grid = cus * per_cu;
    }
    if (grid < 0) return;
    if (hipMemsetAsync((char*)d_ws + WS_CTL, 0, CTL_ZERO_BYTES, stream) != hipSuccess) { fprintf(stderr, "memset failed\n"); return; }
    Args a{};
    for (int i = 0; i < 28; ++i) a.in[i] = (const float*)d_in[i];
    a.out = (float*)d_out; a.ws = (unsigned char*)d_ws;
    void* args[] = {&a};
    hipError_t e = hipLaunchCooperativeKernel((const void*)fwd_megakernel, dim3(grid), dim3(512), args, LDS_BYTES, stream);
    if (e != hipSuccess) fprintf(stderr, "cooperative launch failed: %s (grid %d)\n", hipGetErrorString(e), grid);
}
```

```cpp
#include <hip/hip_runtime.h>
#include <hip/hip_cooperative_groups.h>
#include <cstdio>
#include <cstdint>
namespace cg = cooperative_groups;
__device__ __forceinline__ int lane_id_() { int l; asm volatile("v_mbcnt_lo_u32_b32 %0, -1, 0\n\tv_mbcnt_hi_u32_b32 %0, -1, %0" : "=v"(l)); return l; }
namespace pg8 {
#define PG8_LAS __attribute__((address_space(3)))
typedef unsigned short bf16_t;
typedef short bf16x8 __attribute__((ext_vector_type(8)));
typedef float f32x4 __attribute__((ext_vector_type(4)));
typedef unsigned u32x4 __attribute__((ext_vector_type(4)));
constexpr int BM = 256, BK = 64, HALF = 128, HTB = HALF * BK * 2  , STAGE_BYTES = 8 * HTB, NXCD = 8, WGM = 8;

__host__ __device__ __forceinline__ int lds_byte(int r, int c) { const int st = (r >> 4) * 2 + (c >> 5), rr = r & 15, cc = c & 31, ob = rr * 64 + cc * 2; return st * 1024 + (ob ^ (((ob >> 9) & 1) << 5)); }
__host__ __device__ __forceinline__ void stage_rc(int b, int& R, int& C) { const int st = b / 1024, sb = b % 1024, swz = sb ^ (((sb >> 9) & 1) << 5); R = (st >> 1) * 16 + swz / 64; C = (st & 1) * 32 + (swz % 64) / 2; }
__host__ __device__ __forceinline__ int perm32(int rho) { const int n = rho >> 4, i = rho & 15; return 8 * (i >> 2) + 4 * n + (i & 3); }

struct Unit { int pm, pn; };
struct Gemm { const bf16_t* A; const bf16_t* Bt; int M, N, K; };

struct StaticOrder {
    int nM, nN, nwg, G, c;
    __host__ __device__ void init(int M, int N, int G_, int c_) { nM = M / BM; nN = N / BM; nwg = nM * nN; G = G_; c = c_; }
    __host__ __device__ bool next(int i, Unit& u) const {
        const long L = (long)i * G + c; if (L >= nwg) return false;
        int wgid = (int)L; { const int q = nwg / NXCD, r = nwg % NXCD, xcd = wgid % NXCD, off = wgid / NXCD; wgid = (xcd < r ? xcd * (q + 1) : r * (q + 1) + (xcd - r) * q) + off; }
        const int nig = WGM * nN, gid = wgid / nig, fm = gid * WGM, gsz = (nM - fm) < WGM ? (nM - fm) : WGM;
        u.pm = fm + ((wgid % nig) % gsz); u.pn = (wgid % nig) / gsz; return true;
    }
    __device__ __forceinline__ void a_ready(const Unit&) const {}
    __device__ __forceinline__ void done(const Unit&) const {}
};

__device__ __forceinline__ unsigned cvt_pk_bf16(float lo, float hi) { unsigned r; asm volatile("v_cvt_pk_bf16_f32 %0, %1, %2" : "=v"(r) : "v"(lo), "v"(hi)); return r; }
typedef float f32x2 __attribute__((ext_vector_type(2)));
__device__ __forceinline__ unsigned pk_bf16(float lo, float hi) { typedef __bf16 b2_t __attribute__((ext_vector_type(2))); f32x2 v = {lo, hi}; b2_t b = __builtin_convertvector(v, b2_t); return __builtin_bit_cast(unsigned, b); }
__device__ __forceinline__ float fast_sigmoid(float v) { return __builtin_amdgcn_rcpf(1.0f + __builtin_amdgcn_exp2f(-1.44269504089f * v)); }
struct EpiSwiglu {
    static constexpr bool PERM = true, AFTER_DRAIN = false; static constexpr int NSTORES = 8;
    bf16_t* H; int ldh; const float* ssq;
    __device__ __forceinline__ void operator()(const f32x4 (&acc)[2][2][4][2], const Unit& u, int wr, int wc, int fr, int fq) const {
        const int row0 = u.pm * BM + wr * 64 + fr, col0 = u.pn * HALF + wc * 32 + 8 * fq;
#pragma unroll
        for (int ai = 0; ai < 2; ++ai)
#pragma unroll
            for (int m = 0; m < 4; ++m) {
                bf16_t* p = H + (size_t)(row0 + ai * HALF + m * 16) * ldh + col0;
                const float rstd = __builtin_amdgcn_rsqf(ssq[row0 + ai * HALF + m * 16] * (1.0f / 1024.0f) + 1e-6f);
                float h[8];
#pragma unroll
                for (int n = 0; n < 2; ++n)
#pragma unroll
                    for (int j = 0; j < 4; ++j) { const float g = acc[ai][0][m][n][j] * rstd, up = acc[ai][1][m][n][j] * rstd; h[4 * n + j] = g * fast_sigmoid(g) * up; }
                u32x4 w; w.x = pk_bf16(h[0], h[1]); w.y = pk_bf16(h[2], h[3]); w.z = pk_bf16(h[4], h[5]); w.w = pk_bf16(h[6], h[7]);
                *(u32x4*)p = w;
            }
    }
};
template <bool FIRST, bool LAST, bool HALF_ALPHA> struct EpiResid {
    static constexpr bool PERM = true, AFTER_DRAIN = false; static constexpr int NSTORES = 0;
    const float* base32; float* out32; bf16_t* xn; float* ssq;
    __device__ __forceinline__ void operator()(const f32x4 (&acc)[2][2][4][2], const Unit& u, int wr, int wc, int fr, int fq) const {
        const int row0 = u.pm * BM + wr * 64 + fr, col0 = u.pn * BM + wc * 32 + 8 * fq;
        constexpr float alpha = HALF_ALPHA ? 0.5f : 1.0f;
#pragma unroll
        for (int ai = 0; ai < 2; ++ai)
#pragma unroll
            for (int m = 0; m < 4; ++m) {
                float s = 0.f;
#pragma unroll
                for (int bj = 0; bj < 2; ++bj) {
                    const size_t off = (size_t)(row0 + ai * HALF + m * 16) * 1024 + col0 + bj * HALF;
                    f32x4 b0, b1;
                    if (FIRST) { b0 = *(const f32x4*)(base32 + off); b1 = *(const f32x4*)(base32 + off + 4); }
                    else { const u32x4 r = *(const u32x4*)(xn + off);
                        b0 = (f32x4){__uint_as_float(r.x << 16), __uint_as_float(r.x & 0xffff0000u), __uint_as_float(r.y << 16), __uint_as_float(r.y & 0xffff0000u)};
                        b1 = (f32x4){__uint_as_float(r.z << 16), __uint_as_float(r.z & 0xffff0000u), __uint_as_float(r.w << 16), __uint_as_float(r.w & 0xffff0000u)}; }
                    const f32x4 v0 = b0 + alpha * acc[ai][bj][m][0], v1 = b1 + alpha * acc[ai][bj][m][1];
                    if (LAST) { *(f32x4*)(out32 + off) = v0; *(f32x4*)(out32 + off + 4) = v1; }
                    else {
                        u32x4 w; w.x = pk_bf16(v0[0], v0[1]); w.y = pk_bf16(v0[2], v0[3]); w.z = pk_bf16(v1[0], v1[1]); w.w = pk_bf16(v1[2], v1[3]);
                        *(u32x4*)(xn + off) = w;
                        const float r0 = __uint_as_float(w.x << 16), r1 = __uint_as_float(w.x & 0xffff0000u), r2 = __uint_as_float(w.y << 16), r3 = __uint_as_float(w.y & 0xffff0000u);
                        const float r4 = __uint_as_float(w.z << 16), r5 = __uint_as_float(w.z & 0xffff0000u), r6 = __uint_as_float(w.w << 16), r7 = __uint_as_float(w.w & 0xffff0000u);
                        s += (r0 * r0 + r1 * r1) + (r2 * r2 + r3 * r3) + (r4 * r4 + r5 * r5) + (r6 * r6 + r7 * r7);
                    }
                }
                if (!LAST) { s += __shfl_xor(s, 16); s += __shfl_xor(s, 32); if (fq == 0) __hip_atomic_fetch_add(ssq + row0 + ai * HALF + m * 16, s, __ATOMIC_RELAXED, __HIP_MEMORY_SCOPE_AGENT); }
            }
    }
};
template <int GELU_FROM> struct EpiSplit {
    static constexpr bool PERM = true, AFTER_DRAIN = false; static constexpr int NSTORES = 16;
    bf16_t* O; size_t split_stride; const float* ssq;
    __device__ __forceinline__ void operator()(const f32x4 (&acc)[2][2][4][2], const Unit& u, int wr, int wc, int fr, int fq) const {
        const int t = u.pn >> 2; bf16_t* basep = O + (size_t)t * split_stride;
        const int row0 = u.pm * BM + wr * 64 + fr, col0 = (u.pn & 3) * BM + wc * 32 + 8 * fq;
        const bool act = t >= GELU_FROM;
#pragma unroll
        for (int ai = 0; ai < 2; ++ai)
#pragma unroll
            for (int m = 0; m < 4; ++m) {
                const float rstd = __builtin_amdgcn_rsqf(ssq[row0 + ai * HALF + m * 16] * (1.0f / 1024.0f) + 1e-6f);
#pragma unroll
                for (int bj = 0; bj < 2; ++bj) {
                    float h[8];
#pragma unroll
                    for (int n = 0; n < 2; ++n)
#pragma unroll
                        for (int j = 0; j < 4; ++j) { float v = acc[ai][bj][m][n][j] * rstd;
                            if (act) { const float z = 1.5957691216f * (v + 0.044715f * v * v * v); v = v * fast_sigmoid(z); }
                            h[4 * n + j] = v; }
                    u32x4 w; w.x = pk_bf16(h[0], h[1]); w.y = pk_bf16(h[2], h[3]); w.z = pk_bf16(h[4], h[5]); w.w = pk_bf16(h[6], h[7]);
                    *(u32x4*)(basep + (size_t)(row0 + ai * HALF + m * 16) * 1024 + col0 + bj * HALF) = w;
                }
            }
    }
};
template <class Epi, class Sched, bool ALIGN_EPI = false, bool SP2 = false>
__device__ __forceinline__ void gemm_phase(PG8_LAS unsigned char* lds, const Gemm g, const Sched& S, const Epi& E, int wave_s) {
    int tid = wave_s * 64 + lane_id_(); asm volatile("" : "+v"(tid));
    const int wid = __builtin_amdgcn_readfirstlane(tid >> 6), lane = tid & 63, wr = wid >> 2, wc = wid & 3, fr = lane & 15, fq = lane >> 4;
    const int K = g.K, nt = K / BK;
    unsigned voffA[2], voffB[2];
#pragma unroll
    for (int i = 0; i < 2; ++i) { int R, C; stage_rc(tid * 16 + i * 8192, R, C); const int Rb = Epi::PERM ? ((R & ~31) + perm32(R & 31)) : R;
        voffA[i] = (unsigned)(R * K + C) * 2u; voffB[i] = (unsigned)(Rb * K + C) * 2u; }
    const size_t kstep = (size_t)(BK * 2);
    const size_t hstep = (size_t)HALF * K * 2;
    const size_t tstep = 2 * hstep;
    const unsigned ldsw = (unsigned)wid * 1024u;
    const int aoff = lds_byte(wr * 64 + fr, fq * 8), boff = lds_byte(wc * 32 + fr, fq * 8);
#define PG8_SA(b, h) (((b) * 2 + (h)) * HTB)
#define PG8_SB(b, h) ((4 + (b) * 2 + (h)) * HTB)
#define PG8_STAGE(bufoff, gbase, voff) do { _Pragma("unroll") for (int _i = 0; _i < 2; ++_i) \
        __builtin_amdgcn_global_load_lds((const unsigned*)((const char*)(gbase) + (voff)[_i]), (PG8_LAS unsigned*)(lds + (bufoff) + ldsw + _i * 8192), 16, 0, 0); } while (0)
#define PG8_LDA(dst, b, h) do { _Pragma("unroll") for (int m = 0; m < 4; ++m) _Pragma("unroll") for (int k = 0; k < 2; ++k) dst[m][k] = *(const PG8_LAS bf16x8*)(lds + PG8_SA(b, h) + aoff + m * 2048 + k * 1024); } while (0)
#define PG8_LDB(dst, b, h) do { _Pragma("unroll") for (int n = 0; n < 2; ++n) _Pragma("unroll") for (int k = 0; k < 2; ++k) dst[n][k] = *(const PG8_LAS bf16x8*)(lds + PG8_SB(b, h) + boff + n * 2048 + k * 1024); } while (0)
#define PG8_MMA(ai, bj, At, Bt) do { __builtin_amdgcn_s_setprio(1); _Pragma("unroll") for (int m = 0; m < 4; ++m) _Pragma("unroll") for (int n = 0; n < 2; ++n) _Pragma("unroll") for (int k = 0; k < 2; ++k) \
        acc[ai][bj][m][n] = __builtin_amdgcn_mfma_f32_16x16x32_bf16(Bt[n][k], At[m][k], acc[ai][bj][m][n], 0, 0, 0); __builtin_amdgcn_s_setprio(0); } while (0)
#define PG8_WAIT_V(n) asm volatile("s_waitcnt vmcnt(" #n ")" ::: "memory")
#define PG8_WAIT_L(n) asm volatile("s_waitcnt lgkmcnt(" #n ")" ::: "memory")
#define PG8_WAIT_V8_STRICT() asm volatile("s_waitcnt vmcnt(8)" ::: "memory")
#define PG8_WAIT_V8_RELAX() do { if constexpr (Epi::NSTORES == 8) asm volatile("s_waitcnt vmcnt(16)" ::: "memory"); else if constexpr (Epi::NSTORES == 16) asm volatile("s_waitcnt vmcnt(24)" ::: "memory"); else asm volatile("s_waitcnt vmcnt(8)" ::: "memory"); } while (0)
#define PG8_BAR __builtin_amdgcn_s_barrier()
#define PG8_SCHED __builtin_amdgcn_sched_barrier(0)
#define PG8_SP2_PAIR(WAITM) do { \
            PG8_LDB(B0, 0, 0); PG8_LDB(B1, 0, 1); PG8_SCHED; PG8_LDA(At, 0, 0); PG8_STAGE(PG8_SA(1, 1), a1 + hstep, voffA); \
            WAITM(); PG8_WAIT_L(0); PG8_BAR; PG8_MMA(0, 0, At, B0); PG8_MMA(0, 1, At, B1); PG8_BAR; PG8_SCHED; \
            PG8_LDA(At, 0, 1); PG8_STAGE(PG8_SB(0, 0), b2, voffB); PG8_STAGE(PG8_SB(0, 1), b2 + hstep, voffB); PG8_STAGE(PG8_SA(0, 0), a2, voffA); \
            WAITM(); PG8_WAIT_L(0); PG8_BAR; PG8_MMA(1, 0, At, B0); PG8_MMA(1, 1, At, B1); PG8_BAR; PG8_SCHED; \
            PG8_LDB(B0, 1, 0); PG8_LDB(B1, 1, 1); PG8_SCHED; PG8_LDA(At, 1, 0); PG8_STAGE(PG8_SA(0, 1), a2 + hstep, voffA); \
            WAITM(); PG8_WAIT_L(0); PG8_BAR; PG8_MMA(0, 0, At, B0); PG8_MMA(0, 1, At, B1); PG8_BAR; PG8_SCHED; \
            PG8_LDA(At, 1, 1); PG8_STAGE(PG8_SB(1, 0), b3, voffB); PG8_STAGE(PG8_SB(1, 1), b3 + hstep, voffB); PG8_STAGE(PG8_SA(1, 0), a3, voffA); \
            WAITM(); PG8_WAIT_L(0); PG8_BAR; PG8_MMA(1, 0, At, B0); PG8_MMA(1, 1, At, B1); PG8_BAR; PG8_SCHED; \
            } while (0)
    Unit cur, nxt; int ui = 0; bool peeled = false;
    if (!S.next(0, cur)) return;
    f32x4 acc[2][2][4][2];
#pragma unroll
    for (int a = 0; a < 2; ++a)
#pragma unroll
        for (int b = 0; b < 2; ++b)
#pragma unroll
            for (int m = 0; m < 4; ++m)
#pragma unroll
                for (int n = 0; n < 2; ++n) acc[a][b][m][n] = (f32x4){0.f, 0.f, 0.f, 0.f};
    bf16x8 At[4][2], B0[2][2], B1[2][2];
    const char* cA = (const char*)g.A + (size_t)cur.pm * tstep; const char* cB = (const char*)g.Bt + (size_t)cur.pn * tstep;
    S.a_ready(cur);
    if constexpr (SP2) {
        PG8_STAGE(PG8_SB(0, 0), cB, voffB); PG8_STAGE(PG8_SB(0, 1), cB + hstep, voffB); PG8_STAGE(PG8_SA(0, 0), cA, voffA); PG8_STAGE(PG8_SA(0, 1), cA + hstep, voffA);
        if (wr == 1) PG8_BAR;
        PG8_WAIT_V(2); PG8_BAR;
        PG8_STAGE(PG8_SB(1, 0), cB + kstep, voffB); PG8_STAGE(PG8_SA(1, 0), cA + kstep, voffA); PG8_STAGE(PG8_SB(1, 1), cB + hstep + kstep, voffB);
        PG8_WAIT_V(6); PG8_BAR;
    } else {
        PG8_STAGE(PG8_SB(0, 0), cB, voffB); PG8_STAGE(PG8_SA(0, 0), cA, voffA); PG8_STAGE(PG8_SB(0, 1), cB + hstep, voffB); PG8_STAGE(PG8_SA(0, 1), cA + hstep, voffA);
        if (wr == 1) PG8_BAR;
        PG8_WAIT_V(4); PG8_BAR;
        PG8_STAGE(PG8_SB(1, 0), cB + kstep, voffB); PG8_STAGE(PG8_SA(1, 0), cA + kstep, voffA); PG8_STAGE(PG8_SB(1, 1), cB + hstep + kstep, voffB);
        PG8_WAIT_V(6); PG8_BAR;
    }
    for (;;) {
        const bool has_next = S.next(ui + 1, nxt);
        const char* nA = has_next ? (const char*)g.A + (size_t)nxt.pm * tstep : cA; const char* nB = has_next ? (const char*)g.Bt + (size_t)nxt.pn * tstep : cB;
        for (int t = peeled ? 2 : 0; t < nt; t += 2) {
            const bool last = (t == nt - 2);
            const char* a1 = cA + (size_t)(t + 1) * kstep;
            const char* a2 = last ? nA : cA + (size_t)(t + 2) * kstep; const char* b2 = last ? nB : cB + (size_t)(t + 2) * kstep;
            const char* a3 = a2 + kstep; const char* b3 = b2 + kstep;
            if (last && has_next) S.a_ready(nxt);
            if constexpr (SP2) {
            PG8_SP2_PAIR(PG8_WAIT_V8_STRICT);
            } else {
            PG8_LDB(B0, 0, 0); PG8_SCHED; PG8_LDA(At, 0, 0); PG8_STAGE(PG8_SA(1, 1), a1 + hstep, voffA);
            PG8_WAIT_L(8); PG8_BAR; PG8_WAIT_L(0); PG8_MMA(0, 0, At, B0); PG8_BAR; PG8_SCHED;
            PG8_LDB(B1, 0, 1); PG8_STAGE(PG8_SB(0, 0), b2, voffB);
            PG8_BAR; PG8_WAIT_L(0); PG8_MMA(0, 1, At, B1); PG8_BAR;
            PG8_LDA(At, 0, 1); PG8_STAGE(PG8_SA(0, 0), a2, voffA);
            PG8_BAR; PG8_WAIT_L(0); PG8_MMA(1, 0, At, B0); PG8_BAR; PG8_SCHED;
            PG8_STAGE(PG8_SB(0, 1), b2 + hstep, voffB);
            PG8_WAIT_V(6); PG8_BAR; PG8_MMA(1, 1, At, B1); PG8_BAR;
            PG8_LDB(B0, 1, 0); PG8_SCHED; PG8_LDA(At, 1, 0); PG8_STAGE(PG8_SA(0, 1), a2 + hstep, voffA);
            PG8_WAIT_L(8); PG8_BAR; PG8_WAIT_L(0); PG8_MMA(0, 0, At, B0); PG8_BAR; PG8_SCHED;
            PG8_LDB(B1, 1, 1); PG8_STAGE(PG8_SB(1, 0), b3, voffB);
            PG8_BAR; PG8_WAIT_L(0); PG8_MMA(0, 1, At, B1); PG8_BAR;
            PG8_LDA(At, 1, 1); PG8_STAGE(PG8_SA(1, 0), a3, voffA);
            PG8_BAR; PG8_WAIT_L(0); PG8_MMA(1, 0, At, B0); PG8_BAR; PG8_SCHED;
            PG8_STAGE(PG8_SB(1, 1), b3 + hstep, voffB);
            PG8_WAIT_V(6); PG8_BAR; PG8_MMA(1, 1, At, B1); PG8_BAR;
            }
        }
        if constexpr (ALIGN_EPI) { if (wr == 0) PG8_BAR; }
        if constexpr (!Epi::AFTER_DRAIN) { E(acc, cur, wr, wc, fr, fq); S.done(cur); }
        if (!has_next) break;
#pragma unroll
        for (int a = 0; a < 2; ++a)
#pragma unroll
            for (int b = 0; b < 2; ++b)
#pragma unroll
                for (int m = 0; m < 4; ++m)
#pragma unroll
                    for (int n = 0; n < 2; ++n) acc[a][b][m][n] = (f32x4){0.f, 0.f, 0.f, 0.f};
        cur = nxt; cA = nA; cB = nB; ++ui;
        if constexpr (ALIGN_EPI) { if (wr == 1) PG8_BAR; }
        if constexpr (SP2 && Epi::NSTORES > 0 && !Epi::AFTER_DRAIN) {
            const char* a1 = cA + kstep; const char* a2 = cA + 2 * kstep; const char* b2 = cB + 2 * kstep; const char* a3 = a2 + kstep; const char* b3 = b2 + kstep;
            PG8_SP2_PAIR(PG8_WAIT_V8_RELAX);
            peeled = true;
        }
    }
    PG8_WAIT_V(0);
    if constexpr (!ALIGN_EPI) { if (wr == 0) PG8_BAR; }
    PG8_BAR;
    if constexpr (Epi::AFTER_DRAIN) { E.fused(acc, cur, wr, wc, fr, fq, lds, wid, lane); S.done(cur); }
#undef PG8_SA
#undef PG8_SB
#undef PG8_STAGE
#undef PG8_LDA
#undef PG8_LDB
#undef PG8_MMA
#undef PG8_WAIT_V
#undef PG8_WAIT_L
#undef PG8_SP2_PAIR
#undef PG8_BAR
#undef PG8_SCHED
}
}
constexpr int BATCH = 8, SEQ = 2048, D = 1024, M = BATCH * SEQ, FF = 2816, NH = 16, HD = 64;
constexpr float EPS = 1e-6f;
constexpr size_t MiB = 1u << 20;
constexpr size_t WS_CTL = 0, WS_SSQ = 65536, CTL_ZERO_BYTES = 65536 + 6 * 65536;
constexpr size_t WS_SUM = 1 * MiB;
constexpr size_t WS_W = 3 * MiB;
constexpr size_t SZ_WIN = (size_t)2 * FF * D * 2, SZ_WOUT = (size_t)D * FF * 2;
constexpr size_t W_FF0 = WS_W, W_FF1 = W_FF0 + SZ_WIN + SZ_WOUT, W_FF2 = W_FF1 + SZ_WIN + SZ_WOUT, W_FF3 = W_FF2 + SZ_WIN + SZ_WOUT;
constexpr size_t W_QKV = W_FF3 + SZ_WIN + SZ_WOUT, W_O = W_QKV + (size_t)3 * D * D * 2, W_LIN = W_O + (size_t)D * D * 2, W_LO = W_LIN + (size_t)2 * D * D * 2;
constexpr size_t W_GR = W_LO + (size_t)D * D * 2, W_GI = W_GR + 16 * 64 * 64 * 2, W_END = W_GI + 16 * 64 * 64 * 2;
constexpr size_t WS_XN = 84 * MiB;
constexpr size_t WS_ACT = 116 * MiB;
constexpr size_t WS_END = WS_ACT + 96 * MiB;
static_assert(W_END <= WS_XN && WS_XN + (size_t)M * D * 2 <= WS_ACT && WS_END <= 256 * MiB && (size_t)M * FF * 2 <= 96 * MiB, "d_ws map");
constexpr int LDS_BYTES = 147456;

#define LAS __attribute__((address_space(3)))
typedef unsigned short bf16;
typedef unsigned v4u __attribute__((ext_vector_type(4)));
typedef unsigned v2u __attribute__((ext_vector_type(2)));
typedef float f32x4 __attribute__((ext_vector_type(4)));
typedef float f32x16 __attribute__((ext_vector_type(16)));
typedef short bf16x8 __attribute__((ext_vector_type(8)));
using pg8::pk_bf16;
__device__ __forceinline__ float bf_lo(unsigned u) { return __uint_as_float(u << 16); }
__device__ __forceinline__ float bf_hi(unsigned u) { return __uint_as_float(u & 0xffff0000u); }
__device__ __forceinline__ float wave_sum(float v) {
#pragma unroll
    for (int o = 1; o < 64; o <<= 1) v += __shfl_xor(v, o);
    return v;
}
#define LOG2E 1.44269504089f
#define LN2 0.69314718056f

__device__ __forceinline__ void transpose_tile(const float* W, const float* gain, int K, int N, int k0, int n0, bf16* WT, int drow0, LAS float* scr, int lane) {
    f32x4 v[8]; float gv[8];
    const int r0 = lane >> 3, c4 = lane & 7;
#pragma unroll
    for (int i = 0; i < 8; ++i) { v[i] = *(const f32x4*)(W + (size_t)(k0 + r0 + 8 * i) * N + n0 + 4 * c4); gv[i] = gain ? gain[k0 + r0 + 8 * i] : 1.0f; }
#pragma unroll
    for (int i = 0; i < 8; ++i) { LAS float* d = scr + (r0 + 8 * i) * 33 + 4 * c4; d[0] = v[i][0] * gv[i]; d[1] = v[i][1] * gv[i]; d[2] = v[i][2] * gv[i]; d[3] = v[i][3] * gv[i]; }
    asm volatile("s_waitcnt lgkmcnt(0)" ::: "memory");
    const int c = lane & 7;
#pragma unroll
    for (int j = 0; j < 4; ++j) { const int n = (lane >> 3) + 8 * j; const LAS float* s = scr + (8 * c) * 33 + n;
        v4u o; o.x = pk_bf16(s[0 * 33], s[1 * 33]); o.y = pk_bf16(s[2 * 33], s[3 * 33]); o.z = pk_bf16(s[4 * 33], s[5 * 33]); o.w = pk_bf16(s[6 * 33], s[7 * 33]);
        *(v4u*)(WT + (size_t)(drow0 + n) * K + k0 + 8 * c) = o; }
    asm volatile("s_waitcnt lgkmcnt(0)" ::: "memory");
}
template <bool SWIGLU> __device__ __forceinline__ void transpose_item(const float* W, const float* gain, int K, int N, bf16* WT, LAS float* scr, int item, int lane) {
    const int nblk = N / 32, kb = item / nblk, nb = item % nblk, n0 = 32 * nb;
    int drow0 = n0;
    if (SWIGLU) { const int up = n0 >= FF, f = up ? n0 - FF : n0; drow0 = 256 * (f >> 7) + (up ? 128 : 0) + (f & 127); }
    transpose_tile(W, gain, K, N, 64 * kb, n0, WT, drow0, scr, lane);
}

__device__ __forceinline__ void cvt_phase(const float* x, bf16* xn, float* ssq, int gw, int ngw, int lane) {
    for (int m = gw; m < M; m += ngw) {
        const f32x4* xr = (const f32x4*)(x + (size_t)m * D) + lane;
        f32x4 v[4]; float s = 0.f;
#pragma unroll
        for (int j = 0; j < 4; ++j) { v[j] = xr[64 * j]; s += (v[j].x * v[j].x + v[j].y * v[j].y) + (v[j].z * v[j].z + v[j].w * v[j].w); }
        s = wave_sum(s);
        if (lane == 0) ssq[m] = s;
        v2u* o = (v2u*)(xn + (size_t)m * D) + lane;
#pragma unroll
        for (int j = 0; j < 4; ++j) { v2u w; w.x = pk_bf16(v[j].x, v[j].y); w.y = pk_bf16(v[j].z, v[j].w); o[64 * j] = w; }
    }
}

constexpr int KP = 72;
constexpr float SB_EXIT = 40.0f * 1.44269504089f;
typedef short v4i16_t __attribute__((ext_vector_type(4)));
__device__ __forceinline__ v2u vtr(const LAS bf16* p) { return __builtin_bit_cast(v2u, __builtin_amdgcn_ds_read_tr16_b64_v4i16((LAS v4i16_t*)p)); }
__device__ __forceinline__ void attn_phase(LAS unsigned char* lds, const bf16* Q, const bf16* K, const bf16* V, bf16* O, const float* qg, const float* kg, int gw, int ngw, int wave_s) {
    int tid_ = wave_s * 64 + lane_id_(); asm volatile("" : "+v"(tid_));
    const int lane = tid_ & 63, w = __builtin_amdgcn_readfirstlane(tid_ >> 6), hi = lane >> 5, ql = lane & 31;
    LAS bf16* Ks = (LAS bf16*)(lds + w * (64 * KP * 2));
    LAS bf16* Vs = Ks + 32 * KP;
    const int skey = lane >> 3, sch = lane & 7;
    const LAS bf16* vtb = Vs + (4 * hi + ((lane & 15) >> 2)) * KP + 16 * ((lane >> 4) & 1) + 4 * (lane & 3);
    for (int wu = gw; wu < BATCH * NH * 64; wu += ngw) {
        const int qblk = wu & 63, bh = wu >> 6, b = bh >> 4, h = bh & 15;
        const int tq = 32 * qblk + ql;
        bf16x8 qf[4];
        {
            const bf16* qp = Q + (size_t)(b * SEQ + tq) * D + h * HD + 8 * hi;
            float qv[4][8]; float ss = 0.f;
#pragma unroll
            for (int s = 0; s < 4; ++s) { const v4u r = *(const v4u*)(qp + 16 * s);
                qv[s][0] = bf_lo(r.x); qv[s][1] = bf_hi(r.x); qv[s][2] = bf_lo(r.y); qv[s][3] = bf_hi(r.y); qv[s][4] = bf_lo(r.z); qv[s][5] = bf_hi(r.z); qv[s][6] = bf_lo(r.w); qv[s][7] = bf_hi(r.w);
#pragma unroll
                for (int j = 0; j < 8; ++j) ss += qv[s][j] * qv[s][j]; }
            ss += __shfl_xor(ss, 32);
            const float rs = (0.125f * LOG2E) * __builtin_amdgcn_rsqf(ss * (1.f / HD) + EPS);
#pragma unroll
            for (int s = 0; s < 4; ++s) { float gp[8];
#pragma unroll
                for (int j = 0; j < 8; ++j) gp[j] = qg[16 * s + 8 * hi + j] * kg[16 * s + 8 * hi + j];
                v4u p;
                p.x = pk_bf16(qv[s][0] * rs * gp[0], qv[s][1] * rs * gp[1]); p.y = pk_bf16(qv[s][2] * rs * gp[2], qv[s][3] * rs * gp[3]);
                p.z = pk_bf16(qv[s][4] * rs * gp[4], qv[s][5] * rs * gp[5]); p.w = pk_bf16(qv[s][6] * rs * gp[6], qv[s][7] * rs * gp[7]);
                qf[s] = __builtin_bit_cast(bf16x8, p); }
        }
        f32x16 o0, o1;
#pragma unroll
        for (int i = 0; i < 16; ++i) { o0[i] = 0.f; o1[i] = 0.f; }
        float R = 0.f;
        v4u krA[4], vrA[4], krB[4], vrB[4];
        int kb = qblk;
        const bf16* kbase = K + (size_t)(b * SEQ + skey) * D + h * HD + 8 * sch;
        const bf16* vbase = V + (size_t)(b * SEQ + skey) * D + h * HD + 8 * sch;
#define ATT_LOAD(KR, VR, KBL) do { _Pragma("unroll") for (int i = 0; i < 4; ++i) { KR[i] = *(const v4u*)(kbase + (size_t)(32 * (KBL) + 8 * i) * D); VR[i] = *(const v4u*)(vbase + (size_t)(32 * (KBL) + 8 * i) * D); } } while (0)
#define ATT_BLOCK(KR, VR, KBC) do { \
            _Pragma("unroll") for (int i = 0; i < 4; ++i) { \
                float kf[8] = {bf_lo(KR[i].x), bf_hi(KR[i].x), bf_lo(KR[i].y), bf_hi(KR[i].y), bf_lo(KR[i].z), bf_hi(KR[i].z), bf_lo(KR[i].w), bf_hi(KR[i].w)}; \
                float ss = 0.f; \
                _Pragma("unroll") for (int j = 0; j < 8; ++j) ss += kf[j] * kf[j]; \
                ss += __uint_as_float(__builtin_amdgcn_mov_dpp(__float_as_uint(ss), 0xB1, 0xF, 0xF, true)); ss += __uint_as_float(__builtin_amdgcn_mov_dpp(__float_as_uint(ss), 0x4E, 0xF, 0xF, true)); ss += __uint_as_float(__builtin_amdgcn_mov_dpp(__float_as_uint(ss), 0x141, 0xF, 0xF, true)); \
                const float rs = __builtin_amdgcn_rsqf(ss * (1.f / HD) + EPS); \
                v4u p_; p_.x = pk_bf16(kf[0] * rs, kf[1] * rs); p_.y = pk_bf16(kf[2] * rs, kf[3] * rs); \
                p_.z = pk_bf16(kf[4] * rs, kf[5] * rs); p_.w = pk_bf16(kf[6] * rs, kf[7] * rs); \
                *(LAS v4u*)(Ks + (skey + 8 * i) * KP + 8 * sch) = p_; \
                *(LAS v4u*)(Vs + (skey + 8 * i) * KP + 8 * sch) = VR[i]; \
            } \
            if ((KBC) >= 2) ATT_LOAD(KR, VR, (KBC) - 2); \
            f32x16 p; \
            _Pragma("unroll") for (int i = 0; i < 16; ++i) p[i] = 0.f; \
            _Pragma("unroll") for (int s = 0; s < 4; ++s) { const bf16x8 kf = *(const LAS bf16x8*)(Ks + ql * KP + 16 * s + 8 * hi); \
                p = __builtin_amdgcn_mfma_f32_32x32x16_bf16(kf, qf[s], p, 0, 0, 0); } \
            const bool diag = ((KBC) == qblk); \
            { \
                float sp[16], lb[16]; \
                _Pragma("unroll") for (int i = 0; i < 16; ++i) { \
                    const float z = p[i]; \
                    const float e = __builtin_amdgcn_exp2f(-fabsf(z)); \
                    const float l = __builtin_amdgcn_logf(1.0f + e); \
                    const int kl = 8 * (i >> 2) + 4 * hi + (i & 3); \
                    const bool valid = !diag || (kl < ql); \
                    sp[i] = valid ? fmaxf(z, 0.f) + l : 0.f; \
                    lb[i] = valid ? fminf(z, 0.f) - l : -1e30f; \
                } \
                float run = R; \
                _Pragma("unroll") for (int g = 3; g >= 0; --g) { \
                    const float Gm = (sp[4 * g] + sp[4 * g + 1]) + (sp[4 * g + 2] + sp[4 * g + 3]); \
                    const float Go = __shfl_xor(Gm, 32); \
                    const float aft = hi ? run : run + Go; \
                    const float e3 = aft, e2 = e3 + sp[4 * g + 3], e1 = e2 + sp[4 * g + 2], e0 = e1 + sp[4 * g + 1]; \
                    p[4 * g + 3] = __builtin_amdgcn_exp2f(lb[4 * g + 3] - e3); \
                    p[4 * g + 2] = __builtin_amdgcn_exp2f(lb[4 * g + 2] - e2); \
                    p[4 * g + 1] = __builtin_amdgcn_exp2f(lb[4 * g + 1] - e1); \
                    p[4 * g + 0] = __builtin_amdgcn_exp2f(lb[4 * g + 0] - e0); \
                    run += Gm + Go; \
                } \
                R = run; \
            } \
            _Pragma("unroll") for (int s2 = 0; s2 < 2; ++s2) { \
                v4u pa; pa.x = pk_bf16(p[8 * s2 + 0], p[8 * s2 + 1]); pa.y = pk_bf16(p[8 * s2 + 2], p[8 * s2 + 3]); \
                pa.z = pk_bf16(p[8 * s2 + 4], p[8 * s2 + 5]); pa.w = pk_bf16(p[8 * s2 + 6], p[8 * s2 + 7]); \
                const bf16x8 pav = __builtin_bit_cast(bf16x8, pa); \
                const LAS bf16* vp = vtb + (16 * s2) * KP; \
                v4u vb; { const v2u a_ = vtr(vp), c_ = vtr(vp + 8 * KP); vb.x = a_.x; vb.y = a_.y; vb.z = c_.x; vb.w = c_.y; } \
                o0 = __builtin_amdgcn_mfma_f32_32x32x16_bf16(pav, __builtin_bit_cast(bf16x8, vb), o0, 0, 0, 0); \
                { const v2u a_ = vtr(vp + 32), c_ = vtr(vp + 8 * KP + 32); vb.x = a_.x; vb.y = a_.y; vb.z = c_.x; vb.w = c_.y; } \
                o1 = __builtin_amdgcn_mfma_f32_32x32x16_bf16(pav, __builtin_bit_cast(bf16x8, vb), o1, 0, 0, 0); \
            } \
            done = ((KBC) == 0) || (__builtin_amdgcn_ballot_w64(R < SB_EXIT) == 0ull); \
        } while (0)
        ATT_LOAD(krA, vrA, kb);
        if (kb >= 1) ATT_LOAD(krB, vrB, kb - 1);
        for (;;) {
            bool done;
            ATT_BLOCK(krA, vrA, kb);
            if (done) break;
            ATT_BLOCK(krB, vrB, kb - 1);
            if (done) break;
            kb -= 2;
        }
#undef ATT_LOAD
#undef ATT_BLOCK
        {
            LAS bf16* Ot = Ks;
#pragma unroll
            for (int i = 0; i < 16; ++i) { const int r = 8 * (i >> 2) + 4 * hi + (i & 3);
                Ot[r * KP + ql] = (bf16)(pk_bf16(o0[i], 0.f) & 0xffffu); Ot[r * KP + 32 + ql] = (bf16)(pk_bf16(o1[i], 0.f) & 0xffffu); }
            bf16* op = O + (size_t)(b * SEQ + 32 * qblk + skey) * D + h * HD + 8 * sch;
#pragma unroll
            for (int i = 0; i < 4; ++i) *(v4u*)(op + (size_t)(8 * i) * D) = *(const LAS v4u*)(Ot + (skey + 8 * i) * KP + 8 * sch);
        }
    }
}

__device__ __forceinline__ void attn_phase2(LAS unsigned char* lds, const bf16* Q, const bf16* K, const bf16* V, bf16* O, const float* qg, const float* kg, int gw, int ngw, int wave_s) {
    int tid_ = wave_s * 64 + lane_id_(); asm volatile("" : "+v"(tid_));
    const int lane = tid_ & 63, w = __builtin_amdgcn_readfirstlane(tid_ >> 6), hi = lane >> 5, ql = lane & 31;
    LAS bf16* Ks = (LAS bf16*)(lds + w * (64 * KP * 2));
    LAS bf16* Vs = Ks + 32 * KP;
    const int skey = lane >> 3, sch = lane & 7;
    const LAS bf16* vtb = Vs + (4 * hi + ((lane & 15) >> 2)) * KP + 16 * ((lane >> 4) & 1) + 4 * (lane & 3);
    for (int wu = gw; wu < BATCH * NH * 32; wu += ngw) {
        const int pq = wu & 31, bh = wu >> 5, b = bh >> 4, h = bh & 15;
        const int qblk0 = 2 * pq, qblk1 = 2 * pq + 1;
        bf16x8 qfa[4], qfb[4];
#define ATT_LOADQ(QF, QBLK) do { \
            const bf16* qp = Q + (size_t)(b * SEQ + 32 * (QBLK) + ql) * D + h * HD + 8 * hi; \
            float qv[4][8]; float ss = 0.f; \
            _Pragma("unroll") for (int s = 0; s < 4; ++s) { const v4u r = *(const v4u*)(qp + 16 * s); \
                qv[s][0] = bf_lo(r.x); qv[s][1] = bf_hi(r.x); qv[s][2] = bf_lo(r.y); qv[s][3] = bf_hi(r.y); qv[s][4] = bf_lo(r.z); qv[s][5] = bf_hi(r.z); qv[s][6] = bf_lo(r.w); qv[s][7] = bf_hi(r.w); \
                _Pragma("unroll") for (int j = 0; j < 8; ++j) ss += qv[s][j] * qv[s][j]; } \
            ss += __shfl_xor(ss, 32); \
            const float rs = (0.125f * LOG2E) * __builtin_amdgcn_rsqf(ss * (1.f / HD) + EPS); \
            _Pragma("unroll") for (int s = 0; s < 4; ++s) { float gp[8]; \
                _Pragma("unroll") for (int j = 0; j < 8; ++j) gp[j] = qg[16 * s + 8 * hi + j] * kg[16 * s + 8 * hi + j]; \
                v4u p; \
                p.x = pk_bf16(qv[s][0] * rs * gp[0], qv[s][1] * rs * gp[1]); p.y = pk_bf16(qv[s][2] * rs * gp[2], qv[s][3] * rs * gp[3]); \
                p.z = pk_bf16(qv[s][4] * rs * gp[4], qv[s][5] * rs * gp[5]); p.w = pk_bf16(qv[s][6] * rs * gp[6], qv[s][7] * rs * gp[7]); \
                QF[s] = __builtin_bit_cast(bf16x8, p); } } while (0)
        ATT_LOADQ(qfa, qblk0);
        ATT_LOADQ(qfb, qblk1);
        f32x16 oa0, oa1, ob0, ob1;
#pragma unroll
        for (int i = 0; i < 16; ++i) { oa0[i] = 0.f; oa1[i] = 0.f; ob0[i] = 0.f; ob1[i] = 0.f; }
        float Ra = 0.f, Rb = 0.f;
        bool da = false, db = false;
        v4u kr[4], vr[4];
        int kb = qblk1;
        const bf16* kbase = K + (size_t)(b * SEQ + skey) * D + h * HD + 8 * sch;
        const bf16* vbase = V + (size_t)(b * SEQ + skey) * D + h * HD + 8 * sch;
#pragma unroll
        for (int i = 0; i < 4; ++i) { kr[i] = *(const v4u*)(kbase + (size_t)(32 * kb + 8 * i) * D); vr[i] = *(const v4u*)(vbase + (size_t)(32 * kb + 8 * i) * D); }
#define ATT_TILE(QF, O0, O1, RR, DIAG) do { \
            f32x16 p; \
            _Pragma("unroll") for (int i = 0; i < 16; ++i) p[i] = 0.f; \
            _Pragma("unroll") for (int s = 0; s < 4; ++s) { const bf16x8 kf = *(const LAS bf16x8*)(Ks + ql * KP + 16 * s + 8 * hi); \
                p = __builtin_amdgcn_mfma_f32_32x32x16_bf16(kf, QF[s], p, 0, 0, 0); } \
            const bool diag = (DIAG); \
            { \
                float sp[16], lb[16]; \
                _Pragma("unroll") for (int i = 0; i < 16; ++i) { \
                    const float z = p[i]; \
                    const float e = __builtin_amdgcn_exp2f(-fabsf(z)); \
                    const float l = __builtin_amdgcn_logf(1.0f + e); \
                    const int kl = 8 * (i >> 2) + 4 * hi + (i & 3); \
                    const bool valid = !diag || (kl < ql); \
                    sp[i] = valid ? fmaxf(z, 0.f) + l : 0.f; \
                    lb[i] = valid ? fminf(z, 0.f) - l : -1e30f; \
                } \
                float run = RR; \
                _Pragma("unroll") for (int g = 3; g >= 0; --g) { \
                    const float Gm = (sp[4 * g] + sp[4 * g + 1]) + (sp[4 * g + 2] + sp[4 * g + 3]); \
                    const float Go = __shfl_xor(Gm, 32); \
                    const float aft = hi ? run : run + Go; \
                    const float e3 = aft, e2 = e3 + sp[4 * g + 3], e1 = e2 + sp[4 * g + 2], e0 = e1 + sp[4 * g + 1]; \
                    p[4 * g + 3] = __builtin_amdgcn_exp2f(lb[4 * g + 3] - e3); \
                    p[4 * g + 2] = __builtin_amdgcn_exp2f(lb[4 * g + 2] - e2); \
                    p[4 * g + 1] = __builtin_amdgcn_exp2f(lb[4 * g + 1] - e1); \
                    p[4 * g + 0] = __builtin_amdgcn_exp2f(lb[4 * g + 0] - e0); \
                    run += Gm + Go; \
                } \
                RR = run; \
            } \
            _Pragma("unroll") for (int s2 = 0; s2 < 2; ++s2) { \
                v4u pa; pa.x = pk_bf16(p[8 * s2 + 0], p[8 * s2 + 1]); pa.y = pk_bf16(p[8 * s2 + 2], p[8 * s2 + 3]); \
                pa.z = pk_bf16(p[8 * s2 + 4], p[8 * s2 + 5]); pa.w = pk_bf16(p[8 * s2 + 6], p[8 * s2 + 7]); \
                const bf16x8 pav = __builtin_bit_cast(bf16x8, pa); \
                const LAS bf16* vp = vtb + (16 * s2) * KP; \
                v4u vb; { const v2u a_ = vtr(vp), c_ = vtr(vp + 8 * KP); vb.x = a_.x; vb.y = a_.y; vb.z = c_.x; vb.w = c_.y; } \
                O0 = __builtin_amdgcn_mfma_f32_32x32x16_bf16(pav, __builtin_bit_cast(bf16x8, vb), O0, 0, 0, 0); \
                { const v2u a_ = vtr(vp + 32), c_ = vtr(vp + 8 * KP + 32); vb.x = a_.x; vb.y = a_.y; vb.z = c_.x; vb.w = c_.y; } \
                O1 = __builtin_amdgcn_mfma_f32_32x32x16_bf16(pav, __builtin_bit_cast(bf16x8, vb), O1, 0, 0, 0); \
            } \
        } while (0)
        for (;;) {
#pragma unroll
            for (int i = 0; i < 4; ++i) {
                float kf[8] = {bf_lo(kr[i].x), bf_hi(kr[i].x), bf_lo(kr[i].y), bf_hi(kr[i].y), bf_lo(kr[i].z), bf_hi(kr[i].z), bf_lo(kr[i].w), bf_hi(kr[i].w)};
                float ss = 0.f;
#pragma unroll
                for (int j = 0; j < 8; ++j) ss += kf[j] * kf[j];
                ss += __uint_as_float(__builtin_amdgcn_mov_dpp(__float_as_uint(ss), 0xB1, 0xF, 0xF, true)); ss += __uint_as_float(__builtin_amdgcn_mov_dpp(__float_as_uint(ss), 0x4E, 0xF, 0xF, true)); ss += __uint_as_float(__builtin_amdgcn_mov_dpp(__float_as_uint(ss), 0x141, 0xF, 0xF, true));
                const float rs = __builtin_amdgcn_rsqf(ss * (1.f / HD) + EPS);
                v4u p_; p_.x = pk_bf16(kf[0] * rs, kf[1] * rs); p_.y = pk_bf16(kf[2] * rs, kf[3] * rs); p_.z = pk_bf16(kf[4] * rs, kf[5] * rs); p_.w = pk_bf16(kf[6] * rs, kf[7] * rs);
                *(LAS v4u*)(Ks + (skey + 8 * i) * KP + 8 * sch) = p_;
                *(LAS v4u*)(Vs + (skey + 8 * i) * KP + 8 * sch) = vr[i];
            }
            if (kb > 0) {
#pragma unroll
                for (int i = 0; i < 4; ++i) { kr[i] = *(const v4u*)(kbase + (size_t)(32 * (kb - 1) + 8 * i) * D); vr[i] = *(const v4u*)(vbase + (size_t)(32 * (kb - 1) + 8 * i) * D); }
            }
            if (!db) { ATT_TILE(qfb, ob0, ob1, Rb, kb == qblk1); db = (__builtin_amdgcn_ballot_w64(Rb < SB_EXIT) == 0ull); }
            if (kb <= qblk0 && !da) { ATT_TILE(qfa, oa0, oa1, Ra, kb == qblk0); da = (__builtin_amdgcn_ballot_w64(Ra < SB_EXIT) == 0ull); }
            if (kb == 0 || (da && db)) break;
            --kb;
        }
#undef ATT_LOADQ
#undef ATT_TILE
#define ATT_STORE(O0, O1, QBLK) do { \
            LAS bf16* Ot = Ks; \
            _Pragma("unroll") for (int i = 0; i < 16; ++i) { const int r = 8 * (i >> 2) + 4 * hi + (i & 3); \
                Ot[r * KP + ql] = (bf16)(pk_bf16(O0[i], 0.f) & 0xffffu); Ot[r * KP + 32 + ql] = (bf16)(pk_bf16(O1[i], 0.f) & 0xffffu); } \
            bf16* op = O + (size_t)(b * SEQ + 32 * (QBLK) + skey) * D + h * HD + 8 * sch; \
            _Pragma("unroll") for (int i = 0; i < 4; ++i) *(v4u*)(op + (size_t)(8 * i) * D) = *(const LAS v4u*)(Ot + (skey + 8 * i) * KP + 8 * sch); } while (0)
        ATT_STORE(oa0, oa1, qblk0);
        ATT_STORE(ob0, ob1, qblk1);
#undef ATT_STORE
    }
}

constexpr int LT = 128, NCH = SEQ / LT;
#define LDS_BARRIER() do { asm volatile("s_waitcnt lgkmcnt(0)" ::: "memory"); __builtin_amdgcn_s_barrier(); asm volatile("" ::: "memory"); } while (0)
__device__ __forceinline__ void lru_phase(LAS unsigned char* lds, const bf16* XB, const bf16* Y, bf16* HY, const bf16* WRt, const bf16* WIt,
        const float* convw, const float* convb, const float* br, const float* bi, const float* lam, unsigned long long* gran, int G, int bid, int wave_s) {
    int tid = wave_s * 64 + lane_id_(); asm volatile("" : "+v"(tid));
    const int lane = tid & 63, w = __builtin_amdgcn_readfirstlane(tid >> 6), hi = lane >> 5, ql = lane & 31;
    LAS float* xcF = (LAS float*)lds;
    LAS bf16* wL = (LAS bf16*)(lds + 32768);
    LAS bf16* xcB = (LAS bf16*)(lds + 65536);
    LAS float* segA = (LAS float*)(lds + 65536 + 128 * KP * 2);
    LAS float* segH = segA + 512;
    LAS float* pA = segH + 512;
    LAS float* pH = pA + 1024;
    LAS bf16* yL = (LAS bf16*)(lds + 65536 + 128 * KP * 2 + 16384);
    const int st = tid >> 3, cc = 8 * (tid & 7);
    LAS float* parL = (LAS float*)(lds + 118784);
    int n_loaded = -1;
    const int rb = w >> 1, cbk = w & 1, d = 32 * cbk + ql;
    v4u xt[2][4], yv[2];
#define LRU_LOAD_X(u_) do { const int ch_ = (u_) >> 7, bn_ = (u_) & 127, b_ = bn_ >> 4, n_ = bn_ & 15, t0_ = ch_ * LT, c0_ = 64 * n_; \
        _Pragma("unroll") for (int r = 0; r < 2; ++r) { yv[r] = *(const v4u*)(Y + (size_t)(b_ * SEQ + t0_ + st + 64 * r) * D + c0_ + cc); \
            _Pragma("unroll") for (int j = 0; j < 4; ++j) { const int ts = t0_ + st + 64 * r + j - 3; xt[r][j] = ts >= 0 ? *(const v4u*)(XB + (size_t)(b_ * SEQ + ts) * D + c0_ + cc) : (v4u){0u, 0u, 0u, 0u}; } } } while (0)
    if (bid < BATCH * 16 * NCH) LRU_LOAD_X(bid);
    for (int unit = bid; unit < BATCH * 16 * NCH; unit += G) {
        const int ch = unit >> 7, bn = unit & 127, b = bn >> 4, n = bn & 15;
        const int t0 = ch * LT, c0 = 64 * n;
        if (n != n_loaded) {
            LDS_BARRIER();
            if (tid < 256) parL[tid] = convw[(tid >> 6) * D + c0 + (tid & 63)];
            else if (tid < 320) parL[tid] = convb[c0 + tid - 256];
            else if (tid < 384) parL[tid] = br[c0 + tid - 320];
            else if (tid < 448) parL[tid] = bi[c0 + tid - 384];
            else { const float lm = lam[c0 + tid - 448]; parL[tid] = -8.0f * (fmaxf(-lm, 0.f) + __builtin_amdgcn_logf(1.0f + __builtin_amdgcn_exp2f(-fabsf(lm) * LOG2E)) * LN2); }
#pragma unroll
            for (int r = 0; r < 2; ++r) { const int e = tid + 512 * r, gate = e >> 9, row = (e >> 3) & 63, chk = e & 7;
                *(LAS v4u*)(wL + (gate * 64 + row) * KP + 8 * chk) = *(const v4u*)((gate ? WIt : WRt) + (size_t)n * 4096 + row * 64 + 8 * chk); }
            n_loaded = n;
        }
        LDS_BARRIER();
        {
            float cw[4][8], cb[8];
#pragma unroll
            for (int j = 0; j < 4; ++j) { const f32x4 c0v = *(const LAS f32x4*)(parL + j * 64 + cc), c1v = *(const LAS f32x4*)(parL + j * 64 + cc + 4);
                cw[j][0] = c0v[0]; cw[j][1] = c0v[1]; cw[j][2] = c0v[2]; cw[j][3] = c0v[3]; cw[j][4] = c1v[0]; cw[j][5] = c1v[1]; cw[j][6] = c1v[2]; cw[j][7] = c1v[3]; }
            { const f32x4 c0v = *(const LAS f32x4*)(parL + 256 + cc), c1v = *(const LAS f32x4*)(parL + 256 + cc + 4);
                cb[0] = c0v[0]; cb[1] = c0v[1]; cb[2] = c0v[2]; cb[3] = c0v[3]; cb[4] = c1v[0]; cb[5] = c1v[1]; cb[6] = c1v[2]; cb[7] = c1v[3]; }
#pragma unroll
            for (int r = 0; r < 2; ++r) {
                const int t = st + 64 * r;
                float acc[8];
#pragma unroll
                for (int e = 0; e < 8; ++e) acc[e] = cb[e];
#pragma unroll
                for (int j = 0; j < 4; ++j) {
                    const v4u x = xt[r][j];
                    acc[0] += cw[j][0] * bf_lo(x.x); acc[1] += cw[j][1] * bf_hi(x.x); acc[2] += cw[j][2] * bf_lo(x.y); acc[3] += cw[j][3] * bf_hi(x.y);
                    acc[4] += cw[j][4] * bf_lo(x.z); acc[5] += cw[j][5] * bf_hi(x.z); acc[6] += cw[j][6] * bf_lo(x.w); acc[7] += cw[j][7] * bf_hi(x.w);
                }
                *(LAS f32x4*)(xcF + t * 64 + cc) = (f32x4){acc[0], acc[1], acc[2], acc[3]}; *(LAS f32x4*)(xcF + t * 64 + cc + 4) = (f32x4){acc[4], acc[5], acc[6], acc[7]};
                v4u p; p.x = pk_bf16(acc[0], acc[1]); p.y = pk_bf16(acc[2], acc[3]); p.z = pk_bf16(acc[4], acc[5]); p.w = pk_bf16(acc[6], acc[7]);
                *(LAS v4u*)(xcB + t * KP + cc) = p;
                *(LAS v4u*)(yL + t * KP + cc) = yv[r];
            }
        }
        if (unit + G < BATCH * 16 * NCH) LRU_LOAD_X(unit + G);
        LDS_BARRIER();
        unsigned xa[2] = {0u, 0u}, xh[2] = {0u, 0u}, xt_[2] = {0u, 0u};
#pragma unroll
        for (int q = 0; q < 2; ++q) { const int kk = w + 8 * q;
            if (kk < ch) { const unsigned long long* g = gran + ((size_t)(b * NCH + kk) * D + c0 + lane) * 2;
                const unsigned long long ya = __hip_atomic_load(g, __ATOMIC_RELAXED, __HIP_MEMORY_SCOPE_AGENT), yh = __hip_atomic_load(g + 1, __ATOMIC_RELAXED, __HIP_MEMORY_SCOPE_AGENT);
                xa[q] = (unsigned)ya; xh[q] = (unsigned)yh; xt_[q] = (unsigned)(ya >> 32) & (unsigned)(yh >> 32); } }
        float av[16], uv[16];
        const int c = lane, sg = 2 * rb + hi, tb = 32 * rb + 16 * hi;
        {
            f32x16 pr, pi;
#pragma unroll
            for (int i = 0; i < 16; ++i) { pr[i] = 0.f; pi[i] = 0.f; }
            const int trow = 32 * rb + 16 * ((ql >> 2) & 1) + 4 * (ql >> 3) + (ql & 3);
#pragma unroll
            for (int s = 0; s < 4; ++s) {
                const bf16x8 af = *(const LAS bf16x8*)(xcB + trow * KP + 16 * s + 8 * hi);
                const bf16x8 wr_ = *(const LAS bf16x8*)(wL + d * KP + 16 * s + 8 * hi), wi_ = *(const LAS bf16x8*)(wL + (64 + d) * KP + 16 * s + 8 * hi);
                pr = __builtin_amdgcn_mfma_f32_32x32x16_bf16(af, wr_, pr, 0, 0, 0);
                pi = __builtin_amdgcn_mfma_f32_32x32x16_bf16(af, wi_, pi, 0, 0, 0);
            }
            const float brv = parL[320 + d], biv = parL[384 + d], ls8 = parL[448 + d];
            float A = 1.f, H = 0.f;
#pragma unroll
            for (int i = 0; i < 16; ++i) {
                const float r = pg8::fast_sigmoid(pr[i] + brv), ig = pg8::fast_sigmoid(pi[i] + biv);
                const float la = ls8 * r;
                const float a = __builtin_amdgcn_exp2f(la * LOG2E);
                const float mult = __builtin_amdgcn_sqrtf(fmaxf(1.0f - a * a, 0.f));
                const float u = mult * ig * xcF[(tb + i) * 64 + d];
                av[i] = a; uv[i] = u; H = a * H + u; A *= a;
            }
            segA[sg * 64 + d] = A; segH[sg * 64 + d] = H;
        }
        LDS_BARRIER();
        if (w == 0 && ch < NCH - 1) {
            float At = 1.f, Ht = 0.f;
#pragma unroll
            for (int s = 0; s < 8; ++s) { const float a = segA[s * 64 + c], hh = segH[s * 64 + c]; Ht = a * Ht + hh; At *= a; }
            unsigned long long* g = gran + ((size_t)(b * NCH + ch) * D + c0 + c) * 2;
            __hip_atomic_store(g, (1ull << 32) | (unsigned long long)__float_as_uint(At), __ATOMIC_RELAXED, __HIP_MEMORY_SCOPE_AGENT);
            __hip_atomic_store(g + 1, (1ull << 32) | (unsigned long long)__float_as_uint(Ht), __ATOMIC_RELAXED, __HIP_MEMORY_SCOPE_AGENT);
        }
#pragma unroll
        for (int q = 0; q < 2; ++q) { const int kk = w + 8 * q;
            if (kk < ch) {
                const unsigned long long* g = gran + ((size_t)(b * NCH + kk) * D + c0 + c) * 2;
                for (unsigned spins = 0; spins < (1u << 22); ++spins) {
                    if (__all(xt_[q] == 1u)) break;
                    __builtin_amdgcn_s_sleep(1);
                    const unsigned long long ya = __hip_atomic_load(g, __ATOMIC_RELAXED, __HIP_MEMORY_SCOPE_AGENT), yh = __hip_atomic_load(g + 1, __ATOMIC_RELAXED, __HIP_MEMORY_SCOPE_AGENT);
                    xa[q] = (unsigned)ya; xh[q] = (unsigned)yh; xt_[q] = (unsigned)(ya >> 32) & (unsigned)(yh >> 32); }
                pA[kk * 64 + c] = __uint_as_float(xa[q]); pH[kk * 64 + c] = __uint_as_float(xh[q]);
            } }
        LDS_BARRIER();
        {
            float h = 0.f;
            for (int kk = 0; kk < ch; ++kk) h = pA[kk * 64 + d] * h + pH[kk * 64 + d];
            for (int s = 0; s < 7; ++s) { if (s < sg) h = segA[s * 64 + d] * h + segH[s * 64 + d]; }
#pragma unroll
            for (int i = 0; i < 16; ++i) { const int t = tb + i; h = av[i] * h + uv[i];
                const float yv_ = __uint_as_float((unsigned)yL[t * KP + d] << 16);
                xcB[t * KP + d] = (bf16)(pk_bf16(h * yv_, 0.f) & 0xffffu); }
        }
        LDS_BARRIER();
#pragma unroll
        for (int r = 0; r < 2; ++r) *(v4u*)(HY + (size_t)(b * SEQ + t0 + st + 64 * r) * D + c0 + cc) = *(const LAS v4u*)(xcB + (st + 64 * r) * KP + cc);
    }
}

#define RLX_AGENT __ATOMIC_RELAXED, __HIP_MEMORY_SCOPE_AGENT
#define XB_TMO      128
#define XB_XCNT(j)  (256  + 64 * (j))
#define XB_XSUB(j)  (1280 + 64 * (j))
#define XB_XGEN(j)  (2304 + 64 * (j))
#define XB_TOP      3328
#define XB_TOPGEN   3392
#define XCD_BAR_WORDS 3456
#define XB_SPIN_CAP (1u << 18)

__device__ __forceinline__ unsigned xb_ld(unsigned* p)              { return __hip_atomic_load(p, __ATOMIC_RELAXED, __HIP_MEMORY_SCOPE_AGENT); }
__device__ __forceinline__ unsigned xb_add(unsigned* p, unsigned v) { return __hip_atomic_fetch_add(p, v, __ATOMIC_RELAXED, __HIP_MEMORY_SCOPE_AGENT); }
__device__ __forceinline__ unsigned xb_xcc_id() { return (unsigned)__builtin_amdgcn_s_getreg((3 << 11) | 20) & 0xFu; }
#define XB_SPIN(cond, bar) do { unsigned _sp = 0; while (cond) { __builtin_amdgcn_s_sleep(1); \
    if ((++_sp & 255u) == 0u) { if (xb_ld(&(bar)[XB_TMO])) break; if (_sp > XB_SPIN_CAP) { atomicAdd(&(bar)[XB_TMO], 1u); break; } } } } while (0)

struct XcdBarrier {
    unsigned* bar; unsigned x;
    volatile LAS unsigned* st;
};

__device__ __forceinline__ XcdBarrier xcd_barrier_post(unsigned* bar, volatile LAS unsigned* st, bool is_t0) {
    XcdBarrier b; b.bar = bar; b.x = xb_xcc_id(); b.st = st;
    if (is_t0) (void)xb_add(&bar[XB_XCNT(b.x)], 1u);
    return b;
}
__device__ __forceinline__ void xcd_barrier_complete(unsigned* bar, unsigned x, unsigned& nloc, unsigned& nx) {
    const unsigned G = gridDim.x * gridDim.y * gridDim.z;
    unsigned sum, cnt, mine, sp = 0u;
    for (;;) {
        sum = 0u; cnt = 0u; mine = 0u;
#pragma unroll
        for (unsigned j = 0; j < 16; ++j) { const unsigned c = xb_ld(&bar[XB_XCNT(j)]); sum += c; cnt += (c > 0u) ? 1u : 0u; mine = (j == x) ? c : mine; }
        if (sum == G) break;
        __builtin_amdgcn_s_sleep(1);
        if ((++sp & 255u) == 0u) { if (xb_ld(&bar[XB_TMO])) break; if (sp > XB_SPIN_CAP) { atomicAdd(&bar[XB_TMO], 1u); break; } }
    }
    nloc = mine > 0u ? mine : 1u; nx = cnt > 0u ? cnt : 1u;
}

__device__ __forceinline__ void xcd_barrier(const XcdBarrier& b, int wave_s) {
    asm volatile("s_waitcnt vmcnt(0)" ::: "memory");
    __syncthreads();
    if (wave_s == 0 && lane_id_() == 0) {
        unsigned* bar = b.bar;
        __builtin_amdgcn_s_waitcnt(0);
        unsigned nloc = b.st[0], nx = b.st[1];
        if (nloc == 0u) { xcd_barrier_complete(bar, b.x, nloc, nx); b.st[0] = nloc; b.st[1] = nx; }
        const unsigned old = xb_add(&bar[XB_XSUB(b.x)], 1u);
        const unsigned gen = old / nloc;
        if (old + 1u == (gen + 1u) * nloc) {
            __builtin_amdgcn_fence(__ATOMIC_RELEASE, "agent");
            asm volatile("s_waitcnt vmcnt(0)" ::: "memory");
            const unsigned og = xb_add(&bar[XB_TOP], 1u);
            const unsigned tg = og / nx;
            if (og + 1u == (tg + 1u) * nx) xb_add(&bar[XB_TOPGEN], 1u);
            else XB_SPIN(xb_ld(&bar[XB_TOPGEN]) == tg, bar);
            __builtin_amdgcn_fence(__ATOMIC_ACQUIRE, "agent");
            xb_add(&bar[XB_XGEN(b.x)], 1u);
            asm volatile("s_waitcnt vmcnt(0)" ::: "memory");
        } else {
            XB_SPIN(xb_ld(&bar[XB_XGEN(b.x)]) == gen, bar);
            __builtin_amdgcn_fence(__ATOMIC_ACQUIRE, "agent");
            asm volatile("s_waitcnt vmcnt(0)" ::: "memory");
        }
    }
    __syncthreads();
}

__device__ __forceinline__ int launder_s_(int k) { asm volatile("" : "+s"(k)); return k; }
struct Args { const float* in[28]; float* out; unsigned char* ws; };
__global__ void __launch_bounds__(512, 2) fwd_megakernel(Args a) {
    const float* const* kin_ = (const float* const*)__builtin_amdgcn_kernarg_segment_ptr();
#define AIN(k) (kin_[launder_s_(k)])
    extern __shared__ __attribute__((aligned(16))) unsigned char lds_raw[];
    cg::grid_group grid = cg::this_grid();
    LAS unsigned char* lds = (LAS unsigned char*)lds_raw;
    const int tid = threadIdx.x, lane = tid & 63, wave = __builtin_amdgcn_readfirstlane(tid >> 6);
    const int G = gridDim.x, bid = blockIdx.x;
    const int gw = bid * 8 + wave, ngw = G * 8;
    unsigned char* ws = a.ws;
    bf16* XN = (bf16*)(ws + WS_XN); bf16* ACT = (bf16*)(ws + WS_ACT);
    bf16* QB = ACT; bf16* KB = ACT + (size_t)M * D; bf16* VB = ACT + (size_t)2 * M * D;
    volatile LAS unsigned* MISC = (volatile LAS unsigned*)(lds + 131072 + 4096);
    if (tid < 2) MISC[tid] = 0u;
    __syncthreads();
    const XcdBarrier xbar = xcd_barrier_post((unsigned*)(ws + WS_CTL), MISC, tid == 0);

    float* SSQ = (float*)(ws + WS_SSQ);
#define SSQ_AT(s) (SSQ + (size_t)(s) * M)
    constexpr int I_IN = (D / 64) * (2 * FF / 32), I_OUT = (FF / 64) * (D / 32), I_QKV = (D / 64) * (3 * D / 32), I_SQ = (D / 64) * (D / 32), I_LIN = (D / 64) * (2 * D / 32), I_G = 16 * 2;
    constexpr int SEG0 = I_IN, SEG1 = SEG0 + I_OUT + I_QKV + I_SQ + I_IN, SEG2 = SEG1 + I_OUT + I_IN + I_OUT, SEG3 = SEG2 + I_LIN + I_SQ + 2 * I_G + I_IN + I_OUT;
#define FFW(f) (ws + W_FF0 + (size_t)(f) * (SZ_WIN + SZ_WOUT))
#define CONVERT_ITEMS(lo_, hi_, wk_, nwk_) do { LAS float* scr = (LAS float*)(lds + wave * 16384); int tl_ = lane_id_(); asm volatile("" : "+v"(tl_)); const int lane = tl_; \
        for (int it = (lo_) + (wk_); it < (hi_); it += (nwk_)) { int r = it; \
            if (r < I_IN) { transpose_item<true>(AIN(2), AIN(1), D, 2 * FF, (bf16*)FFW(0), scr, r, lane); continue; } r -= I_IN; \
            if (r < I_OUT) { transpose_item<false>(AIN(3), nullptr, FF, D, (bf16*)(FFW(0) + SZ_WIN), scr, r, lane); continue; } r -= I_OUT; \
            if (r < I_QKV) { transpose_item<false>(AIN(5), AIN(4), D, 3 * D, (bf16*)(ws + W_QKV), scr, r, lane); continue; } r -= I_QKV; \
            if (r < I_SQ) { transpose_item<false>(AIN(8), nullptr, D, D, (bf16*)(ws + W_O), scr, r, lane); continue; } r -= I_SQ; \
            if (r < I_IN) { transpose_item<true>(AIN(10), AIN(9), D, 2 * FF, (bf16*)FFW(1), scr, r, lane); continue; } r -= I_IN; \
            if (r < I_OUT) { transpose_item<false>(AIN(11), nullptr, FF, D, (bf16*)(FFW(1) + SZ_WIN), scr, r, lane); continue; } r -= I_OUT; \
            if (r < I_IN) { transpose_item<true>(AIN(13), AIN(12), D, 2 * FF, (bf16*)FFW(2), scr, r, lane); continue; } r -= I_IN; \
            if (r < I_OUT) { transpose_item<false>(AIN(14), nullptr, FF, D, (bf16*)(FFW(2) + SZ_WIN), scr, r, lane); continue; } r -= I_OUT; \
            if (r < I_LIN) { transpose_item<false>(AIN(16), AIN(15), D, 2 * D, (bf16*)(ws + W_LIN), scr, r, lane); continue; } r -= I_LIN; \
            if (r < I_SQ) { transpose_item<false>(AIN(24), nullptr, D, D, (bf16*)(ws + W_LO), scr, r, lane); continue; } r -= I_SQ; \
            if (r < I_G) { transpose_item<false>(AIN(19) + (size_t)(r >> 1) * 4096, nullptr, 64, 64, (bf16*)(ws + W_GR) + (size_t)(r >> 1) * 4096, scr, r & 1, lane); continue; } r -= I_G; \
            if (r < I_G) { transpose_item<false>(AIN(21) + (size_t)(r >> 1) * 4096, nullptr, 64, 64, (bf16*)(ws + W_GI) + (size_t)(r >> 1) * 4096, scr, r & 1, lane); continue; } r -= I_G; \
            if (r < I_IN) { transpose_item<true>(AIN(26), AIN(25), D, 2 * FF, (bf16*)FFW(3), scr, r, lane); continue; } r -= I_IN; \
            transpose_item<false>(AIN(27), nullptr, FF, D, (bf16*)(FFW(3) + SZ_WIN), scr, r, lane); } } while (0)
    const int ffn_units = (M / 256) * (2 * FF / 256), ffn_rounds = (ffn_units + G - 1) / G, idle_from = ffn_units - (ffn_rounds - 1) * G;
#define CONVERT_IN_TAIL(lo_, hi_) do { if (idle_from < G) { if (bid >= idle_from) CONVERT_ITEMS(lo_, hi_, (bid - idle_from) * 8 + wave, (G - idle_from) * 8); } \
        else CONVERT_ITEMS(lo_, hi_, gw, ngw); } while (0)
    {
        CONVERT_ITEMS(0, SEG0, gw, ngw);
        cvt_phase(AIN(0), XN, SSQ_AT(0), gw, ngw, lane);
        for (int i = bid * 512 + tid; i < 2 * BATCH * NCH * D; i += G * 512) ((unsigned long long*)(ws + WS_SUM))[i] = 0ull;
    }
#define SEAM() xcd_barrier(xbar, wave)
    if (a.ws == nullptr) grid.sync();
    SEAM();
#define GEMM(EPI, Aptr, Wptr, NN, KK, E) do { pg8::Gemm g{(Aptr), (const bf16*)(Wptr), M, (NN), (KK)}; pg8::StaticOrder S; S.init(M, (NN), G, bid); \
        pg8::gemm_phase<EPI, pg8::StaticOrder, true, true>(lds, g, S, (E), wave); } while (0)
#define FFN(widx, s_in, FIRST, LAST, TLO, THI) do { \
        { pg8::EpiSwiglu E{ACT, FF, SSQ_AT(s_in)}; GEMM(pg8::EpiSwiglu, XN, ws + W_FF0 + (size_t)(widx) * (SZ_WIN + SZ_WOUT), 2 * FF, D, E); } \
        if ((TLO) < (THI)) CONVERT_IN_TAIL(TLO, THI); \
        SEAM(); \
        { typedef pg8::EpiResid<FIRST, LAST, true> EpiR; EpiR E{AIN(0), ((float*)AIN(28)), XN, SSQ_AT((s_in) + 1)}; GEMM(EpiR, ACT, ws + W_FF0 + (size_t)(widx) * (SZ_WIN + SZ_WOUT) + SZ_WIN, D, FF, E); } \
        } while (0)

    FFN(0, 0, false, false, SEG0, SEG1);
    SEAM();
    { pg8::EpiSplit<99> E{ACT, (size_t)M * D, SSQ_AT(1)}; GEMM(pg8::EpiSplit<99>, XN, ws + W_QKV, 3 * D, D, E); }
    SEAM();
    { const int vcu = (G % 8 == 0) ? (bid % 8) * (G / 8) + bid / 8 : bid;
      attn_phase2(lds, QB, KB, VB, QB, AIN(6), AIN(7), vcu * 8 + wave, ngw, wave); }
    SEAM();
    { typedef pg8::EpiResid<false, false, false> EpiR; EpiR E{AIN(0), ((float*)AIN(28)), XN, SSQ_AT(2)}; GEMM(EpiR, QB, ws + W_O, D, D, E); }
    SEAM();
    FFN(1, 2, false, false, SEG1, SEG2);
    SEAM();
    FFN(2, 3, false, false, SEG2, SEG3);
    SEAM();
    { pg8::EpiSplit<1> E{ACT, (size_t)M * D, SSQ_AT(4)}; GEMM(pg8::EpiSplit<1>, XN, ws + W_LIN, 2 * D, D, E); }
    SEAM();
    lru_phase(lds, QB, KB, VB, (const bf16*)(ws + W_GR), (const bf16*)(ws + W_GI), AIN(17), AIN(18), AIN(20), AIN(22), AIN(23), (unsigned long long*)(ws + WS_SUM), G, (G % 8 == 0) ? (bid % 8) * (G / 8) + bid / 8 : bid, wave);
    SEAM();
    { typedef pg8::EpiResid<false, false, false> EpiR; EpiR E{AIN(0), ((float*)AIN(28)), XN, SSQ_AT(5)}; GEMM(EpiR, VB, ws + W_LO, D, D, E); }
    SEAM();
    FFN(3, 5, false, true, 0, 0);
}

extern "C" void kernel_launch(void* const* d_in, const int* in_sizes, int n_in, void* d_out, int out_size, void* d_ws, size_t ws_size, hipStream_t stream) {
    static int grid = 0;
    if (grid == 0) {
        if (n_in != 28 || out_size != M * D || ws_size < WS_END) { fprintf(stderr, "kernel_launch: unexpected problem (n_in %d out %d ws %zu)\n", n_in, out_size, ws_size); grid = -1; return; }
        int dev = 0, cus = 0, per_cu = 0;
        hipGetDevice(&dev); hipDeviceGetAttribute(&cus, hipDeviceAttributeMultiprocessorCount, dev);
        if (hipFuncSetAttribute((const void*)fwd_megakernel, hipFuncAttributeMaxDynamicSharedMemorySize, LDS_BYTES) != hipSuccess) { fprintf(stderr, "kernel_launch: hipFuncSetAttribute failed\n"); grid = -1; return; }
        if (hipOccupancyMaxActiveBlocksPerMultiprocessor(&per_cu, (const void*)fwd_megakernel, 512, LDS_BYTES) != hipSuccess || per_cu < 1) { fprintf(stderr, "kernel_launch: occupancy query says %d\n", per_cu); per_cu = 1; }
        (void)hipGetLastError();
        grid = cus * per_cu;
    }
    if (grid < 0) return;
    if (hipMemsetAsync((char*)d_ws + WS_CTL, 0, CTL_ZERO_BYTES, stream) != hipSuccess) { fprintf(stderr, "memset failed\n"); return; }
    Args a{};
    for (int i = 0; i < 28; ++i) a.in[i] = (const float*)d_in[i];
    a.out = (float*)d_out; a.ws = (unsigned char*)d_ws;
    void* args[] = {&a};
    hipError_t e = hipLaunchCooperativeKernel((const void*)fwd_megakernel, dim3(grid), dim3(512), args, LDS_BYTES, stream);
    if (e != hipSuccess) fprintf(stderr, "cooperative launch failed: %s (grid %d)\n", hipGetErrorString(e), grid);
}
```

```cpp
#include <hip/hip_runtime.h>
#include <hip/hip_cooperative_groups.h>
#include <cstdio>
#include <cstdint>
namespace cg = cooperative_groups;
__device__ __forceinline__ int lane_id_() { int l; asm volatile("v_mbcnt_lo_u32_b32 %0, -1, 0\n\tv_mbcnt_hi_u32_b32 %0, -1, %0" : "=v"(l)); return l; }
namespace pg8 {
#define PG8_LAS __attribute__((address_space(3)))
typedef unsigned short bf16_t;
typedef short bf16x8 __attribute__((ext_vector_type(8)));
typedef float f32x4 __attribute__((ext_vector_type(4)));
typedef unsigned u32x4 __attribute__((ext_vector_type(4)));
constexpr int BM = 256, BK = 64, HALF = 128, HTB = HALF * BK * 2  , STAGE_BYTES = 8 * HTB, NXCD = 8, WGM = 8;

__host__ __device__ __forceinline__ int lds_byte(int r, int c) { const int st = (r >> 4) * 2 + (c >> 5), rr = r & 15, cc = c & 31, ob = rr * 64 + cc * 2; return st * 1024 + (ob ^ (((ob >> 9) & 1) << 5)); }
__host__ __device__ __forceinline__ void stage_rc(int b, int& R, int& C) { const int st = b / 1024, sb = b % 1024, swz = sb ^ (((sb >> 9) & 1) << 5); R = (st >> 1) * 16 + swz / 64; C = (st & 1) * 32 + (swz % 64) / 2; }
__host__ __device__ __forceinline__ int perm32(int rho) { const int n = rho >> 4, i = rho & 15; return 8 * (i >> 2) + 4 * n + (i & 3); }

constexpr int PRE_SLOT = 136192;
struct Unit { int pm, pn; };
struct Gemm { const bf16_t* A; const bf16_t* Bt; int M, N, K; };

struct StaticOrder {
    int nM, nN, nwg, G, c;
    __host__ __device__ void init(int M, int N, int G_, int c_) { nM = M / BM; nN = N / BM; nwg = nM * nN; G = G_; c = c_; }
    __host__ __device__ bool next(int i, Unit& u) const {
        const long L = (long)i * G + c; if (L >= nwg) return false;
        int wgid = (int)L; { const int q = nwg / NXCD, r = nwg % NXCD, xcd = wgid % NXCD, off = wgid / NXCD; wgid = (xcd < r ? xcd * (q + 1) : r * (q + 1) + (xcd - r) * q) + off; }
        const int nig = WGM * nN, gid = wgid / nig, fm = gid * WGM, gsz = (nM - fm) < WGM ? (nM - fm) : WGM;
        u.pm = fm + ((wgid % nig) % gsz); u.pn = (wgid % nig) / gsz; return true;
    }
    __device__ __forceinline__ void a_ready(const Unit&) const {}
    __device__ __forceinline__ void done(const Unit&) const {}
};

__device__ __forceinline__ unsigned cvt_pk_bf16(float lo, float hi) { unsigned r; asm volatile("v_cvt_pk_bf16_f32 %0, %1, %2" : "=v"(r) : "v"(lo), "v"(hi)); return r; }
typedef float f32x2 __attribute__((ext_vector_type(2)));
__device__ __forceinline__ unsigned pk_bf16(float lo, float hi) { typedef __bf16 b2_t __attribute__((ext_vector_type(2))); f32x2 v = {lo, hi}; b2_t b = __builtin_convertvector(v, b2_t); return __builtin_bit_cast(unsigned, b); }
__device__ __forceinline__ float fast_sigmoid(float v) { return __builtin_amdgcn_rcpf(1.0f + __builtin_amdgcn_exp2f(-1.44269504089f * v)); }
struct EpiSwiglu {
    static constexpr bool PERM = true, AFTER_DRAIN = false; static constexpr int NSTORES = 8;
    static constexpr int NPRE = 2;
    __device__ __forceinline__ void prefetch(PG8_LAS unsigned char* lds, int wid, const Unit& u, int wr, int fr, int fq) const {
        { const int l_ = lane_id_(); fr = l_ & 15; fq = l_ >> 4; }
#pragma unroll
        for (int j = 0; j < 2; ++j) { const int i = 2 * fq + j;
            __builtin_amdgcn_global_load_lds((const unsigned*)(ssq + u.pm * BM + wr * 64 + fr + (i >> 2) * HALF + (i & 3) * 16), (PG8_LAS unsigned*)(lds + PRE_SLOT + wid * 512 + j * 256), 4, 0, 0); }
    }
    bf16_t* H; int ldh; const float* ssq;
    __device__ __forceinline__ void operator()(const f32x4 (&acc)[2][2][4][2], const Unit& u, int wr, int wc, int fr, int fq, PG8_LAS unsigned char* lds, int wid) const {
        const int row0 = u.pm * BM + wr * 64 + fr, col0 = u.pn * HALF + wc * 32 + 8 * fq;
#pragma unroll
        for (int ai = 0; ai < 2; ++ai)
#pragma unroll
            for (int m = 0; m < 4; ++m) {
                bf16_t* p = H + (size_t)(row0 + ai * HALF + m * 16) * ldh + col0;
                const float rstd = __builtin_amdgcn_rsqf(*(const PG8_LAS float*)(lds + PRE_SLOT + wid * 512 + (m & 1) * 256 + (fr + 16 * ((ai * 4 + m) >> 1)) * 4) * (1.0f / 1024.0f) + 1e-6f);
                float h[8];
#pragma unroll
                for (int n = 0; n < 2; ++n)
#pragma unroll
                    for (int j = 0; j < 4; ++j) { const float g = acc[ai][0][m][n][j] * rstd, up = acc[ai][1][m][n][j] * rstd; h[4 * n + j] = g * fast_sigmoid(g) * up; }
                u32x4 w; w.x = pk_bf16(h[0], h[1]); w.y = pk_bf16(h[2], h[3]); w.z = pk_bf16(h[4], h[5]); w.w = pk_bf16(h[6], h[7]);
                *(u32x4*)p = w;
            }
    }
};
template <bool FIRST, bool LAST, bool HALF_ALPHA> struct EpiResid {
    static constexpr bool PERM = true, AFTER_DRAIN = false; static constexpr int NSTORES = 0;
    static constexpr int NPRE = 0;
    __device__ __forceinline__ void prefetch(PG8_LAS unsigned char*, int, const Unit&, int, int, int) const {}
    const float* base32; float* out32; bf16_t* xn; float* ssq;
    __device__ __forceinline__ void operator()(const f32x4 (&acc)[2][2][4][2], const Unit& u, int wr, int wc, int fr, int fq, PG8_LAS unsigned char*, int) const {
        const int row0 = u.pm * BM + wr * 64 + fr, col0 = u.pn * BM + wc * 32 + 8 * fq;
        constexpr float alpha = HALF_ALPHA ? 0.5f : 1.0f;
#pragma unroll
        for (int ai = 0; ai < 2; ++ai)
#pragma unroll
            for (int m = 0; m < 4; ++m) {
                float s = 0.f;
#pragma unroll
                for (int bj = 0; bj < 2; ++bj) {
                    const size_t off = (size_t)(row0 + ai * HALF + m * 16) * 1024 + col0 + bj * HALF;
                    f32x4 b0, b1;
                    if (FIRST) { b0 = *(const f32x4*)(base32 + off); b1 = *(const f32x4*)(base32 + off + 4); }
                    else { const u32x4 r = *(const u32x4*)(xn + off);
                        b0 = (f32x4){__uint_as_float(r.x << 16), __uint_as_float(r.x & 0xffff0000u), __uint_as_float(r.y << 16), __uint_as_float(r.y & 0xffff0000u)};
                        b1 = (f32x4){__uint_as_float(r.z << 16), __uint_as_float(r.z & 0xffff0000u), __uint_as_float(r.w << 16), __uint_as_float(r.w & 0xffff0000u)}; }
                    const f32x4 v0 = b0 + alpha * acc[ai][bj][m][0], v1 = b1 + alpha * acc[ai][bj][m][1];
                    if (LAST) { *(f32x4*)(out32 + off) = v0; *(f32x4*)(out32 + off + 4) = v1; }
                    else {
                        u32x4 w; w.x = pk_bf16(v0[0], v0[1]); w.y = pk_bf16(v0[2], v0[3]); w.z = pk_bf16(v1[0], v1[1]); w.w = pk_bf16(v1[2], v1[3]);
                        *(u32x4*)(xn + off) = w;
                        const float r0 = __uint_as_float(w.x << 16), r1 = __uint_as_float(w.x & 0xffff0000u), r2 = __uint_as_float(w.y << 16), r3 = __uint_as_float(w.y & 0xffff0000u);
                        const float r4 = __uint_as_float(w.z << 16), r5 = __uint_as_float(w.z & 0xffff0000u), r6 = __uint_as_float(w.w << 16), r7 = __uint_as_float(w.w & 0xffff0000u);
                        s += (r0 * r0 + r1 * r1) + (r2 * r2 + r3 * r3) + (r4 * r4 + r5 * r5) + (r6 * r6 + r7 * r7);
                    }
                }
                if (!LAST) { s += __shfl_xor(s, 16); s += __shfl_xor(s, 32); if (fq == 0) __hip_atomic_fetch_add(ssq + row0 + ai * HALF + m * 16, s, __ATOMIC_RELAXED, __HIP_MEMORY_SCOPE_AGENT); }
            }
    }
};
template <int GELU_FROM> struct EpiSplit {
    static constexpr bool PERM = true, AFTER_DRAIN = false; static constexpr int NSTORES = 16;
    static constexpr int NPRE = 2;
    __device__ __forceinline__ void prefetch(PG8_LAS unsigned char* lds, int wid, const Unit& u, int wr, int fr, int fq) const {
        { const int l_ = lane_id_(); fr = l_ & 15; fq = l_ >> 4; }
#pragma unroll
        for (int j = 0; j < 2; ++j) { const int i = 2 * fq + j;
            __builtin_amdgcn_global_load_lds((const unsigned*)(ssq + u.pm * BM + wr * 64 + fr + (i >> 2) * HALF + (i & 3) * 16), (PG8_LAS unsigned*)(lds + PRE_SLOT + wid * 512 + j * 256), 4, 0, 0); }
    }
    bf16_t* O; size_t split_stride; const float* ssq;
    __device__ __forceinline__ void operator()(const f32x4 (&acc)[2][2][4][2], const Unit& u, int wr, int wc, int fr, int fq, PG8_LAS unsigned char* lds, int wid) const {
        const int t = u.pn >> 2; bf16_t* basep = O + (size_t)t * split_stride;
        const int row0 = u.pm * BM + wr * 64 + fr, col0 = (u.pn & 3) * BM + wc * 32 + 8 * fq;
        const bool act = t >= GELU_FROM;
#pragma unroll
        for (int ai = 0; ai < 2; ++ai)
#pragma unroll
            for (int m = 0; m < 4; ++m) {
                const float rstd = __builtin_amdgcn_rsqf(*(const PG8_LAS float*)(lds + PRE_SLOT + wid * 512 + (m & 1) * 256 + (fr + 16 * ((ai * 4 + m) >> 1)) * 4) * (1.0f / 1024.0f) + 1e-6f);
#pragma unroll
                for (int bj = 0; bj < 2; ++bj) {
                    float h[8];
#pragma unroll
                    for (int n = 0; n < 2; ++n)
#pragma unroll
                        for (int j = 0; j < 4; ++j) { float v = acc[ai][bj][m][n][j] * rstd;
                            if (act) { const float z = 1.5957691216f * (v + 0.044715f * v * v * v); v = v * fast_sigmoid(z); }
                            h[4 * n + j] = v; }
                    u32x4 w; w.x = pk_bf16(h[0], h[1]); w.y = pk_bf16(h[2], h[3]); w.z = pk_bf16(h[4], h[5]); w.w = pk_bf16(h[6], h[7]);
                    *(u32x4*)(basep + (size_t)(row0 + ai * HALF + m * 16) * 1024 + col0 + bj * HALF) = w;
                }
            }
    }
};
template <class Epi, class Sched, bool ALIGN_EPI = false, bool SP2 = false>
__device__ __forceinline__ void gemm_phase(PG8_LAS unsigned char* lds, const Gemm g, const Sched& S, const Epi& E, int wave_s) {
    int tid = wave_s * 64 + lane_id_(); asm volatile("" : "+v"(tid));
    const int wid = __builtin_amdgcn_readfirstlane(tid >> 6), lane = tid & 63, wr = wid >> 2, wc = wid & 3, fr = lane & 15, fq = lane >> 4;
    const int K = g.K, nt = K / BK;
    unsigned voffA[2], voffB[2];
#pragma unroll
    for (int i = 0; i < 2; ++i) { int R, C; stage_rc(tid * 16 + i * 8192, R, C); const int Rb = Epi::PERM ? ((R & ~31) + perm32(R & 31)) : R;
        voffA[i] = (unsigned)(R * K + C) * 2u; voffB[i] = (unsigned)(Rb * K + C) * 2u; }
    const size_t kstep = (size_t)(BK * 2);
    const size_t hstep = (size_t)HALF * K * 2;
    const size_t tstep = 2 * hstep;
    const unsigned ldsw = (unsigned)wid * 1024u;
    const int aoff = lds_byte(wr * 64 + fr, fq * 8), boff = lds_byte(wc * 32 + fr, fq * 8);
#define PG8_SA(b, h) (((b) * 2 + (h)) * HTB)
#define PG8_SB(b, h) ((4 + (b) * 2 + (h)) * HTB)
#define PG8_STAGE(bufoff, gbase, voff) do { const char* gb_ = (const char*)(gbase); asm volatile("" : "+s"(gb_));   \
        _Pragma("unroll") for (int _i = 0; _i < 2; ++_i) \
        __builtin_amdgcn_global_load_lds((const unsigned*)(gb_ + (voff)[_i]), (PG8_LAS unsigned*)(lds + (bufoff) + ldsw + _i * 8192), 16, 0, 0); } while (0)
#define PG8_LDA(dst, b, h) do { _Pragma("unroll") for (int m = 0; m < 4; ++m) _Pragma("unroll") for (int k = 0; k < 2; ++k) dst[m][k] = *(const PG8_LAS bf16x8*)(lds + PG8_SA(b, h) + aoff + m * 2048 + k * 1024); } while (0)
#define PG8_LDB(dst, b, h) do { _Pragma("unroll") for (int n = 0; n < 2; ++n) _Pragma("unroll") for (int k = 0; k < 2; ++k) dst[n][k] = *(const PG8_LAS bf16x8*)(lds + PG8_SB(b, h) + boff + n * 2048 + k * 1024); } while (0)
#define PG8_MMA(ai, bj, At, Bt) do { __builtin_amdgcn_s_setprio(1); _Pragma("unroll") for (int m = 0; m < 4; ++m) _Pragma("unroll") for (int n = 0; n < 2; ++n) _Pragma("unroll") for (int k = 0; k < 2; ++k) \
        acc[ai][bj][m][n] = __builtin_amdgcn_mfma_f32_16x16x32_bf16(Bt[n][k], At[m][k], acc[ai][bj][m][n], 0, 0, 0); __builtin_amdgcn_s_setprio(0); } while (0)
#define PG8_WAIT_V(n) asm volatile("s_waitcnt vmcnt(" #n ")" ::: "memory")
#define PG8_WAIT_L(n) asm volatile("s_waitcnt lgkmcnt(" #n ")" ::: "memory")
#define PG8_WAIT_V8_STRICT() asm volatile("s_waitcnt vmcnt(8)" ::: "memory")
#define PG8_WAIT_V8_RELAX() do { if constexpr (Epi::NSTORES + Epi::NPRE == 10) asm volatile("s_waitcnt vmcnt(18)" ::: "memory"); else if constexpr (Epi::NSTORES + Epi::NPRE == 18) asm volatile("s_waitcnt vmcnt(26)" ::: "memory"); else asm volatile("s_waitcnt vmcnt(8)" ::: "memory"); } while (0)
#define PG8_BAR __builtin_amdgcn_s_barrier()
#define PG8_SCHED __builtin_amdgcn_sched_barrier(0)
#define PG8_SP2_PAIR(WAITM) do { \
            PG8_LDB(B0, 0, 0); PG8_LDB(B1, 0, 1); PG8_SCHED; PG8_LDA(At, 0, 0); PG8_STAGE(PG8_SA(1, 1), a1 + hstep, voffA); \
            WAITM(); PG8_WAIT_L(0); PG8_BAR; PG8_MMA(0, 0, At, B0); PG8_MMA(0, 1, At, B1); PG8_BAR; PG8_SCHED; \
            PG8_LDA(At, 0, 1); PG8_STAGE(PG8_SB(0, 0), b2, voffB); PG8_STAGE(PG8_SB(0, 1), b2 + hstep, voffB); PG8_STAGE(PG8_SA(0, 0), a2, voffA); \
            WAITM(); PG8_WAIT_L(0); PG8_BAR; PG8_MMA(1, 0, At, B0); PG8_MMA(1, 1, At, B1); PG8_BAR; PG8_SCHED; \
            PG8_LDB(B0, 1, 0); PG8_LDB(B1, 1, 1); PG8_SCHED; PG8_LDA(At, 1, 0); PG8_STAGE(PG8_SA(0, 1), a2 + hstep, voffA); \
            WAITM(); PG8_WAIT_L(0); PG8_BAR; PG8_MMA(0, 0, At, B0); PG8_MMA(0, 1, At, B1); PG8_BAR; PG8_SCHED; \
            PG8_LDA(At, 1, 1); PG8_STAGE(PG8_SB(1, 0), b3, voffB); PG8_STAGE(PG8_SB(1, 1), b3 + hstep, voffB); PG8_STAGE(PG8_SA(1, 0), a3, voffA); \
            WAITM(); PG8_WAIT_L(0); PG8_BAR; PG8_MMA(1, 0, At, B0); PG8_MMA(1, 1, At, B1); PG8_BAR; PG8_SCHED; \
            } while (0)
    Unit cur, nxt; int ui = 0; bool peeled = false;
    if (!S.next(0, cur)) return;
    if constexpr (Epi::NPRE > 0) E.prefetch(lds, wid, cur, wr, fr, fq);
    f32x4 acc[2][2][4][2];
#pragma unroll
    for (int a = 0; a < 2; ++a)
#pragma unroll
        for (int b = 0; b < 2; ++b)
#pragma unroll
            for (int m = 0; m < 4; ++m)
#pragma unroll
                for (int n = 0; n < 2; ++n) acc[a][b][m][n] = (f32x4){0.f, 0.f, 0.f, 0.f};
    bf16x8 At[4][2], B0[2][2], B1[2][2];
    const char* cA = (const char*)g.A + (size_t)cur.pm * tstep; const char* cB = (const char*)g.Bt + (size_t)cur.pn * tstep;
    S.a_ready(cur);
    if constexpr (SP2) {
        PG8_STAGE(PG8_SB(0, 0), cB, voffB); PG8_STAGE(PG8_SB(0, 1), cB + hstep, voffB); PG8_STAGE(PG8_SA(0, 0), cA, voffA); PG8_STAGE(PG8_SA(0, 1), cA + hstep, voffA);
        if (wr == 1) PG8_BAR;
        PG8_WAIT_V(2); PG8_BAR;
        PG8_STAGE(PG8_SB(1, 0), cB + kstep, voffB); PG8_STAGE(PG8_SA(1, 0), cA + kstep, voffA); PG8_STAGE(PG8_SB(1, 1), cB + hstep + kstep, voffB);
        PG8_WAIT_V(6); PG8_BAR;
    } else {
        PG8_STAGE(PG8_SB(0, 0), cB, voffB); PG8_STAGE(PG8_SA(0, 0), cA, voffA); PG8_STAGE(PG8_SB(0, 1), cB + hstep, voffB); PG8_STAGE(PG8_SA(0, 1), cA + hstep, voffA);
        if (wr == 1) PG8_BAR;
        PG8_WAIT_V(4); PG8_BAR;
        PG8_STAGE(PG8_SB(1, 0), cB + kstep, voffB); PG8_STAGE(PG8_SA(1, 0), cA + kstep, voffA); PG8_STAGE(PG8_SB(1, 1), cB + hstep + kstep, voffB);
        PG8_WAIT_V(6); PG8_BAR;
    }
    for (;;) {
        const bool has_next = S.next(ui + 1, nxt);
        const char* nA = has_next ? (const char*)g.A + (size_t)nxt.pm * tstep : cA; const char* nB = has_next ? (const char*)g.Bt + (size_t)nxt.pn * tstep : cB;
        for (int t = peeled ? 2 : 0; t < nt; t += 2) {
            const bool last = (t == nt - 2);
            const char* a1 = cA + (size_t)(t + 1) * kstep;
            const char* a2 = last ? nA : cA + (size_t)(t + 2) * kstep; const char* b2 = last ? nB : cB + (size_t)(t + 2) * kstep;
            const char* a3 = a2 + kstep; const char* b3 = b2 + kstep;
            if (last && has_next) S.a_ready(nxt);
            if constexpr (SP2) {
            PG8_SP2_PAIR(PG8_WAIT_V8_STRICT);
            } else {
            PG8_LDB(B0, 0, 0); PG8_SCHED; PG8_LDA(At, 0, 0); PG8_STAGE(PG8_SA(1, 1), a1 + hstep, voffA);
            PG8_WAIT_L(8); PG8_BAR; PG8_WAIT_L(0); PG8_MMA(0, 0, At, B0); PG8_BAR; PG8_SCHED;
            PG8_LDB(B1, 0, 1); PG8_STAGE(PG8_SB(0, 0), b2, voffB);
            PG8_BAR; PG8_WAIT_L(0); PG8_MMA(0, 1, At, B1); PG8_BAR;
            PG8_LDA(At, 0, 1); PG8_STAGE(PG8_SA(0, 0), a2, voffA);
            PG8_BAR; PG8_WAIT_L(0); PG8_MMA(1, 0, At, B0); PG8_BAR; PG8_SCHED;
            PG8_STAGE(PG8_SB(0, 1), b2 + hstep, voffB);
            PG8_WAIT_V(6); PG8_BAR; PG8_MMA(1, 1, At, B1); PG8_BAR;
            PG8_LDB(B0, 1, 0); PG8_SCHED; PG8_LDA(At, 1, 0); PG8_STAGE(PG8_SA(0, 1), a2 + hstep, voffA);
            PG8_WAIT_L(8); PG8_BAR; PG8_WAIT_L(0); PG8_MMA(0, 0, At, B0); PG8_BAR; PG8_SCHED;
            PG8_LDB(B1, 1, 1); PG8_STAGE(PG8_SB(1, 0), b3, voffB);
            PG8_BAR; PG8_WAIT_L(0); PG8_MMA(0, 1, At, B1); PG8_BAR;
            PG8_LDA(At, 1, 1); PG8_STAGE(PG8_SA(1, 0), a3, voffA);
            PG8_BAR; PG8_WAIT_L(0); PG8_MMA(1, 0, At, B0); PG8_BAR; PG8_SCHED;
            PG8_STAGE(PG8_SB(1, 1), b3 + hstep, voffB);
            PG8_WAIT_V(6); PG8_BAR; PG8_MMA(1, 1, At, B1); PG8_BAR;
            }
        }
        if constexpr (ALIGN_EPI) { if (wr == 0) PG8_BAR; }
        if constexpr (!Epi::AFTER_DRAIN) { E(acc, cur, wr, wc, fr, fq, lds, wid); S.done(cur); }
        if (!has_next) break;
#pragma unroll
        for (int a = 0; a < 2; ++a)
#pragma unroll
            for (int b = 0; b < 2; ++b)
#pragma unroll
                for (int m = 0; m < 4; ++m)
#pragma unroll
                    for (int n = 0; n < 2; ++n) acc[a][b][m][n] = (f32x4){0.f, 0.f, 0.f, 0.f};
        cur = nxt; cA = nA; cB = nB; ++ui;
        if constexpr (ALIGN_EPI) { if (wr == 1) PG8_BAR; }
        if constexpr (Epi::NPRE > 0) E.prefetch(lds, wid, cur, wr, fr, fq);
        if constexpr (SP2 && Epi::NSTORES > 0 && !Epi::AFTER_DRAIN) {
            const char* a1 = cA + kstep; const char* a2 = cA + 2 * kstep; const char* b2 = cB + 2 * kstep; const char* a3 = a2 + kstep; const char* b3 = b2 + kstep;
            PG8_SP2_PAIR(PG8_WAIT_V8_RELAX);
            peeled = true;
        }
    }
    PG8_WAIT_V(0);
    if constexpr (!ALIGN_EPI) { if (wr == 0) PG8_BAR; }
    PG8_BAR;
    if constexpr (Epi::AFTER_DRAIN) { E.fused(acc, cur, wr, wc, fr, fq, lds, wid, lane); S.done(cur); }
#undef PG8_SA
#undef PG8_SB
#undef PG8_STAGE
#undef PG8_LDA
#undef PG8_LDB
#undef PG8_MMA
#undef PG8_WAIT_V
#undef PG8_WAIT_L
#undef PG8_SP2_PAIR
#undef PG8_BAR
#undef PG8_SCHED
}
}
constexpr int BATCH = 8, SEQ = 2048, D = 1024, M = BATCH * SEQ, FF = 2816, NH = 16, HD = 64;
constexpr float EPS = 1e-6f;
constexpr size_t MiB = 1u << 20;
constexpr size_t WS_CTL = 0, WS_SSQ = 65536, CTL_ZERO_BYTES = 65536 + 6 * 65536;
constexpr size_t WS_SUM = 1 * MiB;
constexpr size_t WS_W = 3 * MiB;
constexpr size_t SZ_WIN = (size_t)2 * FF * D * 2, SZ_WOUT = (size_t)D * FF * 2;
constexpr size_t W_FF0 = WS_W, W_FF1 = W_FF0 + SZ_WIN + SZ_WOUT, W_FF2 = W_FF1 + SZ_WIN + SZ_WOUT, W_FF3 = W_FF2 + SZ_WIN + SZ_WOUT;
constexpr size_t W_QKV = W_FF3 + SZ_WIN + SZ_WOUT, W_O = W_QKV + (size_t)3 * D * D * 2, W_LIN = W_O + (size_t)D * D * 2, W_LO = W_LIN + (size_t)2 * D * D * 2;
constexpr size_t W_GR = W_LO + (size_t)D * D * 2, W_GI = W_GR + 16 * 64 * 64 * 2, W_END = W_GI + 16 * 64 * 64 * 2;
constexpr size_t WS_XN = 84 * MiB;
constexpr size_t WS_ACT = 116 * MiB;
constexpr size_t WS_END = WS_ACT + 96 * MiB;
static_assert(W_END <= WS_XN && WS_XN + (size_t)M * D * 2 <= WS_ACT && WS_END <= 256 * MiB && (size_t)M * FF * 2 <= 96 * MiB, "d_ws map");
constexpr int LDS_BYTES = 147456;

#define LAS __attribute__((address_space(3)))
typedef unsigned short bf16;
typedef unsigned v4u __attribute__((ext_vector_type(4)));
typedef unsigned v2u __attribute__((ext_vector_type(2)));
typedef float f32x4 __attribute__((ext_vector_type(4)));
typedef float f32x16 __attribute__((ext_vector_type(16)));
typedef short bf16x8 __attribute__((ext_vector_type(8)));
using pg8::pk_bf16;
__device__ __forceinline__ float bf_lo(unsigned u) { return __uint_as_float(u << 16); }
__device__ __forceinline__ float bf_hi(unsigned u) { return __uint_as_float(u & 0xffff0000u); }
__device__ __forceinline__ float wave_sum(float v) {
#pragma unroll
    for (int o = 1; o < 64; o <<= 1) v += __shfl_xor(v, o);
    return v;
}
#define LOG2E 1.44269504089f
#define LN2 0.69314718056f

__device__ __forceinline__ void transpose_tile(const float* W, const float* gain, int K, int N, int k0, int n0, bf16* WT, int drow0, LAS float* scr, int lane) {
    f32x4 v[8]; float gv[8];
    const int r0 = lane >> 3, c4 = lane & 7;
#pragma unroll
    for (int i = 0; i < 8; ++i) { v[i] = *(const f32x4*)(W + (size_t)(k0 + r0 + 8 * i) * N + n0 + 4 * c4); gv[i] = gain ? gain[k0 + r0 + 8 * i] : 1.0f; }
#pragma unroll
    for (int i = 0; i < 8; ++i) { LAS float* d = scr + (r0 + 8 * i) * 33 + 4 * c4; d[0] = v[i][0] * gv[i]; d[1] = v[i][1] * gv[i]; d[2] = v[i][2] * gv[i]; d[3] = v[i][3] * gv[i]; }
    asm volatile("s_waitcnt lgkmcnt(0)" ::: "memory");
    const int c = lane & 7;
#pragma unroll
    for (int j = 0; j < 4; ++j) { const int n = (lane >> 3) + 8 * j; const LAS float* s = scr + (8 * c) * 33 + n;
        v4u o; o.x = pk_bf16(s[0 * 33], s[1 * 33]); o.y = pk_bf16(s[2 * 33], s[3 * 33]); o.z = pk_bf16(s[4 * 33], s[5 * 33]); o.w = pk_bf16(s[6 * 33], s[7 * 33]);
        *(v4u*)(WT + (size_t)(drow0 + n) * K + k0 + 8 * c) = o; }
    asm volatile("s_waitcnt lgkmcnt(0)" ::: "memory");
}
template <bool SWIGLU> __device__ __forceinline__ void transpose_item(const float* W, const float* gain, int K, int N, bf16* WT, LAS float* scr, int item, int lane) {
    const int nblk = N / 32, kb = item / nblk, nb = item % nblk, n0 = 32 * nb;
    int drow0 = n0;
    if (SWIGLU) { const int up = n0 >= FF, f = up ? n0 - FF : n0; drow0 = 256 * (f >> 7) + (up ? 128 : 0) + (f & 127); }
    transpose_tile(W, gain, K, N, 64 * kb, n0, WT, drow0, scr, lane);
}

__device__ __forceinline__ void cvt_phase(const float* x, bf16* xn, float* ssq, int gw, int ngw, int lane) {
    for (int m = gw; m < M; m += ngw) {
        const f32x4* xr = (const f32x4*)(x + (size_t)m * D) + lane;
        f32x4 v[4]; float s = 0.f;
#pragma unroll
        for (int j = 0; j < 4; ++j) { v[j] = xr[64 * j]; s += (v[j].x * v[j].x + v[j].y * v[j].y) + (v[j].z * v[j].z + v[j].w * v[j].w); }
        s = wave_sum(s);
        if (lane == 0) ssq[m] = s;
        v2u* o = (v2u*)(xn + (size_t)m * D) + lane;
#pragma unroll
        for (int j = 0; j < 4; ++j) { v2u w; w.x = pk_bf16(v[j].x, v[j].y); w.y = pk_bf16(v[j].z, v[j].w); o[64 * j] = w; }
    }
}

constexpr int KP = 72;
constexpr float SB_EXIT = 40.0f * 1.44269504089f;
typedef short v4i16_t __attribute__((ext_vector_type(4)));
__device__ __forceinline__ v2u vtr(const LAS bf16* p) { return __builtin_bit_cast(v2u, __builtin_amdgcn_ds_read_tr16_b64_v4i16((LAS v4i16_t*)p)); }
__device__ __forceinline__ void attn_phase(LAS unsigned char* lds, const bf16* Q, const bf16* K, const bf16* V, bf16* O, const float* qg, const float* kg, int gw, int ngw, int wave_s) {
    int tid_ = wave_s * 64 + lane_id_(); asm volatile("" : "+v"(tid_));
    const int lane = tid_ & 63, w = __builtin_amdgcn_readfirstlane(tid_ >> 6), hi = lane >> 5, ql = lane & 31;
    LAS bf16* Ks = (LAS bf16*)(lds + w * (64 * KP * 2));
    LAS bf16* Vs = Ks + 32 * KP;
    const int skey = lane >> 3, sch = lane & 7;
    const LAS bf16* vtb = Vs + (4 * hi + ((lane & 15) >> 2)) * KP + 16 * ((lane >> 4) & 1) + 4 * (lane & 3);
    for (int wu = gw; wu < BATCH * NH * 64; wu += ngw) {
        const int qblk = wu & 63, bh = wu >> 6, b = bh >> 4, h = bh & 15;
        const int tq = 32 * qblk + ql;
        bf16x8 qf[4];
        {
            const bf16* qp = Q + (size_t)(b * SEQ + tq) * D + h * HD + 8 * hi;
            float qv[4][8]; float ss = 0.f;
#pragma unroll
            for (int s = 0; s < 4; ++s) { const v4u r = *(const v4u*)(qp + 16 * s);
                qv[s][0] = bf_lo(r.x); qv[s][1] = bf_hi(r.x); qv[s][2] = bf_lo(r.y); qv[s][3] = bf_hi(r.y); qv[s][4] = bf_lo(r.z); qv[s][5] = bf_hi(r.z); qv[s][6] = bf_lo(r.w); qv[s][7] = bf_hi(r.w);
#pragma unroll
                for (int j = 0; j < 8; ++j) ss += qv[s][j] * qv[s][j]; }
            ss += __shfl_xor(ss, 32);
            const float rs = (0.125f * LOG2E) * __builtin_amdgcn_rsqf(ss * (1.f / HD) + EPS);
#pragma unroll
            for (int s = 0; s < 4; ++s) { float gp[8];
#pragma unroll
                for (int j = 0; j < 8; ++j) gp[j] = qg[16 * s + 8 * hi + j] * kg[16 * s + 8 * hi + j];
                v4u p;
                p.x = pk_bf16(qv[s][0] * rs * gp[0], qv[s][1] * rs * gp[1]); p.y = pk_bf16(qv[s][2] * rs * gp[2], qv[s][3] * rs * gp[3]);
                p.z = pk_bf16(qv[s][4] * rs * gp[4], qv[s][5] * rs * gp[5]); p.w = pk_bf16(qv[s][6] * rs * gp[6], qv[s][7] * rs * gp[7]);
                qf[s] = __builtin_bit_cast(bf16x8, p); }
        }
        f32x16 o0, o1;
#pragma unroll
        for (int i = 0; i < 16; ++i) { o0[i] = 0.f; o1[i] = 0.f; }
        float R = 0.f;
        v4u krA[4], vrA[4], krB[4], vrB[4];
        int kb = qblk;
        const bf16* kbase = K + (size_t)(b * SEQ + skey) * D + h * HD + 8 * sch;
        const bf16* vbase = V + (size_t)(b * SEQ + skey) * D + h * HD + 8 * sch;
#define ATT_LOAD(KR, VR, KBL) do { _Pragma("unroll") for (int i = 0; i < 4; ++i) { KR[i] = *(const v4u*)(kbase + (size_t)(32 * (KBL) + 8 * i) * D); VR[i] = *(const v4u*)(vbase + (size_t)(32 * (KBL) + 8 * i) * D); } } while (0)
#define ATT_BLOCK(KR, VR, KBC) do { \
            _Pragma("unroll") for (int i = 0; i < 4; ++i) { \
                float kf[8] = {bf_lo(KR[i].x), bf_hi(KR[i].x), bf_lo(KR[i].y), bf_hi(KR[i].y), bf_lo(KR[i].z), bf_hi(KR[i].z), bf_lo(KR[i].w), bf_hi(KR[i].w)}; \
                float ss = 0.f; \
                _Pragma("unroll") for (int j = 0; j < 8; ++j) ss += kf[j] * kf[j]; \
                ss += __uint_as_float(__builtin_amdgcn_mov_dpp(__float_as_uint(ss), 0xB1, 0xF, 0xF, true)); ss += __uint_as_float(__builtin_amdgcn_mov_dpp(__float_as_uint(ss), 0x4E, 0xF, 0xF, true)); ss += __uint_as_float(__builtin_amdgcn_mov_dpp(__float_as_uint(ss), 0x141, 0xF, 0xF, true)); \
                const float rs = __builtin_amdgcn_rsqf(ss * (1.f / HD) + EPS); \
                v4u p_; p_.x = pk_bf16(kf[0] * rs, kf[1] * rs); p_.y = pk_bf16(kf[2] * rs, kf[3] * rs); \
                p_.z = pk_bf16(kf[4] * rs, kf[5] * rs); p_.w = pk_bf16(kf[6] * rs, kf[7] * rs); \
                *(LAS v4u*)(Ks + (skey + 8 * i) * KP + 8 * sch) = p_; \
                *(LAS v4u*)(Vs + (skey + 8 * i) * KP + 8 * sch) = VR[i]; \
            } \
            if ((KBC) >= 2) ATT_LOAD(KR, VR, (KBC) - 2); \
            f32x16 p; \
            _Pragma("unroll") for (int i = 0; i < 16; ++i) p[i] = 0.f; \
            _Pragma("unroll") for (int s = 0; s < 4; ++s) { const bf16x8 kf = *(const LAS bf16x8*)(Ks + ql * KP + 16 * s + 8 * hi); \
                p = __builtin_amdgcn_mfma_f32_32x32x16_bf16(kf, qf[s], p, 0, 0, 0); } \
            const bool diag = ((KBC) == qblk); \
            { \
                float sp[16], lb[16]; \
                _Pragma("unroll") for (int i = 0; i < 16; ++i) { \
                    const float z = p[i]; \
                    const float e = __builtin_amdgcn_exp2f(-fabsf(z)); \
                    const float l = __builtin_amdgcn_logf(1.0f + e); \
                    const int kl = 8 * (i >> 2) + 4 * hi + (i & 3); \
                    const bool valid = !diag || (kl < ql); \
                    sp[i] = valid ? fmaxf(z, 0.f) + l : 0.f; \
                    lb[i] = valid ? fminf(z, 0.f) - l : -1e30f; \
                } \
                float run = R; \
                _Pragma("unroll") for (int g = 3; g >= 0; --g) { \
                    const float Gm = (sp[4 * g] + sp[4 * g + 1]) + (sp[4 * g + 2] + sp[4 * g + 3]); \
                    const float Go = __shfl_xor(Gm, 32); \
                    const float aft = hi ? run : run + Go; \
                    const float e3 = aft, e2 = e3 + sp[4 * g + 3], e1 = e2 + sp[4 * g + 2], e0 = e1 + sp[4 * g + 1]; \
                    p[4 * g + 3] = __builtin_amdgcn_exp2f(lb[4 * g + 3] - e3); \
                    p[4 * g + 2] = __builtin_amdgcn_exp2f(lb[4 * g + 2] - e2); \
                    p[4 * g + 1] = __builtin_amdgcn_exp2f(lb[4 * g + 1] - e1); \
                    p[4 * g + 0] = __builtin_amdgcn_exp2f(lb[4 * g + 0] - e0); \
                    run += Gm + Go; \
                } \
                R = run; \
            } \
            _Pragma("unroll") for (int s2 = 0; s2 < 2; ++s2) { \
                v4u pa; pa.x = pk_bf16(p[8 * s2 + 0], p[8 * s2 + 1]); pa.y = pk_bf16(p[8 * s2 + 2], p[8 * s2 + 3]); \
                pa.z = pk_bf16(p[8 * s2 + 4], p[8 * s2 + 5]); pa.w = pk_bf16(p[8 * s2 + 6], p[8 * s2 + 7]); \
                const bf16x8 pav = __builtin_bit_cast(bf16x8, pa); \
                const LAS bf16* vp = vtb + (16 * s2) * KP; \
                v4u vb; { const v2u a_ = vtr(vp), c_ = vtr(vp + 8 * KP); vb.x = a_.x; vb.y = a_.y; vb.z = c_.x; vb.w = c_.y; } \
                o0 = __builtin_amdgcn_mfma_f32_32x32x16_bf16(pav, __builtin_bit_cast(bf16x8, vb), o0, 0, 0, 0); \
                { const v2u a_ = vtr(vp + 32), c_ = vtr(vp + 8 * KP + 32); vb.x = a_.x; vb.y = a_.y; vb.z = c_.x; vb.w = c_.y; } \
                o1 = __builtin_amdgcn_mfma_f32_32x32x16_bf16(pav, __builtin_bit_cast(bf16x8, vb), o1, 0, 0, 0); \
            } \
            done = ((KBC) == 0) || (__builtin_amdgcn_ballot_w64(R < SB_EXIT) == 0ull); \
        } while (0)
        ATT_LOAD(krA, vrA, kb);
        if (kb >= 1) ATT_LOAD(krB, vrB, kb - 1);
        for (;;) {
            bool done;
            ATT_BLOCK(krA, vrA, kb);
            if (done) break;
            ATT_BLOCK(krB, vrB, kb - 1);
            if (done) break;
            kb -= 2;
        }
#undef ATT_LOAD
#undef ATT_BLOCK
        {
            LAS bf16* Ot = Ks;
#pragma unroll
            for (int i = 0; i < 16; ++i) { const int r = 8 * (i >> 2) + 4 * hi + (i & 3);
                Ot[r * KP + ql] = (bf16)(pk_bf16(o0[i], 0.f) & 0xffffu); Ot[r * KP + 32 + ql] = (bf16)(pk_bf16(o1[i], 0.f) & 0xffffu); }
            bf16* op = O + (size_t)(b * SEQ + 32 * qblk + skey) * D + h * HD + 8 * sch;
#pragma unroll
            for (int i = 0; i < 4; ++i) *(v4u*)(op + (size_t)(8 * i) * D) = *(const LAS v4u*)(Ot + (skey + 8 * i) * KP + 8 * sch);
        }
    }
}

__device__ __forceinline__ void attn_phase2(LAS unsigned char* lds, const bf16* Q, const bf16* K, const bf16* V, bf16* O, const float* qg, const float* kg, int gw, int ngw, int wave_s) {
    int tid_ = wave_s * 64 + lane_id_(); asm volatile("" : "+v"(tid_));
    const int lane = tid_ & 63, w = __builtin_amdgcn_readfirstlane(tid_ >> 6), hi = lane >> 5, ql = lane & 31;
    LAS bf16* Ks = (LAS bf16*)(lds + w * (64 * KP * 2));
    LAS bf16* Vs = Ks + 32 * KP;
    const int skey = lane >> 3, sch = lane & 7;
    const LAS bf16* vtb = Vs + (4 * hi + ((lane & 15) >> 2)) * KP + 16 * ((lane >> 4) & 1) + 4 * (lane & 3);
    for (int wu = gw; wu < BATCH * NH * 32; wu += ngw) {
        const int pq = wu & 31, bh = wu >> 5, b = bh >> 4, h = bh & 15;
        const int qblk0 = 2 * pq, qblk1 = 2 * pq + 1;
        bf16x8 qfa[4], qfb[4];
#define ATT_LOADQ(QF, QBLK) do { \
            const bf16* qp = Q + (size_t)(b * SEQ + 32 * (QBLK) + ql) * D + h * HD + 8 * hi; \
            float qv[4][8]; float ss = 0.f; \
            _Pragma("unroll") for (int s = 0; s < 4; ++s) { const v4u r = *(const v4u*)(qp + 16 * s); \
                qv[s][0] = bf_lo(r.x); qv[s][1] = bf_hi(r.x); qv[s][2] = bf_lo(r.y); qv[s][3] = bf_hi(r.y); qv[s][4] = bf_lo(r.z); qv[s][5] = bf_hi(r.z); qv[s][6] = bf_lo(r.w); qv[s][7] = bf_hi(r.w); \
                _Pragma("unroll") for (int j = 0; j < 8; ++j) ss += qv[s][j] * qv[s][j]; } \
            ss += __shfl_xor(ss, 32); \
            const float rs = (0.125f * LOG2E) * __builtin_amdgcn_rsqf(ss * (1.f / HD) + EPS); \
            _Pragma("unroll") for (int s = 0; s < 4; ++s) { float gp[8]; \
                _Pragma("unroll") for (int j = 0; j < 8; ++j) gp[j] = qg[16 * s + 8 * hi + j] * kg[16 * s + 8 * hi + j]; \
                v4u p; \
                p.x = pk_bf16(qv[s][0] * rs * gp[0], qv[s][1] * rs * gp[1]); p.y = pk_bf16(qv[s][2] * rs * gp[2], qv[s][3] * rs * gp[3]); \
                p.z = pk_bf16(qv[s][4] * rs * gp[4], qv[s][5] * rs * gp[5]); p.w = pk_bf16(qv[s][6] * rs * gp[6], qv[s][7] * rs * gp[7]); \
                QF[s] = __builtin_bit_cast(bf16x8, p); } } while (0)
        ATT_LOADQ(qfa, qblk0);
        ATT_LOADQ(qfb, qblk1);
        f32x16 oa0, oa1, ob0, ob1;
#pragma unroll
        for (int i = 0; i < 16; ++i) { oa0[i] = 0.f; oa1[i] = 0.f; ob0[i] = 0.f; ob1[i] = 0.f; }
        float Ra = 0.f, Rb = 0.f;
        bool da = false, db = false;
        v4u kr[4], vr[4];
        int kb = qblk1;
        const bf16* kbase = K + (size_t)(b * SEQ + skey) * D + h * HD + 8 * sch;
        const bf16* vbase = V + (size_t)(b * SEQ + skey) * D + h * HD + 8 * sch;
#pragma unroll
        for (int i = 0; i < 4; ++i) { kr[i] = *(const v4u*)(kbase + (size_t)(32 * kb + 8 * i) * D); vr[i] = *(const v4u*)(vbase + (size_t)(32 * kb + 8 * i) * D); }
#define ATT_TILE(QF, O0, O1, RR, DIAG) do { \
            f32x16 p; \
            _Pragma("unroll") for (int i = 0; i < 16; ++i) p[i] = 0.f; \
            _Pragma("unroll") for (int s = 0; s < 4; ++s) { const bf16x8 kf = *(const LAS bf16x8*)(Ks + ql * KP + 16 * s + 8 * hi); \
                p = __builtin_amdgcn_mfma_f32_32x32x16_bf16(kf, QF[s], p, 0, 0, 0); } \
            const bool diag = (DIAG); \
            { \
                float sp[16], lb[16]; \
                _Pragma("unroll") for (int i = 0; i < 16; ++i) { \
                    const float z = p[i]; \
                    const float e = __builtin_amdgcn_exp2f(-fabsf(z)); \
                    const float l = __builtin_amdgcn_logf(1.0f + e); \
                    const int kl = 8 * (i >> 2) + 4 * hi + (i & 3); \
                    const bool valid = !diag || (kl < ql); \
                    sp[i] = valid ? fmaxf(z, 0.f) + l : 0.f; \
                    lb[i] = valid ? fminf(z, 0.f) - l : -1e30f; \
                } \
                float run = RR; \
                _Pragma("unroll") for (int g = 3; g >= 0; --g) { \
                    const float Gm = (sp[4 * g] + sp[4 * g + 1]) + (sp[4 * g + 2] + sp[4 * g + 3]); \
                    const float Go = __shfl_xor(Gm, 32); \
                    const float aft = hi ? run : run + Go; \
                    const float e3 = aft, e2 = e3 + sp[4 * g + 3], e1 = e2 + sp[4 * g + 2], e0 = e1 + sp[4 * g + 1]; \
                    p[4 * g + 3] = __builtin_amdgcn_exp2f(lb[4 * g + 3] - e3); \
                    p[4 * g + 2] = __builtin_amdgcn_exp2f(lb[4 * g + 2] - e2); \
                    p[4 * g + 1] = __builtin_amdgcn_exp2f(lb[4 * g + 1] - e1); \
                    p[4 * g + 0] = __builtin_amdgcn_exp2f(lb[4 * g + 0] - e0); \
                    run += Gm + Go; \
                } \
                RR = run; \
            } \
            _Pragma("unroll") for (int s2 = 0; s2 < 2; ++s2) { \
                v4u pa; pa.x = pk_bf16(p[8 * s2 + 0], p[8 * s2 + 1]); pa.y = pk_bf16(p[8 * s2 + 2], p[8 * s2 + 3]); \
                pa.z = pk_bf16(p[8 * s2 + 4], p[8 * s2 + 5]); pa.w = pk_bf16(p[8 * s2 + 6], p[8 * s2 + 7]); \
                const bf16x8 pav = __builtin_bit_cast(bf16x8, pa); \
                const LAS bf16* vp = vtb + (16 * s2) * KP; \
                v4u vb; { const v2u a_ = vtr(vp), c_ = vtr(vp + 8 * KP); vb.x = a_.x; vb.y = a_.y; vb.z = c_.x; vb.w = c_.y; } \
                O0 = __builtin_amdgcn_mfma_f32_32x32x16_bf16(pav, __builtin_bit_cast(bf16x8, vb), O0, 0, 0, 0); \
                { const v2u a_ = vtr(vp + 32), c_ = vtr(vp + 8 * KP + 32); vb.x = a_.x; vb.y = a_.y; vb.z = c_.x; vb.w = c_.y; } \
                O1 = __builtin_amdgcn_mfma_f32_32x32x16_bf16(pav, __builtin_bit_cast(bf16x8, vb), O1, 0, 0, 0); \
            } \
        } while (0)
        for (;;) {
#pragma unroll
            for (int i = 0; i < 4; ++i) {
                float kf[8] = {bf_lo(kr[i].x), bf_hi(kr[i].x), bf_lo(kr[i].y), bf_hi(kr[i].y), bf_lo(kr[i].z), bf_hi(kr[i].z), bf_lo(kr[i].w), bf_hi(kr[i].w)};
                float ss = 0.f;
#pragma unroll
                for (int j = 0; j < 8; ++j) ss += kf[j] * kf[j];
                ss += __uint_as_float(__builtin_amdgcn_mov_dpp(__float_as_uint(ss), 0xB1, 0xF, 0xF, true)); ss += __uint_as_float(__builtin_amdgcn_mov_dpp(__float_as_uint(ss), 0x4E, 0xF, 0xF, true)); ss += __uint_as_float(__builtin_amdgcn_mov_dpp(__float_as_uint(ss), 0x141, 0xF, 0xF, true));
                const float rs = __builtin_amdgcn_rsqf(ss * (1.f / HD) + EPS);
                v4u p_; p_.x = pk_bf16(kf[0] * rs, kf[1] * rs); p_.y = pk_bf16(kf[2] * rs, kf[3] * rs); p_.z = pk_bf16(kf[4] * rs, kf[5] * rs); p_.w = pk_bf16(kf[6] * rs, kf[7] * rs);
                *(LAS v4u*)(Ks + (skey + 8 * i) * KP + 8 * sch) = p_;
                *(LAS v4u*)(Vs + (skey + 8 * i) * KP + 8 * sch) = vr[i];
            }
            if (kb > 0) {
#pragma unroll
                for (int i = 0; i < 4; ++i) { kr[i] = *(const v4u*)(kbase + (size_t)(32 * (kb - 1) + 8 * i) * D); vr[i] = *(const v4u*)(vbase + (size_t)(32 * (kb - 1) + 8 * i) * D); }
            }
            if (!db) { ATT_TILE(qfb, ob0, ob1, Rb, kb == qblk1); db = (__builtin_amdgcn_ballot_w64(Rb < SB_EXIT) == 0ull); }
            if (kb <= qblk0 && !da) { ATT_TILE(qfa, oa0, oa1, Ra, kb == qblk0); da = (__builtin_amdgcn_ballot_w64(Ra < SB_EXIT) == 0ull); }
            if (kb == 0 || (da && db)) break;
            --kb;
        }
#undef ATT_LOADQ
#undef ATT_TILE
#define ATT_STORE(O0, O1, QBLK) do { \
            LAS bf16* Ot = Ks; \
            _Pragma("unroll") for (int i = 0; i < 16; ++i) { const int r = 8 * (i >> 2) + 4 * hi + (i & 3); \
                Ot[r * KP + ql] = (bf16)(pk_bf16(O0[i], 0.f) & 0xffffu); Ot[r * KP + 32 + ql] = (bf16)(pk_bf16(O1[i], 0.f) & 0xffffu); } \
            bf16* op = O + (size_t)(b * SEQ + 32 * (QBLK) + skey) * D + h * HD + 8 * sch; \
            _Pragma("unroll") for (int i = 0; i < 4; ++i) *(v4u*)(op + (size_t)(8 * i) * D) = *(const LAS v4u*)(Ot + (skey + 8 * i) * KP + 8 * sch); } while (0)
        ATT_STORE(oa0, oa1, qblk0);
        ATT_STORE(ob0, ob1, qblk1);
#undef ATT_STORE
    }
}

constexpr int LT = 128, NCH = SEQ / LT;
#define LDS_BARRIER() do { asm volatile("s_waitcnt lgkmcnt(0)" ::: "memory"); __builtin_amdgcn_s_barrier(); asm volatile("" ::: "memory"); } while (0)
__device__ __forceinline__ void lru_phase(LAS unsigned char* lds, const bf16* XB, const bf16* Y, bf16* HY, const bf16* WRt, const bf16* WIt,
        const float* convw, const float* convb, const float* br, const float* bi, const float* lam, unsigned long long* gran, int G, int bid, int wave_s) {
    int tid = wave_s * 64 + lane_id_(); asm volatile("" : "+v"(tid));
    const int lane = tid & 63, w = __builtin_amdgcn_readfirstlane(tid >> 6), hi = lane >> 5, ql = lane & 31;
    LAS float* xcF = (LAS float*)lds;
    LAS bf16* wL = (LAS bf16*)(lds + 32768);
    LAS bf16* xcB = (LAS bf16*)(lds + 65536);
    LAS float* segA = (LAS float*)(lds + 65536 + 128 * KP * 2);
    LAS float* segH = segA + 512;
    LAS float* pA = segH + 512;
    LAS float* pH = pA + 1024;
    LAS bf16* yL = (LAS bf16*)(lds + 65536 + 128 * KP * 2 + 16384);
    const int st = tid >> 3, cc = 8 * (tid & 7);
    LAS float* parL = (LAS float*)(lds + 118784);
    int n_loaded = -1;
    const int rb = w >> 1, cbk = w & 1, d = 32 * cbk + ql;
    v4u xt[2][4], yv[2];
#define LRU_LOAD_X(u_) do { const int ch_ = (u_) >> 7, bn_ = (u_) & 127, b_ = bn_ >> 4, n_ = bn_ & 15, t0_ = ch_ * LT, c0_ = 64 * n_; \
        _Pragma("unroll") for (int r = 0; r < 2; ++r) { yv[r] = *(const v4u*)(Y + (size_t)(b_ * SEQ + t0_ + st + 64 * r) * D + c0_ + cc); \
            _Pragma("unroll") for (int j = 0; j < 4; ++j) { const int ts = t0_ + st + 64 * r + j - 3; xt[r][j] = ts >= 0 ? *(const v4u*)(XB + (size_t)(b_ * SEQ + ts) * D + c0_ + cc) : (v4u){0u, 0u, 0u, 0u}; } } } while (0)
    if (bid < BATCH * 16 * NCH) LRU_LOAD_X(bid);
    for (int unit = bid; unit < BATCH * 16 * NCH; unit += G) {
        const int ch = unit >> 7, bn = unit & 127, b = bn >> 4, n = bn & 15;
        const int t0 = ch * LT, c0 = 64 * n;
        if (n != n_loaded) {
            LDS_BARRIER();
            if (tid < 256) parL[tid] = convw[(tid >> 6) * D + c0 + (tid & 63)];
            else if (tid < 320) parL[tid] = convb[c0 + tid - 256];
            else if (tid < 384) parL[tid] = br[c0 + tid - 320];
            else if (tid < 448) parL[tid] = bi[c0 + tid - 384];
            else { const float lm = lam[c0 + tid - 448]; parL[tid] = -8.0f * (fmaxf(-lm, 0.f) + __builtin_amdgcn_logf(1.0f + __builtin_amdgcn_exp2f(-fabsf(lm) * LOG2E)) * LN2); }
#pragma unroll
            for (int r = 0; r < 2; ++r) { const int e = tid + 512 * r, gate = e >> 9, row = (e >> 3) & 63, chk = e & 7;
                *(LAS v4u*)(wL + (gate * 64 + row) * KP + 8 * chk) = *(const v4u*)((gate ? WIt : WRt) + (size_t)n * 4096 + row * 64 + 8 * chk); }
            n_loaded = n;
        }
        LDS_BARRIER();
        {
            float cw[4][8], cb[8];
#pragma unroll
            for (int j = 0; j < 4; ++j) { const f32x4 c0v = *(const LAS f32x4*)(parL + j * 64 + cc), c1v = *(const LAS f32x4*)(parL + j * 64 + cc + 4);
                cw[j][0] = c0v[0]; cw[j][1] = c0v[1]; cw[j][2] = c0v[2]; cw[j][3] = c0v[3]; cw[j][4] = c1v[0]; cw[j][5] = c1v[1]; cw[j][6] = c1v[2]; cw[j][7] = c1v[3]; }
            { const f32x4 c0v = *(const LAS f32x4*)(parL + 256 + cc), c1v = *(const LAS f32x4*)(parL + 256 + cc + 4);
                cb[0] = c0v[0]; cb[1] = c0v[1]; cb[2] = c0v[2]; cb[3] = c0v[3]; cb[4] = c1v[0]; cb[5] = c1v[1]; cb[6] = c1v[2]; cb[7] = c1v[3]; }
#pragma unroll
            for (int r = 0; r < 2; ++r) {
                const int t = st + 64 * r;
                float acc[8];
#pragma unroll
                for (int e = 0; e < 8; ++e) acc[e] = cb[e];
#pragma unroll
                for (int j = 0; j < 4; ++j) {
                    const v4u x = xt[r][j];
                    acc[0] += cw[j][0] * bf_lo(x.x); acc[1] += cw[j][1] * bf_hi(x.x); acc[2] += cw[j][2] * bf_lo(x.y); acc[3] += cw[j][3] * bf_hi(x.y);
                    acc[4] += cw[j][4] * bf_lo(x.z); acc[5] += cw[j][5] * bf_hi(x.z); acc[6] += cw[j][6] * bf_lo(x.w); acc[7] += cw[j][7] * bf_hi(x.w);
                }
                *(LAS f32x4*)(xcF + t * 64 + cc) = (f32x4){acc[0], acc[1], acc[2], acc[3]}; *(LAS f32x4*)(xcF + t * 64 + cc + 4) = (f32x4){acc[4], acc[5], acc[6], acc[7]};
                v4u p; p.x = pk_bf16(acc[0], acc[1]); p.y = pk_bf16(acc[2], acc[3]); p.z = pk_bf16(acc[4], acc[5]); p.w = pk_bf16(acc[6], acc[7]);
                *(LAS v4u*)(xcB + t * KP + cc) = p;
                *(LAS v4u*)(yL + t * KP + cc) = yv[r];
            }
        }
        if (unit + G < BATCH * 16 * NCH) LRU_LOAD_X(unit + G);
        LDS_BARRIER();
        unsigned xa[2] = {0u, 0u}, xh[2] = {0u, 0u}, xt_[2] = {0u, 0u};
#pragma unroll
        for (int q = 0; q < 2; ++q) { const int kk = w + 8 * q;
            if (kk < ch) { const unsigned long long* g = gran + ((size_t)(b * NCH + kk) * D + c0 + lane) * 2;
                const unsigned long long ya = __hip_atomic_load(g, __ATOMIC_RELAXED, __HIP_MEMORY_SCOPE_AGENT), yh = __hip_atomic_load(g + 1, __ATOMIC_RELAXED, __HIP_MEMORY_SCOPE_AGENT);
                xa[q] = (unsigned)ya; xh[q] = (unsigned)yh; xt_[q] = (unsigned)(ya >> 32) & (unsigned)(yh >> 32); } }
        float av[16], uv[16];
        const int c = lane, sg = 2 * rb + hi, tb = 32 * rb + 16 * hi;
        {
            f32x16 pr, pi;
#pragma unroll
            for (int i = 0; i < 16; ++i) { pr[i] = 0.f; pi[i] = 0.f; }
            const int trow = 32 * rb + 16 * ((ql >> 2) & 1) + 4 * (ql >> 3) + (ql & 3);
#pragma unroll
            for (int s = 0; s < 4; ++s) {
                const bf16x8 af = *(const LAS bf16x8*)(xcB + trow * KP + 16 * s + 8 * hi);
                const bf16x8 wr_ = *(const LAS bf16x8*)(wL + d * KP + 16 * s + 8 * hi), wi_ = *(const LAS bf16x8*)(wL + (64 + d) * KP + 16 * s + 8 * hi);
                pr = __builtin_amdgcn_mfma_f32_32x32x16_bf16(af, wr_, pr, 0, 0, 0);
                pi = __builtin_amdgcn_mfma_f32_32x32x16_bf16(af, wi_, pi, 0, 0, 0);
            }
            const float brv = parL[320 + d], biv = parL[384 + d], ls8 = parL[448 + d];
            float A = 1.f, H = 0.f;
#pragma unroll
            for (int i = 0; i < 16; ++i) {
                const float r = pg8::fast_sigmoid(pr[i] + brv), ig = pg8::fast_sigmoid(pi[i] + biv);
                const float la = ls8 * r;
                const float a = __builtin_amdgcn_exp2f(la * LOG2E);
                const float mult = __builtin_amdgcn_sqrtf(fmaxf(1.0f - a * a, 0.f));
                const float u = mult * ig * xcF[(tb + i) * 64 + d];
                av[i] = a; uv[i] = u; H = a * H + u; A *= a;
            }
            segA[sg * 64 + d] = A; segH[sg * 64 + d] = H;
        }
        LDS_BARRIER();
        if (w == 0 && ch < NCH - 1) {
            float At = 1.f, Ht = 0.f;
#pragma unroll
            for (int s = 0; s < 8; ++s) { const float a = segA[s * 64 + c], hh = segH[s * 64 + c]; Ht = a * Ht + hh; At *= a; }
            unsigned long long* g = gran + ((size_t)(b * NCH + ch) * D + c0 + c) * 2;
            __hip_atomic_store(g, (1ull << 32) | (unsigned long long)__float_as_uint(At), __ATOMIC_RELAXED, __HIP_MEMORY_SCOPE_AGENT);
            __hip_atomic_store(g + 1, (1ull << 32) | (unsigned long long)__float_as_uint(Ht), __ATOMIC_RELAXED, __HIP_MEMORY_SCOPE_AGENT);
        }
#pragma unroll
        for (int q = 0; q < 2; ++q) { const int kk = w + 8 * q;
            if (kk < ch) {
                const unsigned long long* g = gran + ((size_t)(b * NCH + kk) * D + c0 + c) * 2;
                for (unsigned spins = 0; spins < (1u << 22); ++spins) {
                    if (__all(xt_[q] == 1u)) break;
                    __builtin_amdgcn_s_sleep(1);
                    const unsigned long long ya = __hip_atomic_load(g, __ATOMIC_RELAXED, __HIP_MEMORY_SCOPE_AGENT), yh = __hip_atomic_load(g + 1, __ATOMIC_RELAXED, __HIP_MEMORY_SCOPE_AGENT);
                    xa[q] = (unsigned)ya; xh[q] = (unsigned)yh; xt_[q] = (unsigned)(ya >> 32) & (unsigned)(yh >> 32); }
                pA[kk * 64 + c] = __uint_as_float(xa[q]); pH[kk * 64 + c] = __uint_as_float(xh[q]);
            } }
        LDS_BARRIER();
        {
            float h = 0.f;
            for (int kk = 0; kk < ch; ++kk) h = pA[kk * 64 + d] * h + pH[kk * 64 + d];
            for (int s = 0; s < 7; ++s) { if (s < sg) h = segA[s * 64 + d] * h + segH[s * 64 + d]; }
#pragma unroll
            for (int i = 0; i < 16; ++i) { const int t = tb + i; h = av[i] * h + uv[i];
                const float yv_ = __uint_as_float((unsigned)yL[t * KP + d] << 16);
                xcB[t * KP + d] = (bf16)(pk_bf16(h * yv_, 0.f) & 0xffffu); }
        }
        LDS_BARRIER();
#pragma unroll
        for (int r = 0; r < 2; ++r) *(v4u*)(HY + (size_t)(b * SEQ + t0 + st + 64 * r) * D + c0 + cc) = *(const LAS v4u*)(xcB + (st + 64 * r) * KP + cc);
    }
}

#define RLX_AGENT __ATOMIC_RELAXED, __HIP_MEMORY_SCOPE_AGENT
#define XB_TMO      128
#define XB_XCNT(j)  (256  + 64 * (j))
#define XB_XSUB(j)  (1280 + 64 * (j))
#define XB_XGEN(j)  (2304 + 64 * (j))
#define XB_TOP      3328
#define XB_TOPGEN   3392
#define XCD_BAR_WORDS 3456
#define XB_SPIN_CAP (1u << 18)

__device__ __forceinline__ unsigned xb_ld(unsigned* p)              { return __hip_atomic_load(p, __ATOMIC_RELAXED, __HIP_MEMORY_SCOPE_AGENT); }
__device__ __forceinline__ unsigned xb_add(unsigned* p, unsigned v) { return __hip_atomic_fetch_add(p, v, __ATOMIC_RELAXED, __HIP_MEMORY_SCOPE_AGENT); }
__device__ __forceinline__ unsigned xb_xcc_id() { return (unsigned)__builtin_amdgcn_s_getreg((3 << 11) | 20) & 0xFu; }
#define XB_SPIN(cond, bar) do { unsigned _sp = 0; while (cond) { __builtin_amdgcn_s_sleep(1); \
    if ((++_sp & 255u) == 0u) { if (xb_ld(&(bar)[XB_TMO])) break; if (_sp > XB_SPIN_CAP) { atomicAdd(&(bar)[XB_TMO], 1u); break; } } } } while (0)

struct XcdBarrier {
    unsigned* bar; unsigned x;
    volatile LAS unsigned* st;
};

__device__ __forceinline__ XcdBarrier xcd_barrier_post(unsigned* bar, volatile LAS unsigned* st, bool is_t0) {
    XcdBarrier b; b.bar = bar; b.x = xb_xcc_id(); b.st = st;
    if (is_t0) (void)xb_add(&bar[XB_XCNT(b.x)], 1u);
    return b;
}
__device__ __forceinline__ void xcd_barrier_complete(unsigned* bar, unsigned x, unsigned& nloc, unsigned& nx) {
    const unsigned G = gridDim.x * gridDim.y * gridDim.z;
    unsigned sum, cnt, mine, sp = 0u;
    for (;;) {
        sum = 0u; cnt = 0u; mine = 0u;
#pragma unroll
        for (unsigned j = 0; j < 16; ++j) { const unsigned c = xb_ld(&bar[XB_XCNT(j)]); sum += c; cnt += (c > 0u) ? 1u : 0u; mine = (j == x) ? c : mine; }
        if (sum == G) break;
        __builtin_amdgcn_s_sleep(1);
        if ((++sp & 255u) == 0u) { if (xb_ld(&bar[XB_TMO])) break; if (sp > XB_SPIN_CAP) { atomicAdd(&bar[XB_TMO], 1u); break; } }
    }
    nloc = mine > 0u ? mine : 1u; nx = cnt > 0u ? cnt : 1u;
}

__device__ __forceinline__ void xcd_barrier(const XcdBarrier& b, int wave_s) {
    asm volatile("s_waitcnt vmcnt(0)" ::: "memory");
    __syncthreads();
    if (wave_s == 0 && lane_id_() == 0) {
        unsigned* bar = b.bar;
        __builtin_amdgcn_s_waitcnt(0);
        unsigned nloc = b.st[0], nx = b.st[1];
        if (nloc == 0u) { xcd_barrier_complete(bar, b.x, nloc, nx); b.st[0] = nloc; b.st[1] = nx; }
        const unsigned old = xb_add(&bar[XB_XSUB(b.x)], 1u);
        const unsigned gen = old / nloc;
        if (old + 1u == (gen + 1u) * nloc) {
            __builtin_amdgcn_fence(__ATOMIC_RELEASE, "agent");
            asm volatile("s_waitcnt vmcnt(0)" ::: "memory");
            const unsigned og = xb_add(&bar[XB_TOP], 1u);
            const unsigned tg = og / nx;
            if (og + 1u == (tg + 1u) * nx) xb_add(&bar[XB_TOPGEN], 1u);
            else XB_SPIN(xb_ld(&bar[XB_TOPGEN]) == tg, bar);
            __builtin_amdgcn_fence(__ATOMIC_ACQUIRE, "agent");
            xb_add(&bar[XB_XGEN(b.x)], 1u);
            asm volatile("s_waitcnt vmcnt(0)" ::: "memory");
        } else {
            XB_SPIN(xb_ld(&bar[XB_XGEN(b.x)]) == gen, bar);
            __builtin_amdgcn_fence(__ATOMIC_ACQUIRE, "agent");
            asm volatile("s_waitcnt vmcnt(0)" ::: "memory");
        }
    }
    __syncthreads();
}

__device__ __forceinline__ int launder_s_(int k) { asm volatile("" : "+s"(k)); return k; }
struct Args { const float* in[28]; float* out; unsigned char* ws; };
__global__ void __launch_bounds__(512, 2) fwd_megakernel(Args a) {
    const float* const* kin_ = (const float* const*)__builtin_amdgcn_kernarg_segment_ptr();
#define AIN(k) (kin_[launder_s_(k)])
    extern __shared__ __attribute__((aligned(16))) unsigned char lds_raw[];
    cg::grid_group grid = cg::this_grid();
    LAS unsigned char* lds = (LAS unsigned char*)lds_raw;
    const int tid = threadIdx.x, lane = tid & 63, wave = __builtin_amdgcn_readfirstlane(tid >> 6);
    const int G = gridDim.x, bid = blockIdx.x;
    const int gw = bid * 8 + wave, ngw = G * 8;
    unsigned char* ws = a.ws;
    bf16* XN = (bf16*)(ws + WS_XN); bf16* ACT = (bf16*)(ws + WS_ACT);
    bf16* QB = ACT; bf16* KB = ACT + (size_t)M * D; bf16* VB = ACT + (size_t)2 * M * D;
    volatile LAS unsigned* MISC = (volatile LAS unsigned*)(lds + 131072 + 4096);
    if (tid < 2) MISC[tid] = 0u;
    __syncthreads();
    const XcdBarrier xbar = xcd_barrier_post((unsigned*)(ws + WS_CTL), MISC, tid == 0);

    float* SSQ = (float*)(ws + WS_SSQ);
#define SSQ_AT(s) (SSQ + (size_t)(s) * M)
    constexpr int I_IN = (D / 64) * (2 * FF / 32), I_OUT = (FF / 64) * (D / 32), I_QKV = (D / 64) * (3 * D / 32), I_SQ = (D / 64) * (D / 32), I_LIN = (D / 64) * (2 * D / 32), I_G = 16 * 2;
    constexpr int SEG0 = I_IN, SEG1 = SEG0 + I_OUT + I_QKV + I_SQ + I_IN, SEG2 = SEG1 + I_OUT + I_IN + I_OUT, SEG3 = SEG2 + I_LIN + I_SQ + 2 * I_G + I_IN + I_OUT;
#define FFW(f) (ws + W_FF0 + (size_t)(f) * (SZ_WIN + SZ_WOUT))
#define CONVERT_ITEMS(lo_, hi_, wk_, nwk_) do { LAS float* scr = (LAS float*)(lds + wave * 16384); int tl_ = lane_id_(); asm volatile("" : "+v"(tl_)); const int lane = tl_; \
        for (int it = (lo_) + (wk_); it < (hi_); it += (nwk_)) { int r = it; \
            if (r < I_IN) { transpose_item<true>(AIN(2), AIN(1), D, 2 * FF, (bf16*)FFW(0), scr, r, lane); continue; } r -= I_IN; \
            if (r < I_OUT) { transpose_item<false>(AIN(3), nullptr, FF, D, (bf16*)(FFW(0) + SZ_WIN), scr, r, lane); continue; } r -= I_OUT; \
            if (r < I_QKV) { transpose_item<false>(AIN(5), AIN(4), D, 3 * D, (bf16*)(ws + W_QKV), scr, r, lane); continue; } r -= I_QKV; \
            if (r < I_SQ) { transpose_item<false>(AIN(8), nullptr, D, D, (bf16*)(ws + W_O), scr, r, lane); continue; } r -= I_SQ; \
            if (r < I_IN) { transpose_item<true>(AIN(10), AIN(9), D, 2 * FF, (bf16*)FFW(1), scr, r, lane); continue; } r -= I_IN; \
            if (r < I_OUT) { transpose_item<false>(AIN(11), nullptr, FF, D, (bf16*)(FFW(1) + SZ_WIN), scr, r, lane); continue; } r -= I_OUT; \
            if (r < I_IN) { transpose_item<true>(AIN(13), AIN(12), D, 2 * FF, (bf16*)FFW(2), scr, r, lane); continue; } r -= I_IN; \
            if (r < I_OUT) { transpose_item<false>(AIN(14), nullptr, FF, D, (bf16*)(FFW(2) + SZ_WIN), scr, r, lane); continue; } r -= I_OUT; \
            if (r < I_LIN) { transpose_item<false>(AIN(16), AIN(15), D, 2 * D, (bf16*)(ws + W_LIN), scr, r, lane); continue; } r -= I_LIN; \
            if (r < I_SQ) { transpose_item<false>(AIN(24), nullptr, D, D, (bf16*)(ws + W_LO), scr, r, lane); continue; } r -= I_SQ; \
            if (r < I_G) { transpose_item<false>(AIN(19) + (size_t)(r >> 1) * 4096, nullptr, 64, 64, (bf16*)(ws + W_GR) + (size_t)(r >> 1) * 4096, scr, r & 1, lane); continue; } r -= I_G; \
            if (r < I_G) { transpose_item<false>(AIN(21) + (size_t)(r >> 1) * 4096, nullptr, 64, 64, (bf16*)(ws + W_GI) + (size_t)(r >> 1) * 4096, scr, r & 1, lane); continue; } r -= I_G; \
            if (r < I_IN) { transpose_item<true>(AIN(26), AIN(25), D, 2 * FF, (bf16*)FFW(3), scr, r, lane); continue; } r -= I_IN; \
            transpose_item<false>(AIN(27), nullptr, FF, D, (bf16*)(FFW(3) + SZ_WIN), scr, r, lane); } } while (0)
    const int ffn_units = (M / 256) * (2 * FF / 256), ffn_rounds = (ffn_units + G - 1) / G, idle_from = ffn_units - (ffn_rounds - 1) * G;
#define CONVERT_IN_TAIL(lo_, hi_) do { if (idle_from < G) { if (bid >= idle_from) CONVERT_ITEMS(lo_, hi_, (bid - idle_from) * 8 + wave, (G - idle_from) * 8); } \
        else CONVERT_ITEMS(lo_, hi_, gw, ngw); } while (0)
    {
        CONVERT_ITEMS(0, SEG0, gw, ngw);
        cvt_phase(AIN(0), XN, SSQ_AT(0), gw, ngw, lane);
        for (int i = bid * 512 + tid; i < 2 * BATCH * NCH * D; i += G * 512) ((unsigned long long*)(ws + WS_SUM))[i] = 0ull;
    }
#define SEAM() xcd_barrier(xbar, wave)
    if (a.ws == nullptr) grid.sync();
    SEAM();
#define GEMM(EPI, Aptr, Wptr, NN, KK, E) do { pg8::Gemm g{(Aptr), (const bf16*)(Wptr), M, (NN), (KK)}; pg8::StaticOrder S; S.init(M, (NN), G, bid); \
        pg8::gemm_phase<EPI, pg8::StaticOrder, true, true>(lds, g, S, (E), wave); } while (0)
#define FFN(widx, s_in, FIRST, LAST, TLO, THI) do { \
        { pg8::EpiSwiglu E{ACT, FF, SSQ_AT(s_in)}; GEMM(pg8::EpiSwiglu, XN, ws + W_FF0 + (size_t)(widx) * (SZ_WIN + SZ_WOUT), 2 * FF, D, E); } \
        if ((TLO) < (THI)) CONVERT_IN_TAIL(TLO, THI); \
        SEAM(); \
        { typedef pg8::EpiResid<FIRST, LAST, true> EpiR; EpiR E{AIN(0), ((float*)AIN(28)), XN, SSQ_AT((s_in) + 1)}; GEMM(EpiR, ACT, ws + W_FF0 + (size_t)(widx) * (SZ_WIN + SZ_WOUT) + SZ_WIN, D, FF, E); } \
        } while (0)

    FFN(0, 0, false, false, SEG0, SEG1);
    SEAM();
    { pg8::EpiSplit<99> E{ACT, (size_t)M * D, SSQ_AT(1)}; GEMM(pg8::EpiSplit<99>, XN, ws + W_QKV, 3 * D, D, E); }
    SEAM();
    { const int vcu = (G % 8 == 0) ? (bid % 8) * (G / 8) + bid / 8 : bid;
      attn_phase2(lds, QB, KB, VB, QB, AIN(6), AIN(7), vcu * 8 + wave, ngw, wave); }
    SEAM();
    { typedef pg8::EpiResid<false, false, false> EpiR; EpiR E{AIN(0), ((float*)AIN(28)), XN, SSQ_AT(2)}; GEMM(EpiR, QB, ws + W_O, D, D, E); }
    SEAM();
    FFN(1, 2, false, false, SEG1, SEG2);
    SEAM();
    FFN(2, 3, false, false, SEG2, SEG3);
    SEAM();
    { pg8::EpiSplit<1> E{ACT, (size_t)M * D, SSQ_AT(4)}; GEMM(pg8::EpiSplit<1>, XN, ws + W_LIN, 2 * D, D, E); }
    SEAM();
    lru_phase(lds, QB, KB, VB, (const bf16*)(ws + W_GR), (const bf16*)(ws + W_GI), AIN(17), AIN(18), AIN(20), AIN(22), AIN(23), (unsigned long long*)(ws + WS_SUM), G, (G % 8 == 0) ? (bid % 8) * (G / 8) + bid / 8 : bid, wave);
    SEAM();
    { typedef pg8::EpiResid<false, false, false> EpiR; EpiR E{AIN(0), ((float*)AIN(28)), XN, SSQ_AT(5)}; GEMM(EpiR, VB, ws + W_LO, D, D, E); }
    SEAM();
    FFN(3, 5, false, true, 0, 0);
}

extern "C" void kernel_launch(void* const* d_in, const int* in_sizes, int n_in, void* d_out, int out_size, void* d_ws, size_t ws_size, hipStream_t stream) {
    static int grid = 0;
    if (grid == 0) {
        if (n_in != 28 || out_size != M * D || ws_size < WS_END) { fprintf(stderr, "kernel_launch: unexpected problem (n_in %d out %d ws %zu)\n", n_in, out_size, ws_size); grid = -1; return; }
        int dev = 0, cus = 0, per_cu = 0;
        hipGetDevice(&dev); hipDeviceGetAttribute(&cus, hipDeviceAttributeMultiprocessorCount, dev);
        if (hipFuncSetAttribute((const void*)fwd_megakernel, hipFuncAttributeMaxDynamicSharedMemorySize, LDS_BYTES) != hipSuccess) { fprintf(stderr, "kernel_launch: hipFuncSetAttribute failed\n"); grid = -1; return; }
        if (hipOccupancyMaxActiveBlocksPerMultiprocessor(&per_cu, (const void*)fwd_megakernel, 512, LDS_BYTES) != hipSuccess || per_cu < 1) { fprintf(stderr, "kernel_launch: occupancy query says %d\n", per_cu); per_cu = 1; }
        (void)hipGetLastError();
        grid = cus * per_cu;
    }
    if (grid < 0) return;
    if (hipMemsetAsync((char*)d_ws + WS_CTL, 0, CTL_ZERO_BYTES, stream) != hipSuccess) { fprintf(stderr, "memset failed\n"); return; }
    Args a{};
    for (int i = 0; i < 28; ++i) a.in[i] = (const float*)d_in[i];
    a.out = (float*)d_out; a.ws = (unsigned char*)d_ws;
    void* args[] = {&a};
    hipError_t e = hipLaunchCooperativeKernel((const void*)fwd_megakernel, dim3(grid), dim3(512), args, LDS_BYTES, stream);
    if (e != hipSuccess) fprintf(stderr, "cooperative launch failed: %s (grid %d)\n", hipGetErrorString(e), grid);
}
```

```cpp
#include <hip/hip_runtime.h>
#include <hip/hip_cooperative_groups.h>
#include <cstdio>
#include <cstdint>
namespace cg = cooperative_groups;
__device__ __forceinline__ int lane_id_() { int l; asm volatile("v_mbcnt_lo_u32_b32 %0, -1, 0\n\tv_mbcnt_hi_u32_b32 %0, -1, %0" : "=v"(l)); return l; }
namespace pg8 {
#define PG8_LAS __attribute__((address_space(3)))
typedef unsigned short bf16_t;
typedef short bf16x8 __attribute__((ext_vector_type(8)));
typedef float f32x4 __attribute__((ext_vector_type(4)));
typedef unsigned u32x4 __attribute__((ext_vector_type(4)));
constexpr int BM = 256, BK = 64, HALF = 128, HTB = HALF * BK * 2  , STAGE_BYTES = 8 * HTB, NXCD = 8, WGM = 8;

__host__ __device__ __forceinline__ int lds_byte(int r, int c) { const int st = (r >> 4) * 2 + (c >> 5), rr = r & 15, cc = c & 31, ob = rr * 64 + cc * 2; return st * 1024 + (ob ^ (((ob >> 9) & 1) << 5)); }
__host__ __device__ __forceinline__ void stage_rc(int b, int& R, int& C) { const int st = b / 1024, sb = b % 1024, swz = sb ^ (((sb >> 9) & 1) << 5); R = (st >> 1) * 16 + swz / 64; C = (st & 1) * 32 + (swz % 64) / 2; }
__host__ __device__ __forceinline__ int perm32(int rho) { const int n = rho >> 4, i = rho & 15; return 8 * (i >> 2) + 4 * n + (i & 3); }

constexpr int PRE_SLOT = 136192;
struct Unit { int pm, pn; };
struct Gemm { const bf16_t* A; const bf16_t* Bt; int M, N, K; };

struct StaticOrder {
    int nM, nN, nwg, G, c;
    __host__ __device__ void init(int M, int N, int G_, int c_) { nM = M / BM; nN = N / BM; nwg = nM * nN; G = G_; c = c_; }
    __host__ __device__ bool next(int i, Unit& u) const {
        const long L = (long)i * G + c; if (L >= nwg) return false;
        int wgid = (int)L; { const int q = nwg / NXCD, r = nwg % NXCD, xcd = wgid % NXCD, off = wgid / NXCD; wgid = (xcd < r ? xcd * (q + 1) : r * (q + 1) + (xcd - r) * q) + off; }
        const int nig = WGM * nN, gid = wgid / nig, fm = gid * WGM, gsz = (nM - fm) < WGM ? (nM - fm) : WGM;
        u.pm = fm + ((wgid % nig) % gsz); u.pn = (wgid % nig) / gsz; return true;
    }
    __device__ __forceinline__ void a_ready(const Unit&) const {}
    __device__ __forceinline__ void done(const Unit&) const {}
};

__device__ __forceinline__ unsigned cvt_pk_bf16(float lo, float hi) { unsigned r; asm volatile("v_cvt_pk_bf16_f32 %0, %1, %2" : "=v"(r) : "v"(lo), "v"(hi)); return r; }
typedef float f32x2 __attribute__((ext_vector_type(2)));
__device__ __forceinline__ unsigned pk_bf16(float lo, float hi) { typedef __bf16 b2_t __attribute__((ext_vector_type(2))); f32x2 v = {lo, hi}; b2_t b = __builtin_convertvector(v, b2_t); return __builtin_bit_cast(unsigned, b); }
__device__ __forceinline__ float fast_sigmoid(float v) { return __builtin_amdgcn_rcpf(1.0f + __builtin_amdgcn_exp2f(-1.44269504089f * v)); }
struct EpiSwiglu {
    static constexpr bool PERM = true, AFTER_DRAIN = false; static constexpr int NSTORES = 8;
    static constexpr int NPRE = 2;
    __device__ __forceinline__ void prefetch(PG8_LAS unsigned char* lds, int wid, const Unit& u, int wr, int fr, int fq) const {
        { const int l_ = lane_id_(); fr = l_ & 15; fq = l_ >> 4; }
#pragma unroll
        for (int j = 0; j < 2; ++j) { const int i = 2 * fq + j;
            __builtin_amdgcn_global_load_lds((const unsigned*)(ssq + u.pm * BM + wr * 64 + fr + (i >> 2) * HALF + (i & 3) * 16), (PG8_LAS unsigned*)(lds + PRE_SLOT + wid * 512 + j * 256), 4, 0, 0); }
    }
    bf16_t* H; int ldh; const float* ssq;
    __device__ __forceinline__ void operator()(const f32x4 (&acc)[2][2][4][2], const Unit& u, int wr, int wc, int fr, int fq, PG8_LAS unsigned char* lds, int wid) const {
        const int row0 = u.pm * BM + wr * 64 + fr, col0 = u.pn * HALF + wc * 32 + 8 * fq;
#pragma unroll
        for (int ai = 0; ai < 2; ++ai)
#pragma unroll
            for (int m = 0; m < 4; ++m) {
                bf16_t* p = H + (size_t)(row0 + ai * HALF + m * 16) * ldh + col0;
                const float rstd = __builtin_amdgcn_rsqf(*(const PG8_LAS float*)(lds + PRE_SLOT + wid * 512 + (m & 1) * 256 + (fr + 16 * ((ai * 4 + m) >> 1)) * 4) * (1.0f / 1024.0f) + 1e-6f);
                const float c1 = -1.44269504089f * rstd, r2 = rstd * rstd;
                f32x2 hh[4];
#pragma unroll
                for (int q = 0; q < 4; ++q) {
                    const f32x2 ag = {acc[ai][0][m][q >> 1][2 * (q & 1)], acc[ai][0][m][q >> 1][2 * (q & 1) + 1]};
                    const f32x2 au = {acc[ai][1][m][q >> 1][2 * (q & 1)], acc[ai][1][m][q >> 1][2 * (q & 1) + 1]};
                    const f32x2 t = ag * c1;
                    f32x2 e; e.x = __builtin_amdgcn_exp2f(t.x); e.y = __builtin_amdgcn_exp2f(t.y);
                    const f32x2 d = e + 1.0f;
                    f32x2 r; r.x = __builtin_amdgcn_rcpf(d.x); r.y = __builtin_amdgcn_rcpf(d.y);
                    hh[q] = (ag * au) * (r * r2);
                }
                u32x4 w; w.x = pk_bf16(hh[0].x, hh[0].y); w.y = pk_bf16(hh[1].x, hh[1].y); w.z = pk_bf16(hh[2].x, hh[2].y); w.w = pk_bf16(hh[3].x, hh[3].y);
                *(u32x4*)p = w;
            }
    }
};
template <bool FIRST, bool LAST, bool HALF_ALPHA> struct EpiResid {
    static constexpr bool PERM = true, AFTER_DRAIN = false; static constexpr int NSTORES = 0;
    static constexpr int NPRE = 0;
    __device__ __forceinline__ void prefetch(PG8_LAS unsigned char*, int, const Unit&, int, int, int) const {}
    const float* base32; float* out32; bf16_t* xn; float* ssq;
    __device__ __forceinline__ void operator()(const f32x4 (&acc)[2][2][4][2], const Unit& u, int wr, int wc, int fr, int fq, PG8_LAS unsigned char*, int) const {
        const int row0 = u.pm * BM + wr * 64 + fr, col0 = u.pn * BM + wc * 32 + 8 * fq;
        constexpr float alpha = HALF_ALPHA ? 0.5f : 1.0f;
#pragma unroll
        for (int ai = 0; ai < 2; ++ai)
#pragma unroll
            for (int m = 0; m < 4; ++m) {
                float s = 0.f;
#pragma unroll
                for (int bj = 0; bj < 2; ++bj) {
                    const size_t off = (size_t)(row0 + ai * HALF + m * 16) * 1024 + col0 + bj * HALF;
                    f32x4 b0, b1;
                    if (FIRST) { b0 = *(const f32x4*)(base32 + off); b1 = *(const f32x4*)(base32 + off + 4); }
                    else { const u32x4 r = *(const u32x4*)(xn + off);
                        b0 = (f32x4){__uint_as_float(r.x << 16), __uint_as_float(r.x & 0xffff0000u), __uint_as_float(r.y << 16), __uint_as_float(r.y & 0xffff0000u)};
                        b1 = (f32x4){__uint_as_float(r.z << 16), __uint_as_float(r.z & 0xffff0000u), __uint_as_float(r.w << 16), __uint_as_float(r.w & 0xffff0000u)}; }
                    const f32x4 v0 = b0 + alpha * acc[ai][bj][m][0], v1 = b1 + alpha * acc[ai][bj][m][1];
                    if (LAST) { *(f32x4*)(out32 + off) = v0; *(f32x4*)(out32 + off + 4) = v1; }
                    else {
                        u32x4 w; w.x = pk_bf16(v0[0], v0[1]); w.y = pk_bf16(v0[2], v0[3]); w.z = pk_bf16(v1[0], v1[1]); w.w = pk_bf16(v1[2], v1[3]);
                        *(u32x4*)(xn + off) = w;
                        const float r0 = __uint_as_float(w.x << 16), r1 = __uint_as_float(w.x & 0xffff0000u), r2 = __uint_as_float(w.y << 16), r3 = __uint_as_float(w.y & 0xffff0000u);
                        const float r4 = __uint_as_float(w.z << 16), r5 = __uint_as_float(w.z & 0xffff0000u), r6 = __uint_as_float(w.w << 16), r7 = __uint_as_float(w.w & 0xffff0000u);
                        s += (r0 * r0 + r1 * r1) + (r2 * r2 + r3 * r3) + (r4 * r4 + r5 * r5) + (r6 * r6 + r7 * r7);
                    }
                }
                if (!LAST) { s += __shfl_xor(s, 16); s += __shfl_xor(s, 32); if (fq == 0) __hip_atomic_fetch_add(ssq + row0 + ai * HALF + m * 16, s, __ATOMIC_RELAXED, __HIP_MEMORY_SCOPE_AGENT); }
            }
    }
};
template <int GELU_FROM> struct EpiSplit {
    static constexpr bool PERM = true, AFTER_DRAIN = false; static constexpr int NSTORES = 16;
    static constexpr int NPRE = 2;
    __device__ __forceinline__ void prefetch(PG8_LAS unsigned char* lds, int wid, const Unit& u, int wr, int fr, int fq) const {
        { const int l_ = lane_id_(); fr = l_ & 15; fq = l_ >> 4; }
#pragma unroll
        for (int j = 0; j < 2; ++j) { const int i = 2 * fq + j;
            __builtin_amdgcn_global_load_lds((const unsigned*)(ssq + u.pm * BM + wr * 64 + fr + (i >> 2) * HALF + (i & 3) * 16), (PG8_LAS unsigned*)(lds + PRE_SLOT + wid * 512 + j * 256), 4, 0, 0); }
    }
    bf16_t* O; size_t split_stride; const float* ssq;
    __device__ __forceinline__ void operator()(const f32x4 (&acc)[2][2][4][2], const Unit& u, int wr, int wc, int fr, int fq, PG8_LAS unsigned char* lds, int wid) const {
        const int t = u.pn >> 2; bf16_t* basep = O + (size_t)t * split_stride;
        const int row0 = u.pm * BM + wr * 64 + fr, col0 = (u.pn & 3) * BM + wc * 32 + 8 * fq;
        const bool act = t >= GELU_FROM;
#pragma unroll
        for (int ai = 0; ai < 2; ++ai)
#pragma unroll
            for (int m = 0; m < 4; ++m) {
                const float rstd = __builtin_amdgcn_rsqf(*(const PG8_LAS float*)(lds + PRE_SLOT + wid * 512 + (m & 1) * 256 + (fr + 16 * ((ai * 4 + m) >> 1)) * 4) * (1.0f / 1024.0f) + 1e-6f);
#pragma unroll
                for (int bj = 0; bj < 2; ++bj) {
                    float h[8];
#pragma unroll
                    for (int n = 0; n < 2; ++n)
#pragma unroll
                        for (int j = 0; j < 4; ++j) { float v = acc[ai][bj][m][n][j] * rstd;
                            if (act) { const float z = 1.5957691216f * (v + 0.044715f * v * v * v); v = v * fast_sigmoid(z); }
                            h[4 * n + j] = v; }
                    u32x4 w; w.x = pk_bf16(h[0], h[1]); w.y = pk_bf16(h[2], h[3]); w.z = pk_bf16(h[4], h[5]); w.w = pk_bf16(h[6], h[7]);
                    *(u32x4*)(basep + (size_t)(row0 + ai * HALF + m * 16) * 1024 + col0 + bj * HALF) = w;
                }
            }
    }
};
template <class Epi, class Sched, bool ALIGN_EPI = false, bool SP2 = false>
__device__ __forceinline__ void gemm_phase(PG8_LAS unsigned char* lds, const Gemm g, const Sched& S, const Epi& E, int wave_s) {
    int tid = wave_s * 64 + lane_id_(); asm volatile("" : "+v"(tid));
    const int wid = __builtin_amdgcn_readfirstlane(tid >> 6), lane = tid & 63, wr = wid >> 2, wc = wid & 3, fr = lane & 15, fq = lane >> 4;
    const int K = g.K, nt = K / BK;
    unsigned voffA[2], voffB[2];
#pragma unroll
    for (int i = 0; i < 2; ++i) { int R, C; stage_rc(tid * 16 + i * 8192, R, C); const int Rb = Epi::PERM ? ((R & ~31) + perm32(R & 31)) : R;
        voffA[i] = (unsigned)(R * K + C) * 2u; voffB[i] = (unsigned)(Rb * K + C) * 2u; }
    const size_t kstep = (size_t)(BK * 2);
    const size_t hstep = (size_t)HALF * K * 2;
    const size_t tstep = 2 * hstep;
    const unsigned ldsw = (unsigned)wid * 1024u;
    const int aoff = lds_byte(wr * 64 + fr, fq * 8), boff = lds_byte(wc * 32 + fr, fq * 8);
#define PG8_SA(b, h) (((b) * 2 + (h)) * HTB)
#define PG8_SB(b, h) ((4 + (b) * 2 + (h)) * HTB)
#define PG8_STAGE(bufoff, gbase, voff) do { const char* gb_ = (const char*)(gbase); asm volatile("" : "+s"(gb_));   \
        _Pragma("unroll") for (int _i = 0; _i < 2; ++_i) \
        __builtin_amdgcn_global_load_lds((const unsigned*)(gb_ + (voff)[_i]), (PG8_LAS unsigned*)(lds + (bufoff) + ldsw + _i * 8192), 16, 0, 0); } while (0)
#define PG8_LDA(dst, b, h) do { _Pragma("unroll") for (int m = 0; m < 4; ++m) _Pragma("unroll") for (int k = 0; k < 2; ++k) dst[m][k] = *(const PG8_LAS bf16x8*)(lds + PG8_SA(b, h) + aoff + m * 2048 + k * 1024); } while (0)
#define PG8_LDB(dst, b, h) do { _Pragma("unroll") for (int n = 0; n < 2; ++n) _Pragma("unroll") for (int k = 0; k < 2; ++k) dst[n][k] = *(const PG8_LAS bf16x8*)(lds + PG8_SB(b, h) + boff + n * 2048 + k * 1024); } while (0)
#define PG8_MMA(ai, bj, At, Bt) do { __builtin_amdgcn_s_setprio(1); _Pragma("unroll") for (int m = 0; m < 4; ++m) _Pragma("unroll") for (int n = 0; n < 2; ++n) _Pragma("unroll") for (int k = 0; k < 2; ++k) \
        acc[ai][bj][m][n] = __builtin_amdgcn_mfma_f32_16x16x32_bf16(Bt[n][k], At[m][k], acc[ai][bj][m][n], 0, 0, 0); __builtin_amdgcn_s_setprio(0); } while (0)
#define PG8_WAIT_V(n) asm volatile("s_waitcnt vmcnt(" #n ")" ::: "memory")
#define PG8_WAIT_L(n) asm volatile("s_waitcnt lgkmcnt(" #n ")" ::: "memory")
#define PG8_WAIT_V8_STRICT() asm volatile("s_waitcnt vmcnt(8)" ::: "memory")
#define PG8_WAIT_V8_RELAX() do { if constexpr (Epi::NSTORES + Epi::NPRE == 10) asm volatile("s_waitcnt vmcnt(18)" ::: "memory"); else if constexpr (Epi::NSTORES + Epi::NPRE == 18) asm volatile("s_waitcnt vmcnt(26)" ::: "memory"); else asm volatile("s_waitcnt vmcnt(8)" ::: "memory"); } while (0)
#define PG8_BAR __builtin_amdgcn_s_barrier()
#define PG8_SCHED __builtin_amdgcn_sched_barrier(0)
#define PG8_SP2_PAIR(WAITM) do { \
            PG8_LDB(B0, 0, 0); PG8_LDB(B1, 0, 1); PG8_SCHED; PG8_LDA(At, 0, 0); PG8_STAGE(PG8_SA(1, 1), a1 + hstep, voffA); \
            WAITM(); PG8_WAIT_L(0); PG8_BAR; PG8_MMA(0, 0, At, B0); PG8_MMA(0, 1, At, B1); PG8_BAR; PG8_SCHED; \
            PG8_LDA(At, 0, 1); PG8_STAGE(PG8_SB(0, 0), b2, voffB); PG8_STAGE(PG8_SB(0, 1), b2 + hstep, voffB); PG8_STAGE(PG8_SA(0, 0), a2, voffA); \
            WAITM(); PG8_WAIT_L(0); PG8_BAR; PG8_MMA(1, 0, At, B0); PG8_MMA(1, 1, At, B1); PG8_BAR; PG8_SCHED; \
            PG8_LDB(B0, 1, 0); PG8_LDB(B1, 1, 1); PG8_SCHED; PG8_LDA(At, 1, 0); PG8_STAGE(PG8_SA(0, 1), a2 + hstep, voffA); \
            WAITM(); PG8_WAIT_L(0); PG8_BAR; PG8_MMA(0, 0, At, B0); PG8_MMA(0, 1, At, B1); PG8_BAR; PG8_SCHED; \
            PG8_LDA(At, 1, 1); PG8_STAGE(PG8_SB(1, 0), b3, voffB); PG8_STAGE(PG8_SB(1, 1), b3 + hstep, voffB); PG8_STAGE(PG8_SA(1, 0), a3, voffA); \
            WAITM(); PG8_WAIT_L(0); PG8_BAR; PG8_MMA(1, 0, At, B0); PG8_MMA(1, 1, At, B1); PG8_BAR; PG8_SCHED; \
            } while (0)
    Unit cur, nxt; int ui = 0; bool peeled = false;
    if (!S.next(0, cur)) return;
    if constexpr (Epi::NPRE > 0) E.prefetch(lds, wid, cur, wr, fr, fq);
    f32x4 acc[2][2][4][2];
#pragma unroll
    for (int a = 0; a < 2; ++a)
#pragma unroll
        for (int b = 0; b < 2; ++b)
#pragma unroll
            for (int m = 0; m < 4; ++m)
#pragma unroll
                for (int n = 0; n < 2; ++n) acc[a][b][m][n] = (f32x4){0.f, 0.f, 0.f, 0.f};
    bf16x8 At[4][2], B0[2][2], B1[2][2];
    const char* cA = (const char*)g.A + (size_t)cur.pm * tstep; const char* cB = (const char*)g.Bt + (size_t)cur.pn * tstep;
    S.a_ready(cur);
    if constexpr (SP2) {
        PG8_STAGE(PG8_SB(0, 0), cB, voffB); PG8_STAGE(PG8_SB(0, 1), cB + hstep, voffB); PG8_STAGE(PG8_SA(0, 0), cA, voffA); PG8_STAGE(PG8_SA(0, 1), cA + hstep, voffA);
        if (wr == 1) PG8_BAR;
        PG8_WAIT_V(2); PG8_BAR;
        PG8_STAGE(PG8_SB(1, 0), cB + kstep, voffB); PG8_STAGE(PG8_SA(1, 0), cA + kstep, voffA); PG8_STAGE(PG8_SB(1, 1), cB + hstep + kstep, voffB);
        PG8_WAIT_V(6); PG8_BAR;
    } else {
        PG8_STAGE(PG8_SB(0, 0), cB, voffB); PG8_STAGE(PG8_SA(0, 0), cA, voffA); PG8_STAGE(PG8_SB(0, 1), cB + hstep, voffB); PG8_STAGE(PG8_SA(0, 1), cA + hstep, voffA);
        if (wr == 1) PG8_BAR;
        PG8_WAIT_V(4); PG8_BAR;
        PG8_STAGE(PG8_SB(1, 0), cB + kstep, voffB); PG8_STAGE(PG8_SA(1, 0), cA + kstep, voffA); PG8_STAGE(PG8_SB(1, 1), cB + hstep + kstep, voffB);
        PG8_WAIT_V(6); PG8_BAR;
    }
    for (;;) {
        const bool has_next = S.next(ui + 1, nxt);
        const char* nA = has_next ? (const char*)g.A + (size_t)nxt.pm * tstep : cA; const char* nB = has_next ? (const char*)g.Bt + (size_t)nxt.pn * tstep : cB;
        for (int t = peeled ? 2 : 0; t < nt; t += 2) {
            const bool last = (t == nt - 2);
            const char* a1 = cA + (size_t)(t + 1) * kstep;
            const char* a2 = last ? nA : cA + (size_t)(t + 2) * kstep; const char* b2 = last ? nB : cB + (size_t)(t + 2) * kstep;
            const char* a3 = a2 + kstep; const char* b3 = b2 + kstep;
            if (last && has_next) S.a_ready(nxt);
            if constexpr (SP2) {
            PG8_SP2_PAIR(PG8_WAIT_V8_STRICT);
            } else {
            PG8_LDB(B0, 0, 0); PG8_SCHED; PG8_LDA(At, 0, 0); PG8_STAGE(PG8_SA(1, 1), a1 + hstep, voffA);
            PG8_WAIT_L(8); PG8_BAR; PG8_WAIT_L(0); PG8_MMA(0, 0, At, B0); PG8_BAR; PG8_SCHED;
            PG8_LDB(B1, 0, 1); PG8_STAGE(PG8_SB(0, 0), b2, voffB);
            PG8_BAR; PG8_WAIT_L(0); PG8_MMA(0, 1, At, B1); PG8_BAR;
            PG8_LDA(At, 0, 1); PG8_STAGE(PG8_SA(0, 0), a2, voffA);
            PG8_BAR; PG8_WAIT_L(0); PG8_MMA(1, 0, At, B0); PG8_BAR; PG8_SCHED;
            PG8_STAGE(PG8_SB(0, 1), b2 + hstep, voffB);
            PG8_WAIT_V(6); PG8_BAR; PG8_MMA(1, 1, At, B1); PG8_BAR;
            PG8_LDB(B0, 1, 0); PG8_SCHED; PG8_LDA(At, 1, 0); PG8_STAGE(PG8_SA(0, 1), a2 + hstep, voffA);
            PG8_WAIT_L(8); PG8_BAR; PG8_WAIT_L(0); PG8_MMA(0, 0, At, B0); PG8_BAR; PG8_SCHED;
            PG8_LDB(B1, 1, 1); PG8_STAGE(PG8_SB(1, 0), b3, voffB);
            PG8_BAR; PG8_WAIT_L(0); PG8_MMA(0, 1, At, B1); PG8_BAR;
            PG8_LDA(At, 1, 1); PG8_STAGE(PG8_SA(1, 0), a3, voffA);
            PG8_BAR; PG8_WAIT_L(0); PG8_MMA(1, 0, At, B0); PG8_BAR; PG8_SCHED;
            PG8_STAGE(PG8_SB(1, 1), b3 + hstep, voffB);
            PG8_WAIT_V(6); PG8_BAR; PG8_MMA(1, 1, At, B1); PG8_BAR;
            }
        }
        if constexpr (ALIGN_EPI) { if (wr == 0) PG8_BAR; }
        if constexpr (!Epi::AFTER_DRAIN) { E(acc, cur, wr, wc, fr, fq, lds, wid); S.done(cur); }
        if (!has_next) break;
#pragma unroll
        for (int a = 0; a < 2; ++a)
#pragma unroll
            for (int b = 0; b < 2; ++b)
#pragma unroll
                for (int m = 0; m < 4; ++m)
#pragma unroll
                    for (int n = 0; n < 2; ++n) acc[a][b][m][n] = (f32x4){0.f, 0.f, 0.f, 0.f};
        cur = nxt; cA = nA; cB = nB; ++ui;
        if constexpr (ALIGN_EPI) { if (wr == 1) PG8_BAR; }
        if constexpr (Epi::NPRE > 0) E.prefetch(lds, wid, cur, wr, fr, fq);
        if constexpr (SP2 && Epi::NSTORES > 0 && !Epi::AFTER_DRAIN) {
            const char* a1 = cA + kstep; const char* a2 = cA + 2 * kstep; const char* b2 = cB + 2 * kstep; const char* a3 = a2 + kstep; const char* b3 = b2 + kstep;
            PG8_SP2_PAIR(PG8_WAIT_V8_RELAX);
            peeled = true;
        }
    }
    PG8_WAIT_V(0);
    if constexpr (!ALIGN_EPI) { if (wr == 0) PG8_BAR; }
    PG8_BAR;
    if constexpr (Epi::AFTER_DRAIN) { E.fused(acc, cur, wr, wc, fr, fq, lds, wid, lane); S.done(cur); }
#undef PG8_SA
#undef PG8_SB
#undef PG8_STAGE
#undef PG8_LDA
#undef PG8_LDB
#undef PG8_MMA
#undef PG8_WAIT_V
#undef PG8_WAIT_L
#undef PG8_SP2_PAIR
#undef PG8_BAR
#undef PG8_SCHED
}
}
constexpr int BATCH = 8, SEQ = 2048, D = 1024, M = BATCH * SEQ, FF = 2816, NH = 16, HD = 64;
constexpr float EPS = 1e-6f;
constexpr size_t MiB = 1u << 20;
constexpr size_t WS_CTL = 0, WS_SSQ = 65536, CTL_ZERO_BYTES = 65536 + 6 * 65536;
constexpr size_t WS_SUM = 1 * MiB;
constexpr size_t WS_W = 3 * MiB;
constexpr size_t SZ_WIN = (size_t)2 * FF * D * 2, SZ_WOUT = (size_t)D * FF * 2;
constexpr size_t W_FF0 = WS_W, W_FF1 = W_FF0 + SZ_WIN + SZ_WOUT, W_FF2 = W_FF1 + SZ_WIN + SZ_WOUT, W_FF3 = W_FF2 + SZ_WIN + SZ_WOUT;
constexpr size_t W_QKV = W_FF3 + SZ_WIN + SZ_WOUT, W_O = W_QKV + (size_t)3 * D * D * 2, W_LIN = W_O + (size_t)D * D * 2, W_LO = W_LIN + (size_t)2 * D * D * 2;
constexpr size_t W_GR = W_LO + (size_t)D * D * 2, W_GI = W_GR + 16 * 64 * 64 * 2, W_END = W_GI + 16 * 64 * 64 * 2;
constexpr size_t WS_XN = 84 * MiB;
constexpr size_t WS_ACT = 116 * MiB;
constexpr size_t WS_END = WS_ACT + 96 * MiB;
static_assert(W_END <= WS_XN && WS_XN + (size_t)M * D * 2 <= WS_ACT && WS_END <= 256 * MiB && (size_t)M * FF * 2 <= 96 * MiB, "d_ws map");
constexpr int LDS_BYTES = 147456;

#define LAS __attribute__((address_space(3)))
typedef unsigned short bf16;
typedef unsigned v4u __attribute__((ext_vector_type(4)));
typedef unsigned v2u __attribute__((ext_vector_type(2)));
typedef float f32x4 __attribute__((ext_vector_type(4)));
typedef float f32x16 __attribute__((ext_vector_type(16)));
typedef short bf16x8 __attribute__((ext_vector_type(8)));
using pg8::pk_bf16;
__device__ __forceinline__ float bf_lo(unsigned u) { return __uint_as_float(u << 16); }
__device__ __forceinline__ float bf_hi(unsigned u) { return __uint_as_float(u & 0xffff0000u); }
__device__ __forceinline__ float wave_sum(float v) {
#pragma unroll
    for (int o = 1; o < 64; o <<= 1) v += __shfl_xor(v, o);
    return v;
}
#define LOG2E 1.44269504089f
#define LN2 0.69314718056f

__device__ __forceinline__ void transpose_tile(const float* W, const float* gain, int K, int N, int k0, int n0, bf16* WT, int drow0, LAS float* scr, int lane) {
    f32x4 v[8]; float gv[8];
    const int r0 = lane >> 3, c4 = lane & 7;
#pragma unroll
    for (int i = 0; i < 8; ++i) { v[i] = *(const f32x4*)(W + (size_t)(k0 + r0 + 8 * i) * N + n0 + 4 * c4); gv[i] = gain ? gain[k0 + r0 + 8 * i] : 1.0f; }
#pragma unroll
    for (int i = 0; i < 8; ++i) { LAS float* d = scr + (r0 + 8 * i) * 33 + 4 * c4; d[0] = v[i][0] * gv[i]; d[1] = v[i][1] * gv[i]; d[2] = v[i][2] * gv[i]; d[3] = v[i][3] * gv[i]; }
    asm volatile("s_waitcnt lgkmcnt(0)" ::: "memory");
    const int c = lane & 7;
#pragma unroll
    for (int j = 0; j < 4; ++j) { const int n = (lane >> 3) + 8 * j; const LAS float* s = scr + (8 * c) * 33 + n;
        v4u o; o.x = pk_bf16(s[0 * 33], s[1 * 33]); o.y = pk_bf16(s[2 * 33], s[3 * 33]); o.z = pk_bf16(s[4 * 33], s[5 * 33]); o.w = pk_bf16(s[6 * 33], s[7 * 33]);
        *(v4u*)(WT + (size_t)(drow0 + n) * K + k0 + 8 * c) = o; }
    asm volatile("s_waitcnt lgkmcnt(0)" ::: "memory");
}
template <bool SWIGLU> __device__ __forceinline__ void transpose_item(const float* W, const float* gain, int K, int N, bf16* WT, LAS float* scr, int item, int lane) {
    const int nblk = N / 32, kb = item / nblk, nb = item % nblk, n0 = 32 * nb;
    int drow0 = n0;
    if (SWIGLU) { const int up = n0 >= FF, f = up ? n0 - FF : n0; drow0 = 256 * (f >> 7) + (up ? 128 : 0) + (f & 127); }
    transpose_tile(W, gain, K, N, 64 * kb, n0, WT, drow0, scr, lane);
}

__device__ __forceinline__ void cvt_phase(const float* x, bf16* xn, float* ssq, int gw, int ngw, int lane) {
    for (int m = gw; m < M; m += ngw) {
        const f32x4* xr = (const f32x4*)(x + (size_t)m * D) + lane;
        f32x4 v[4]; float s = 0.f;
#pragma unroll
        for (int j = 0; j < 4; ++j) { v[j] = xr[64 * j]; s += (v[j].x * v[j].x + v[j].y * v[j].y) + (v[j].z * v[j].z + v[j].w * v[j].w); }
        s = wave_sum(s);
        if (lane == 0) ssq[m] = s;
        v2u* o = (v2u*)(xn + (size_t)m * D) + lane;
#pragma unroll
        for (int j = 0; j < 4; ++j) { v2u w; w.x = pk_bf16(v[j].x, v[j].y); w.y = pk_bf16(v[j].z, v[j].w); o[64 * j] = w; }
    }
}

constexpr int KP = 72;
constexpr float SB_EXIT = 40.0f * 1.44269504089f;
typedef short v4i16_t __attribute__((ext_vector_type(4)));
__device__ __forceinline__ v2u vtr(const LAS bf16* p) { return __builtin_bit_cast(v2u, __builtin_amdgcn_ds_read_tr16_b64_v4i16((LAS v4i16_t*)p)); }
__device__ __forceinline__ void attn_phase(LAS unsigned char* lds, const bf16* Q, const bf16* K, const bf16* V, bf16* O, const float* qg, const float* kg, int gw, int ngw, int wave_s) {
    int tid_ = wave_s * 64 + lane_id_(); asm volatile("" : "+v"(tid_));
    const int lane = tid_ & 63, w = __builtin_amdgcn_readfirstlane(tid_ >> 6), hi = lane >> 5, ql = lane & 31;
    LAS bf16* Ks = (LAS bf16*)(lds + w * (64 * KP * 2));
    LAS bf16* Vs = Ks + 32 * KP;
    const int skey = lane >> 3, sch = lane & 7;
    const LAS bf16* vtb = Vs + (4 * hi + ((lane & 15) >> 2)) * KP + 16 * ((lane >> 4) & 1) + 4 * (lane & 3);
    for (int wu = gw; wu < BATCH * NH * 64; wu += ngw) {
        const int qblk = wu & 63, bh = wu >> 6, b = bh >> 4, h = bh & 15;
        const int tq = 32 * qblk + ql;
        bf16x8 qf[4];
        {
            const bf16* qp = Q + (size_t)(b * SEQ + tq) * D + h * HD + 8 * hi;
            float qv[4][8]; float ss = 0.f;
#pragma unroll
            for (int s = 0; s < 4; ++s) { const v4u r = *(const v4u*)(qp + 16 * s);
                qv[s][0] = bf_lo(r.x); qv[s][1] = bf_hi(r.x); qv[s][2] = bf_lo(r.y); qv[s][3] = bf_hi(r.y); qv[s][4] = bf_lo(r.z); qv[s][5] = bf_hi(r.z); qv[s][6] = bf_lo(r.w); qv[s][7] = bf_hi(r.w);
#pragma unroll
                for (int j = 0; j < 8; ++j) ss += qv[s][j] * qv[s][j]; }
            ss += __shfl_xor(ss, 32);
            const float rs = (0.125f * LOG2E) * __builtin_amdgcn_rsqf(ss * (1.f / HD) + EPS);
#pragma unroll
            for (int s = 0; s < 4; ++s) { float gp[8];
#pragma unroll
                for (int j = 0; j < 8; ++j) gp[j] = qg[16 * s + 8 * hi + j] * kg[16 * s + 8 * hi + j];
                v4u p;
                p.x = pk_bf16(qv[s][0] * rs * gp[0], qv[s][1] * rs * gp[1]); p.y = pk_bf16(qv[s][2] * rs * gp[2], qv[s][3] * rs * gp[3]);
                p.z = pk_bf16(qv[s][4] * rs * gp[4], qv[s][5] * rs * gp[5]); p.w = pk_bf16(qv[s][6] * rs * gp[6], qv[s][7] * rs * gp[7]);
                qf[s] = __builtin_bit_cast(bf16x8, p); }
        }
        f32x16 o0, o1;
#pragma unroll
        for (int i = 0; i < 16; ++i) { o0[i] = 0.f; o1[i] = 0.f; }
        float R = 0.f;
        v4u krA[4], vrA[4], krB[4], vrB[4];
        int kb = qblk;
        const bf16* kbase = K + (size_t)(b * SEQ + skey) * D + h * HD + 8 * sch;
        const bf16* vbase = V + (size_t)(b * SEQ + skey) * D + h * HD + 8 * sch;
#define ATT_LOAD(KR, VR, KBL) do { _Pragma("unroll") for (int i = 0; i < 4; ++i) { KR[i] = *(const v4u*)(kbase + (size_t)(32 * (KBL) + 8 * i) * D); VR[i] = *(const v4u*)(vbase + (size_t)(32 * (KBL) + 8 * i) * D); } } while (0)
#define ATT_BLOCK(KR, VR, KBC) do { \
            _Pragma("unroll") for (int i = 0; i < 4; ++i) { \
                float kf[8] = {bf_lo(KR[i].x), bf_hi(KR[i].x), bf_lo(KR[i].y), bf_hi(KR[i].y), bf_lo(KR[i].z), bf_hi(KR[i].z), bf_lo(KR[i].w), bf_hi(KR[i].w)}; \
                float ss = 0.f; \
                _Pragma("unroll") for (int j = 0; j < 8; ++j) ss += kf[j] * kf[j]; \
                ss += __uint_as_float(__builtin_amdgcn_mov_dpp(__float_as_uint(ss), 0xB1, 0xF, 0xF, true)); ss += __uint_as_float(__builtin_amdgcn_mov_dpp(__float_as_uint(ss), 0x4E, 0xF, 0xF, true)); ss += __uint_as_float(__builtin_amdgcn_mov_dpp(__float_as_uint(ss), 0x141, 0xF, 0xF, true)); \
                const float rs = __builtin_amdgcn_rsqf(ss * (1.f / HD) + EPS); \
                v4u p_; p_.x = pk_bf16(kf[0] * rs, kf[1] * rs); p_.y = pk_bf16(kf[2] * rs, kf[3] * rs); \
                p_.z = pk_bf16(kf[4] * rs, kf[5] * rs); p_.w = pk_bf16(kf[6] * rs, kf[7] * rs); \
                *(LAS v4u*)(Ks + (skey + 8 * i) * KP + 8 * sch) = p_; \
                *(LAS v4u*)(Vs + (skey + 8 * i) * KP + 8 * sch) = VR[i]; \
            } \
            if ((KBC) >= 2) ATT_LOAD(KR, VR, (KBC) - 2); \
            f32x16 p; \
            _Pragma("unroll") for (int i = 0; i < 16; ++i) p[i] = 0.f; \
            _Pragma("unroll") for (int s = 0; s < 4; ++s) { const bf16x8 kf = *(const LAS bf16x8*)(Ks + ql * KP + 16 * s + 8 * hi); \
                p = __builtin_amdgcn_mfma_f32_32x32x16_bf16(kf, qf[s], p, 0, 0, 0); } \
            const bool diag = ((KBC) == qblk); \
            { \
                float sp[16], lb[16]; \
                _Pragma("unroll") for (int i = 0; i < 16; ++i) { \
                    const float z = p[i]; \
                    const float e = __builtin_amdgcn_exp2f(-fabsf(z)); \
                    const float l = __builtin_amdgcn_logf(1.0f + e); \
                    const int kl = 8 * (i >> 2) + 4 * hi + (i & 3); \
                    const bool valid = !diag || (kl < ql); \
                    sp[i] = valid ? fmaxf(z, 0.f) + l : 0.f; \
                    lb[i] = valid ? fminf(z, 0.f) - l : -1e30f; \
                } \
                float run = R; \
                _Pragma("unroll") for (int g = 3; g >= 0; --g) { \
                    const float Gm = (sp[4 * g] + sp[4 * g + 1]) + (sp[4 * g + 2] + sp[4 * g + 3]); \
                    const float Go = __shfl_xor(Gm, 32); \
                    const float aft = hi ? run : run + Go; \
                    const float e3 = aft, e2 = e3 + sp[4 * g + 3], e1 = e2 + sp[4 * g + 2], e0 = e1 + sp[4 * g + 1]; \
                    p[4 * g + 3] = __builtin_amdgcn_exp2f(lb[4 * g + 3] - e3); \
                    p[4 * g + 2] = __builtin_amdgcn_exp2f(lb[4 * g + 2] - e2); \
                    p[4 * g + 1] = __builtin_amdgcn_exp2f(lb[4 * g + 1] - e1); \
                    p[4 * g + 0] = __builtin_amdgcn_exp2f(lb[4 * g + 0] - e0); \
                    run += Gm + Go; \
                } \
                R = run; \
            } \
            _Pragma("unroll") for (int s2 = 0; s2 < 2; ++s2) { \
                v4u pa; pa.x = pk_bf16(p[8 * s2 + 0], p[8 * s2 + 1]); pa.y = pk_bf16(p[8 * s2 + 2], p[8 * s2 + 3]); \
                pa.z = pk_bf16(p[8 * s2 + 4], p[8 * s2 + 5]); pa.w = pk_bf16(p[8 * s2 + 6], p[8 * s2 + 7]); \
                const bf16x8 pav = __builtin_bit_cast(bf16x8, pa); \
                const LAS bf16* vp = vtb + (16 * s2) * KP; \
                v4u vb; { const v2u a_ = vtr(vp), c_ = vtr(vp + 8 * KP); vb.x = a_.x; vb.y = a_.y; vb.z = c_.x; vb.w = c_.y; } \
                o0 = __builtin_amdgcn_mfma_f32_32x32x16_bf16(pav, __builtin_bit_cast(bf16x8, vb), o0, 0, 0, 0); \
                { const v2u a_ = vtr(vp + 32), c_ = vtr(vp + 8 * KP + 32); vb.x = a_.x; vb.y = a_.y; vb.z = c_.x; vb.w = c_.y; } \
                o1 = __builtin_amdgcn_mfma_f32_32x32x16_bf16(pav, __builtin_bit_cast(bf16x8, vb), o1, 0, 0, 0); \
            } \
            done = ((KBC) == 0) || (__builtin_amdgcn_ballot_w64(R < SB_EXIT) == 0ull); \
        } while (0)
        ATT_LOAD(krA, vrA, kb);
        if (kb >= 1) ATT_LOAD(krB, vrB, kb - 1);
        for (;;) {
            bool done;
            ATT_BLOCK(krA, vrA, kb);
            if (done) break;
            ATT_BLOCK(krB, vrB, kb - 1);
            if (done) break;
            kb -= 2;
        }
#undef ATT_LOAD
#undef ATT_BLOCK
        {
            LAS bf16* Ot = Ks;
#pragma unroll
            for (int i = 0; i < 16; ++i) { const int r = 8 * (i >> 2) + 4 * hi + (i & 3);
                Ot[r * KP + ql] = (bf16)(pk_bf16(o0[i], 0.f) & 0xffffu); Ot[r * KP + 32 + ql] = (bf16)(pk_bf16(o1[i], 0.f) & 0xffffu); }
            bf16* op = O + (size_t)(b * SEQ + 32 * qblk + skey) * D + h * HD + 8 * sch;
#pragma unroll
            for (int i = 0; i < 4; ++i) *(v4u*)(op + (size_t)(8 * i) * D) = *(const LAS v4u*)(Ot + (skey + 8 * i) * KP + 8 * sch);
        }
    }
}

__device__ __forceinline__ void attn_phase2(LAS unsigned char* lds, const bf16* Q, const bf16* K, const bf16* V, bf16* O, const float* qg, const float* kg, int gw, int ngw, int wave_s) {
    int tid_ = wave_s * 64 + lane_id_(); asm volatile("" : "+v"(tid_));
    const int lane = tid_ & 63, w = __builtin_amdgcn_readfirstlane(tid_ >> 6), hi = lane >> 5, ql = lane & 31;
    LAS bf16* Ks = (LAS bf16*)(lds + w * (64 * KP * 2));
    LAS bf16* Vs = Ks + 32 * KP;
    const int skey = lane >> 3, sch = lane & 7;
    const LAS bf16* vtb = Vs + (4 * hi + ((lane & 15) >> 2)) * KP + 16 * ((lane >> 4) & 1) + 4 * (lane & 3);
    for (int wu = gw; wu < BATCH * NH * 32; wu += ngw) {
        const int pq = wu & 31, bh = wu >> 5, b = bh >> 4, h = bh & 15;
        const int qblk0 = 2 * pq, qblk1 = 2 * pq + 1;
        bf16x8 qfa[4], qfb[4];
#define ATT_LOADQ(QF, QBLK) do { \
            const bf16* qp = Q + (size_t)(b * SEQ + 32 * (QBLK) + ql) * D + h * HD + 8 * hi; \
            float qv[4][8]; float ss = 0.f; \
            _Pragma("unroll") for (int s = 0; s < 4; ++s) { const v4u r = *(const v4u*)(qp + 16 * s); \
                qv[s][0] = bf_lo(r.x); qv[s][1] = bf_hi(r.x); qv[s][2] = bf_lo(r.y); qv[s][3] = bf_hi(r.y); qv[s][4] = bf_lo(r.z); qv[s][5] = bf_hi(r.z); qv[s][6] = bf_lo(r.w); qv[s][7] = bf_hi(r.w); \
                _Pragma("unroll") for (int j = 0; j < 8; ++j) ss += qv[s][j] * qv[s][j]; } \
            ss += __shfl_xor(ss, 32); \
            const float rs = (0.125f * LOG2E) * __builtin_amdgcn_rsqf(ss * (1.f / HD) + EPS); \
            _Pragma("unroll") for (int s = 0; s < 4; ++s) { float gp[8]; \
                _Pragma("unroll") for (int j = 0; j < 8; ++j) gp[j] = qg[16 * s + 8 * hi + j] * kg[16 * s + 8 * hi + j]; \
                v4u p; \
                p.x = pk_bf16(qv[s][0] * rs * gp[0], qv[s][1] * rs * gp[1]); p.y = pk_bf16(qv[s][2] * rs * gp[2], qv[s][3] * rs * gp[3]); \
                p.z = pk_bf16(qv[s][4] * rs * gp[4], qv[s][5] * rs * gp[5]); p.w = pk_bf16(qv[s][6] * rs * gp[6], qv[s][7] * rs * gp[7]); \
                QF[s] = __builtin_bit_cast(bf16x8, p); } } while (0)
        ATT_LOADQ(qfa, qblk0);
        ATT_LOADQ(qfb, qblk1);
        f32x16 oa0, oa1, ob0, ob1;
#pragma unroll
        for (int i = 0; i < 16; ++i) { oa0[i] = 0.f; oa1[i] = 0.f; ob0[i] = 0.f; ob1[i] = 0.f; }
        float Ra = 0.f, Rb = 0.f;
        bool da = false, db = false;
        v4u kr[4], vr[4];
        int kb = qblk1;
        const bf16* kbase = K + (size_t)(b * SEQ + skey) * D + h * HD + 8 * sch;
        const bf16* vbase = V + (size_t)(b * SEQ + skey) * D + h * HD + 8 * sch;
#pragma unroll
        for (int i = 0; i < 4; ++i) { kr[i] = *(const v4u*)(kbase + (size_t)(32 * kb + 8 * i) * D); vr[i] = *(const v4u*)(vbase + (size_t)(32 * kb + 8 * i) * D); }
#define ATT_TILE(QF, O0, O1, RR, DIAG) do { \
            f32x16 p; \
            _Pragma("unroll") for (int i = 0; i < 16; ++i) p[i] = 0.f; \
            _Pragma("unroll") for (int s = 0; s < 4; ++s) { const bf16x8 kf = *(const LAS bf16x8*)(Ks + ql * KP + 16 * s + 8 * hi); \
                p = __builtin_amdgcn_mfma_f32_32x32x16_bf16(kf, QF[s], p, 0, 0, 0); } \
            const bool diag = (DIAG); \
            { \
                float sp[16], lb[16]; \
                _Pragma("unroll") for (int i = 0; i < 16; ++i) { \
                    const float z = p[i]; \
                    const float e = __builtin_amdgcn_exp2f(-fabsf(z)); \
                    const float l = __builtin_amdgcn_logf(1.0f + e); \
                    const int kl = 8 * (i >> 2) + 4 * hi + (i & 3); \
                    const bool valid = !diag || (kl < ql); \
                    sp[i] = valid ? fmaxf(z, 0.f) + l : 0.f; \
                    lb[i] = valid ? fminf(z, 0.f) - l : -1e30f; \
                } \
                float run = RR; \
                _Pragma("unroll") for (int g = 3; g >= 0; --g) { \
                    const float Gm = (sp[4 * g] + sp[4 * g + 1]) + (sp[4 * g + 2] + sp[4 * g + 3]); \
                    const float Go = __shfl_xor(Gm, 32); \
                    const float aft = hi ? run : run + Go; \
                    const float e3 = aft, e2 = e3 + sp[4 * g + 3], e1 = e2 + sp[4 * g + 2], e0 = e1 + sp[4 * g + 1]; \
                    p[4 * g + 3] = __builtin_amdgcn_exp2f(lb[4 * g + 3] - e3); \
                    p[4 * g + 2] = __builtin_amdgcn_exp2f(lb[4 * g + 2] - e2); \
                    p[4 * g + 1] = __builtin_amdgcn_exp2f(lb[4 * g + 1] - e1); \
                    p[4 * g + 0] = __builtin_amdgcn_exp2f(lb[4 * g + 0] - e0); \
                    run += Gm + Go; \
                } \
                RR = run; \
            } \
            _Pragma("unroll") for (int s2 = 0; s2 < 2; ++s2) { \
                v4u pa; pa.x = pk_bf16(p[8 * s2 + 0], p[8 * s2 + 1]); pa.y = pk_bf16(p[8 * s2 + 2], p[8 * s2 + 3]); \
                pa.z = pk_bf16(p[8 * s2 + 4], p[8 * s2 + 5]); pa.w = pk_bf16(p[8 * s2 + 6], p[8 * s2 + 7]); \
                const bf16x8 pav = __builtin_bit_cast(bf16x8, pa); \
                const LAS bf16* vp = vtb + (16 * s2) * KP; \
                v4u vb; { const v2u a_ = vtr(vp), c_ = vtr(vp + 8 * KP); vb.x = a_.x; vb.y = a_.y; vb.z = c_.x; vb.w = c_.y; } \
                O0 = __builtin_amdgcn_mfma_f32_32x32x16_bf16(pav, __builtin_bit_cast(bf16x8, vb), O0, 0, 0, 0); \
                { const v2u a_ = vtr(vp + 32), c_ = vtr(vp + 8 * KP + 32); vb.x = a_.x; vb.y = a_.y; vb.z = c_.x; vb.w = c_.y; } \
                O1 = __builtin_amdgcn_mfma_f32_32x32x16_bf16(pav, __builtin_bit_cast(bf16x8, vb), O1, 0, 0, 0); \
            } \
        } while (0)
        for (;;) {
#pragma unroll
            for (int i = 0; i < 4; ++i) {
                float kf[8] = {bf_lo(kr[i].x), bf_hi(kr[i].x), bf_lo(kr[i].y), bf_hi(kr[i].y), bf_lo(kr[i].z), bf_hi(kr[i].z), bf_lo(kr[i].w), bf_hi(kr[i].w)};
                float ss = 0.f;
#pragma unroll
                for (int j = 0; j < 8; ++j) ss += kf[j] * kf[j];
                ss += __uint_as_float(__builtin_amdgcn_mov_dpp(__float_as_uint(ss), 0xB1, 0xF, 0xF, true)); ss += __uint_as_float(__builtin_amdgcn_mov_dpp(__float_as_uint(ss), 0x4E, 0xF, 0xF, true)); ss += __uint_as_float(__builtin_amdgcn_mov_dpp(__float_as_uint(ss), 0x141, 0xF, 0xF, true));
                const float rs = __builtin_amdgcn_rsqf(ss * (1.f / HD) + EPS);
                v4u p_; p_.x = pk_bf16(kf[0] * rs, kf[1] * rs); p_.y = pk_bf16(kf[2] * rs, kf[3] * rs); p_.z = pk_bf16(kf[4] * rs, kf[5] * rs); p_.w = pk_bf16(kf[6] * rs, kf[7] * rs);
                *(LAS v4u*)(Ks + (skey + 8 * i) * KP + 8 * sch) = p_;
                *(LAS v4u*)(Vs + (skey + 8 * i) * KP + 8 * sch) = vr[i];
            }
            if (kb > 0) {
#pragma unroll
                for (int i = 0; i < 4; ++i) { kr[i] = *(const v4u*)(kbase + (size_t)(32 * (kb - 1) + 8 * i) * D); vr[i] = *(const v4u*)(vbase + (size_t)(32 * (kb - 1) + 8 * i) * D); }
            }
            if (!db) { ATT_TILE(qfb, ob0, ob1, Rb, kb == qblk1); db = (__builtin_amdgcn_ballot_w64(Rb < SB_EXIT) == 0ull); }
            if (kb <= qblk0 && !da) { ATT_TILE(qfa, oa0, oa1, Ra, kb == qblk0); da = (__builtin_amdgcn_ballot_w64(Ra < SB_EXIT) == 0ull); }
            if (kb == 0 || (da && db)) break;
            --kb;
        }
#undef ATT_LOADQ
#undef ATT_TILE
#define ATT_STORE(O0, O1, QBLK) do { \
            LAS bf16* Ot = Ks; \
            _Pragma("unroll") for (int i = 0; i < 16; ++i) { const int r = 8 * (i >> 2) + 4 * hi + (i & 3); \
                Ot[r * KP + ql] = (bf16)(pk_bf16(O0[i], 0.f) & 0xffffu); Ot[r * KP + 32 + ql] = (bf16)(pk_bf16(O1[i], 0.f) & 0xffffu); } \
            bf16* op = O + (size_t)(b * SEQ + 32 * (QBLK) + skey) * D + h * HD + 8 * sch; \
            _Pragma("unroll") for (int i = 0; i < 4; ++i) *(v4u*)(op + (size_t)(8 * i) * D) = *(const LAS v4u*)(Ot + (skey + 8 * i) * KP + 8 * sch); } while (0)
        ATT_STORE(oa0, oa1, qblk0);
        ATT_STORE(ob0, ob1, qblk1);
#undef ATT_STORE
    }
}

constexpr int LT = 128, NCH = SEQ / LT;
#define LDS_BARRIER() do { asm volatile("s_waitcnt lgkmcnt(0)" ::: "memory"); __builtin_amdgcn_s_barrier(); asm volatile("" ::: "memory"); } while (0)
__device__ __forceinline__ void lru_phase(LAS unsigned char* lds, const bf16* XB, const bf16* Y, bf16* HY, const bf16* WRt, const bf16* WIt,
        const float* convw, const float* convb, const float* br, const float* bi, const float* lam, unsigned long long* gran, int G, int bid, int wave_s) {
    int tid = wave_s * 64 + lane_id_(); asm volatile("" : "+v"(tid));
    const int lane = tid & 63, w = __builtin_amdgcn_readfirstlane(tid >> 6), hi = lane >> 5, ql = lane & 31;
    LAS float* xcF = (LAS float*)lds;
    LAS bf16* wL = (LAS bf16*)(lds + 32768);
    LAS bf16* xcB = (LAS bf16*)(lds + 65536);
    LAS float* segA = (LAS float*)(lds + 65536 + 128 * KP * 2);
    LAS float* segH = segA + 512;
    LAS float* pA = segH + 512;
    LAS float* pH = pA + 1024;
    LAS bf16* yL = (LAS bf16*)(lds + 65536 + 128 * KP * 2 + 16384);
    const int st = tid >> 3, cc = 8 * (tid & 7);
    LAS float* parL = (LAS float*)(lds + 118784);
    int n_loaded = -1;
    const int rb = w >> 1, cbk = w & 1, d = 32 * cbk + ql;
    v4u xt[2][4], yv[2];
#define LRU_LOAD_X(u_) do { const int ch_ = (u_) >> 7, bn_ = (u_) & 127, b_ = bn_ >> 4, n_ = bn_ & 15, t0_ = ch_ * LT, c0_ = 64 * n_; \
        _Pragma("unroll") for (int r = 0; r < 2; ++r) { yv[r] = *(const v4u*)(Y + (size_t)(b_ * SEQ + t0_ + st + 64 * r) * D + c0_ + cc); \
            _Pragma("unroll") for (int j = 0; j < 4; ++j) { const int ts = t0_ + st + 64 * r + j - 3; xt[r][j] = ts >= 0 ? *(const v4u*)(XB + (size_t)(b_ * SEQ + ts) * D + c0_ + cc) : (v4u){0u, 0u, 0u, 0u}; } } } while (0)
    if (bid < BATCH * 16 * NCH) LRU_LOAD_X(bid);
    for (int unit = bid; unit < BATCH * 16 * NCH; unit += G) {
        const int ch = unit >> 7, bn = unit & 127, b = bn >> 4, n = bn & 15;
        const int t0 = ch * LT, c0 = 64 * n;
        if (n != n_loaded) {
            LDS_BARRIER();
            if (tid < 256) parL[tid] = convw[(tid >> 6) * D + c0 + (tid & 63)];
            else if (tid < 320) parL[tid] = convb[c0 + tid - 256];
            else if (tid < 384) parL[tid] = br[c0 + tid - 320];
            else if (tid < 448) parL[tid] = bi[c0 + tid - 384];
            else { const float lm = lam[c0 + tid - 448]; parL[tid] = -8.0f * (fmaxf(-lm, 0.f) + __builtin_amdgcn_logf(1.0f + __builtin_amdgcn_exp2f(-fabsf(lm) * LOG2E)) * LN2); }
#pragma unroll
            for (int r = 0; r < 2; ++r) { const int e = tid + 512 * r, gate = e >> 9, row = (e >> 3) & 63, chk = e & 7;
                *(LAS v4u*)(wL + (gate * 64 + row) * KP + 8 * chk) = *(const v4u*)((gate ? WIt : WRt) + (size_t)n * 4096 + row * 64 + 8 * chk); }
            n_loaded = n;
        }
        LDS_BARRIER();
        {
            float cw[4][8], cb[8];
#pragma unroll
            for (int j = 0; j < 4; ++j) { const f32x4 c0v = *(const LAS f32x4*)(parL + j * 64 + cc), c1v = *(const LAS f32x4*)(parL + j * 64 + cc + 4);
                cw[j][0] = c0v[0]; cw[j][1] = c0v[1]; cw[j][2] = c0v[2]; cw[j][3] = c0v[3]; cw[j][4] = c1v[0]; cw[j][5] = c1v[1]; cw[j][6] = c1v[2]; cw[j][7] = c1v[3]; }
            { const f32x4 c0v = *(const LAS f32x4*)(parL + 256 + cc), c1v = *(const LAS f32x4*)(parL + 256 + cc + 4);
                cb[0] = c0v[0]; cb[1] = c0v[1]; cb[2] = c0v[2]; cb[3] = c0v[3]; cb[4] = c1v[0]; cb[5] = c1v[1]; cb[6] = c1v[2]; cb[7] = c1v[3]; }
#pragma unroll
            for (int r = 0; r < 2; ++r) {
                const int t = st + 64 * r;
                float acc[8];
#pragma unroll
                for (int e = 0; e < 8; ++e) acc[e] = cb[e];
#pragma unroll
                for (int j = 0; j < 4; ++j) {
                    const v4u x = xt[r][j];
                    acc[0] += cw[j][0] * bf_lo(x.x); acc[1] += cw[j][1] * bf_hi(x.x); acc[2] += cw[j][2] * bf_lo(x.y); acc[3] += cw[j][3] * bf_hi(x.y);
                    acc[4] += cw[j][4] * bf_lo(x.z); acc[5] += cw[j][5] * bf_hi(x.z); acc[6] += cw[j][6] * bf_lo(x.w); acc[7] += cw[j][7] * bf_hi(x.w);
                }
                *(LAS f32x4*)(xcF + t * 64 + cc) = (f32x4){acc[0], acc[1], acc[2], acc[3]}; *(LAS f32x4*)(xcF + t * 64 + cc + 4) = (f32x4){acc[4], acc[5], acc[6], acc[7]};
                v4u p; p.x = pk_bf16(acc[0], acc[1]); p.y = pk_bf16(acc[2], acc[3]); p.z = pk_bf16(acc[4], acc[5]); p.w = pk_bf16(acc[6], acc[7]);
                *(LAS v4u*)(xcB + t * KP + cc) = p;
                *(LAS v4u*)(yL + t * KP + cc) = yv[r];
            }
        }
        if (unit + G < BATCH * 16 * NCH) LRU_LOAD_X(unit + G);
        LDS_BARRIER();
        unsigned xa[2] = {0u, 0u}, xh[2] = {0u, 0u}, xt_[2] = {0u, 0u};
#pragma unroll
        for (int q = 0; q < 2; ++q) { const int kk = w + 8 * q;
            if (kk < ch) { const unsigned long long* g = gran + ((size_t)(b * NCH + kk) * D + c0 + lane) * 2;
                const unsigned long long ya = __hip_atomic_load(g, __ATOMIC_RELAXED, __HIP_MEMORY_SCOPE_AGENT), yh = __hip_atomic_load(g + 1, __ATOMIC_RELAXED, __HIP_MEMORY_SCOPE_AGENT);
                xa[q] = (unsigned)ya; xh[q] = (unsigned)yh; xt_[q] = (unsigned)(ya >> 32) & (unsigned)(yh >> 32); } }
        float av[16], uv[16];
        const int c = lane, sg = 2 * rb + hi, tb = 32 * rb + 16 * hi;
        {
            f32x16 pr, pi;
#pragma unroll
            for (int i = 0; i < 16; ++i) { pr[i] = 0.f; pi[i] = 0.f; }
            const int trow = 32 * rb + 16 * ((ql >> 2) & 1) + 4 * (ql >> 3) + (ql & 3);
#pragma unroll
            for (int s = 0; s < 4; ++s) {
                const bf16x8 af = *(const LAS bf16x8*)(xcB + trow * KP + 16 * s + 8 * hi);
                const bf16x8 wr_ = *(const LAS bf16x8*)(wL + d * KP + 16 * s + 8 * hi), wi_ = *(const LAS bf16x8*)(wL + (64 + d) * KP + 16 * s + 8 * hi);
                pr = __builtin_amdgcn_mfma_f32_32x32x16_bf16(af, wr_, pr, 0, 0, 0);
                pi = __builtin_amdgcn_mfma_f32_32x32x16_bf16(af, wi_, pi, 0, 0, 0);
            }
            const float brv = parL[320 + d], biv = parL[384 + d], ls8 = parL[448 + d];
            float A = 1.f, H = 0.f;
#pragma unroll
            for (int i = 0; i < 16; ++i) {
                const float r = pg8::fast_sigmoid(pr[i] + brv), ig = pg8::fast_sigmoid(pi[i] + biv);
                const float la = ls8 * r;
                const float a = __builtin_amdgcn_exp2f(la * LOG2E);
                const float mult = __builtin_amdgcn_sqrtf(fmaxf(1.0f - a * a, 0.f));
                const float u = mult * ig * xcF[(tb + i) * 64 + d];
                av[i] = a; uv[i] = u; H = a * H + u; A *= a;
            }
            segA[sg * 64 + d] = A; segH[sg * 64 + d] = H;
        }
        LDS_BARRIER();
        if (w == 0 && ch < NCH - 1) {
            float At = 1.f, Ht = 0.f;
#pragma unroll
            for (int s = 0; s < 8; ++s) { const float a = segA[s * 64 + c], hh = segH[s * 64 + c]; Ht = a * Ht + hh; At *= a; }
            unsigned long long* g = gran + ((size_t)(b * NCH + ch) * D + c0 + c) * 2;
            __hip_atomic_store(g, (1ull << 32) | (unsigned long long)__float_as_uint(At), __ATOMIC_RELAXED, __HIP_MEMORY_SCOPE_AGENT);
            __hip_atomic_store(g + 1, (1ull << 32) | (unsigned long long)__float_as_uint(Ht), __ATOMIC_RELAXED, __HIP_MEMORY_SCOPE_AGENT);
        }
#pragma unroll
        for (int q = 0; q < 2; ++q) { const int kk = w + 8 * q;
            if (kk < ch) {
                const unsigned long long* g = gran + ((size_t)(b * NCH + kk) * D + c0 + c) * 2;
                for (unsigned spins = 0; spins < (1u << 22); ++spins) {
                    if (__all(xt_[q] == 1u)) break;
                    __builtin_amdgcn_s_sleep(1);
                    const unsigned long long ya = __hip_atomic_load(g, __ATOMIC_RELAXED, __HIP_MEMORY_SCOPE_AGENT), yh = __hip_atomic_load(g + 1, __ATOMIC_RELAXED, __HIP_MEMORY_SCOPE_AGENT);
                    xa[q] = (unsigned)ya; xh[q] = (unsigned)yh; xt_[q] = (unsigned)(ya >> 32) & (unsigned)(yh >> 32); }
                pA[kk * 64 + c] = __uint_as_float(xa[q]); pH[kk * 64 + c] = __uint_as_float(xh[q]);
            } }
        LDS_BARRIER();
        {
            float h = 0.f;
            for (int kk = 0; kk < ch; ++kk) h = pA[kk * 64 + d] * h + pH[kk * 64 + d];
            for (int s = 0; s < 7; ++s) { if (s < sg) h = segA[s * 64 + d] * h + segH[s * 64 + d]; }
#pragma unroll
            for (int i = 0; i < 16; ++i) { const int t = tb + i; h = av[i] * h + uv[i];
                const float yv_ = __uint_as_float((unsigned)yL[t * KP + d] << 16);
                xcB[t * KP + d] = (bf16)(pk_bf16(h * yv_, 0.f) & 0xffffu); }
        }
        LDS_BARRIER();
#pragma unroll
        for (int r = 0; r < 2; ++r) *(v4u*)(HY + (size_t)(b * SEQ + t0 + st + 64 * r) * D + c0 + cc) = *(const LAS v4u*)(xcB + (st + 64 * r) * KP + cc);
    }
}

#define RLX_AGENT __ATOMIC_RELAXED, __HIP_MEMORY_SCOPE_AGENT
#define XB_TMO      128
#define XB_XCNT(j)  (256  + 64 * (j))
#define XB_XSUB(j)  (1280 + 64 * (j))
#define XB_XGEN(j)  (2304 + 64 * (j))
#define XB_TOP      3328
#define XB_TOPGEN   3392
#define XCD_BAR_WORDS 3456
#define XB_SPIN_CAP (1u << 18)

__device__ __forceinline__ unsigned xb_ld(unsigned* p)              { return __hip_atomic_load(p, __ATOMIC_RELAXED, __HIP_MEMORY_SCOPE_AGENT); }
__device__ __forceinline__ unsigned xb_add(unsigned* p, unsigned v) { return __hip_atomic_fetch_add(p, v, __ATOMIC_RELAXED, __HIP_MEMORY_SCOPE_AGENT); }
__device__ __forceinline__ unsigned xb_xcc_id() { return (unsigned)__builtin_amdgcn_s_getreg((3 << 11) | 20) & 0xFu; }
#define XB_SPIN(cond, bar) do { unsigned _sp = 0; while (cond) { __builtin_amdgcn_s_sleep(1); \
    if ((++_sp & 255u) == 0u) { if (xb_ld(&(bar)[XB_TMO])) break; if (_sp > XB_SPIN_CAP) { atomicAdd(&(bar)[XB_TMO], 1u); break; } } } } while (0)

struct XcdBarrier {
    unsigned* bar; unsigned x;
    volatile LAS unsigned* st;
};

__device__ __forceinline__ XcdBarrier xcd_barrier_post(unsigned* bar, volatile LAS unsigned* st, bool is_t0) {
    XcdBarrier b; b.bar = bar; b.x = xb_xcc_id(); b.st = st;
    if (is_t0) (void)xb_add(&bar[XB_XCNT(b.x)], 1u);
    return b;
}
__device__ __forceinline__ void xcd_barrier_complete(unsigned* bar, unsigned x, unsigned& nloc, unsigned& nx) {
    const unsigned G = gridDim.x * gridDim.y * gridDim.z;
    unsigned sum, cnt, mine, sp = 0u;
    for (;;) {
        sum = 0u; cnt = 0u; mine = 0u;
#pragma unroll
        for (unsigned j = 0; j < 16; ++j) { const unsigned c = xb_ld(&bar[XB_XCNT(j)]); sum += c; cnt += (c > 0u) ? 1u : 0u; mine = (j == x) ? c : mine; }
        if (sum == G) break;
        __builtin_amdgcn_s_sleep(1);
        if ((++sp & 255u) == 0u) { if (xb_ld(&bar[XB_TMO])) break; if (sp > XB_SPIN_CAP) { atomicAdd(&bar[XB_TMO], 1u); break; } }
    }
    nloc = mine > 0u ? mine : 1u; nx = cnt > 0u ? cnt : 1u;
}

__device__ __forceinline__ void xcd_barrier(const XcdBarrier& b, int wave_s) {
    asm volatile("s_waitcnt vmcnt(0)" ::: "memory");
    __syncthreads();
    if (wave_s == 0 && lane_id_() == 0) {
        unsigned* bar = b.bar;
        __builtin_amdgcn_s_waitcnt(0);
        unsigned nloc = b.st[0], nx = b.st[1];
        if (nloc == 0u) { xcd_barrier_complete(bar, b.x, nloc, nx); b.st[0] = nloc; b.st[1] = nx; }
        const unsigned old = xb_add(&bar[XB_XSUB(b.x)], 1u);
        const unsigned gen = old / nloc;
        if (old + 1u == (gen + 1u) * nloc) {
            __builtin_amdgcn_fence(__ATOMIC_RELEASE, "agent");
            asm volatile("s_waitcnt vmcnt(0)" ::: "memory");
            const unsigned og = xb_add(&bar[XB_TOP], 1u);
            const unsigned tg = og / nx;
            if (og + 1u == (tg + 1u) * nx) xb_add(&bar[XB_TOPGEN], 1u);
            else XB_SPIN(xb_ld(&bar[XB_TOPGEN]) == tg, bar);
            __builtin_amdgcn_fence(__ATOMIC_ACQUIRE, "agent");
            xb_add(&bar[XB_XGEN(b.x)], 1u);
            asm volatile("s_waitcnt vmcnt(0)" ::: "memory");
        } else {
            XB_SPIN(xb_ld(&bar[XB_XGEN(b.x)]) == gen, bar);
            __builtin_amdgcn_fence(__ATOMIC_ACQUIRE, "agent");
            asm volatile("s_waitcnt vmcnt(0)" ::: "memory");
        }
    }
    __syncthreads();
}

__device__ __forceinline__ int launder_s_(int k) { asm volatile("" : "+s"(k)); return k; }
struct Args { const float* in[28]; float* out; unsigned char* ws; };
__global__ void __launch_bounds__(512, 2) fwd_megakernel(Args a) {
    const float* const* kin_ = (const float* const*)__builtin_amdgcn_kernarg_segment_ptr();
#define AIN(k) (kin_[launder_s_(k)])
    extern __shared__ __attribute__((aligned(16))) unsigned char lds_raw[];
    cg::grid_group grid = cg::this_grid();
    LAS unsigned char* lds = (LAS unsigned char*)lds_raw;
    const int tid = threadIdx.x, lane = tid & 63, wave = __builtin_amdgcn_readfirstlane(tid >> 6);
    const int G = gridDim.x, bid = blockIdx.x;
    const int gw = bid * 8 + wave, ngw = G * 8;
    unsigned char* ws = a.ws;
    bf16* XN = (bf16*)(ws + WS_XN); bf16* ACT = (bf16*)(ws + WS_ACT);
    bf16* QB = ACT; bf16* KB = ACT + (size_t)M * D; bf16* VB = ACT + (size_t)2 * M * D;
    volatile LAS unsigned* MISC = (volatile LAS unsigned*)(lds + 131072 + 4096);
    if (tid < 2) MISC[tid] = 0u;
    __syncthreads();
    const XcdBarrier xbar = xcd_barrier_post((unsigned*)(ws + WS_CTL), MISC, tid == 0);

    float* SSQ = (float*)(ws + WS_SSQ);
#define SSQ_AT(s) (SSQ + (size_t)(s) * M)
    constexpr int I_IN = (D / 64) * (2 * FF / 32), I_OUT = (FF / 64) * (D / 32), I_QKV = (D / 64) * (3 * D / 32), I_SQ = (D / 64) * (D / 32), I_LIN = (D / 64) * (2 * D / 32), I_G = 16 * 2;
    constexpr int SEG0 = I_IN, SEG1 = SEG0 + I_OUT + I_QKV + I_SQ + I_IN, SEG2 = SEG1 + I_OUT + I_IN + I_OUT, SEG3 = SEG2 + I_LIN + I_SQ + 2 * I_G + I_IN + I_OUT;
#define FFW(f) (ws + W_FF0 + (size_t)(f) * (SZ_WIN + SZ_WOUT))
#define CONVERT_ITEMS(lo_, hi_, wk_, nwk_) do { LAS float* scr = (LAS float*)(lds + wave * 16384); int tl_ = lane_id_(); asm volatile("" : "+v"(tl_)); const int lane = tl_; \
        for (int it = (lo_) + (wk_); it < (hi_); it += (nwk_)) { int r = it; \
            if (r < I_IN) { transpose_item<true>(AIN(2), AIN(1), D, 2 * FF, (bf16*)FFW(0), scr, r, lane); continue; } r -= I_IN; \
            if (r < I_OUT) { transpose_item<false>(AIN(3), nullptr, FF, D, (bf16*)(FFW(0) + SZ_WIN), scr, r, lane); continue; } r -= I_OUT; \
            if (r < I_QKV) { transpose_item<false>(AIN(5), AIN(4), D, 3 * D, (bf16*)(ws + W_QKV), scr, r, lane); continue; } r -= I_QKV; \
            if (r < I_SQ) { transpose_item<false>(AIN(8), nullptr, D, D, (bf16*)(ws + W_O), scr, r, lane); continue; } r -= I_SQ; \
            if (r < I_IN) { transpose_item<true>(AIN(10), AIN(9), D, 2 * FF, (bf16*)FFW(1), scr, r, lane); continue; } r -= I_IN; \
            if (r < I_OUT) { transpose_item<false>(AIN(11), nullptr, FF, D, (bf16*)(FFW(1) + SZ_WIN), scr, r, lane); continue; } r -= I_OUT; \
            if (r < I_IN) { transpose_item<true>(AIN(13), AIN(12), D, 2 * FF, (bf16*)FFW(2), scr, r, lane); continue; } r -= I_IN; \
            if (r < I_OUT) { transpose_item<false>(AIN(14), nullptr, FF, D, (bf16*)(FFW(2) + SZ_WIN), scr, r, lane); continue; } r -= I_OUT; \
            if (r < I_LIN) { transpose_item<false>(AIN(16), AIN(15), D, 2 * D, (bf16*)(ws + W_LIN), scr, r, lane); continue; } r -= I_LIN; \
            if (r < I_SQ) { transpose_item<false>(AIN(24), nullptr, D, D, (bf16*)(ws + W_LO), scr, r, lane); continue; } r -= I_SQ; \
            if (r < I_G) { transpose_item<false>(AIN(19) + (size_t)(r >> 1) * 4096, nullptr, 64, 64, (bf16*)(ws + W_GR) + (size_t)(r >> 1) * 4096, scr, r & 1, lane); continue; } r -= I_G; \
            if (r < I_G) { transpose_item<false>(AIN(21) + (size_t)(r >> 1) * 4096, nullptr, 64, 64, (bf16*)(ws + W_GI) + (size_t)(r >> 1) * 4096, scr, r & 1, lane); continue; } r -= I_G; \
            if (r < I_IN) { transpose_item<true>(AIN(26), AIN(25), D, 2 * FF, (bf16*)FFW(3), scr, r, lane); continue; } r -= I_IN; \
            transpose_item<false>(AIN(27), nullptr, FF, D, (bf16*)(FFW(3) + SZ_WIN), scr, r, lane); } } while (0)
    const int ffn_units = (M / 256) * (2 * FF / 256), ffn_rounds = (ffn_units + G - 1) / G, idle_from = ffn_units - (ffn_rounds - 1) * G;
#define CONVERT_IN_TAIL(lo_, hi_) do { if (idle_from < G) { if (bid >= idle_from) CONVERT_ITEMS(lo_, hi_, (bid - idle_from) * 8 + wave, (G - idle_from) * 8); } \
        else CONVERT_ITEMS(lo_, hi_, gw, ngw); } while (0)
    {
        CONVERT_ITEMS(0, SEG0, gw, ngw);
        cvt_phase(AIN(0), XN, SSQ_AT(0), gw, ngw, lane);
        for (int i = bid * 512 + tid; i < 2 * BATCH * NCH * D; i += G * 512) ((unsigned long long*)(ws + WS_SUM))[i] = 0ull;
    }
#define SEAM() xcd_barrier(xbar, wave)
    if (a.ws == nullptr) grid.sync();
    SEAM();
#define GEMM(EPI, Aptr, Wptr, NN, KK, E) do { pg8::Gemm g{(Aptr), (const bf16*)(Wptr), M, (NN), (KK)}; pg8::StaticOrder S; S.init(M, (NN), G, bid); \
        pg8::gemm_phase<EPI, pg8::StaticOrder, true, true>(lds, g, S, (E), wave); } while (0)
#define FFN(widx, s_in, FIRST, LAST, TLO, THI) do { \
        { pg8::EpiSwiglu E{ACT, FF, SSQ_AT(s_in)}; GEMM(pg8::EpiSwiglu, XN, ws + W_FF0 + (size_t)(widx) * (SZ_WIN + SZ_WOUT), 2 * FF, D, E); } \
        if ((TLO) < (THI)) CONVERT_IN_TAIL(TLO, THI); \
        SEAM(); \
        { typedef pg8::EpiResid<FIRST, LAST, true> EpiR; EpiR E{AIN(0), ((float*)AIN(28)), XN, SSQ_AT((s_in) + 1)}; GEMM(EpiR, ACT, ws + W_FF0 + (size_t)(widx) * (SZ_WIN + SZ_WOUT) + SZ_WIN, D, FF, E); } \
        } while (0)

    FFN(0, 0, false, false, SEG0, SEG1);
    SEAM();
    { pg8::EpiSplit<99> E{ACT, (size_t)M * D, SSQ_AT(1)}; GEMM(pg8::EpiSplit<99>, XN, ws + W_QKV, 3 * D, D, E); }
    SEAM();
    { const int vcu = (G % 8 == 0) ? (bid % 8) * (G / 8) + bid / 8 : bid;
      attn_phase2(lds, QB, KB, VB, QB, AIN(6), AIN(7), vcu * 8 + wave, ngw, wave); }
    SEAM();
    { typedef pg8::EpiResid<false, false, false> EpiR; EpiR E{AIN(0), ((float*)AIN(28)), XN, SSQ_AT(2)}; GEMM(EpiR, QB, ws + W_O, D, D, E); }
    SEAM();
    FFN(1, 2, false, false, SEG1, SEG2);
    SEAM();
    FFN(2, 3, false, false, SEG2, SEG3);
    SEAM();
    { pg8::EpiSplit<1> E{ACT, (size_t)M * D, SSQ_AT(4)}; GEMM(pg8::EpiSplit<1>, XN, ws + W_LIN, 2 * D, D, E); }
    SEAM();
    lru_phase(lds, QB, KB, VB, (const bf16*)(ws + W_GR), (const bf16*)(ws + W_GI), AIN(17), AIN(18), AIN(20), AIN(22), AIN(23), (unsigned long long*)(ws + WS_SUM), G, (G % 8 == 0) ? (bid % 8) * (G / 8) + bid / 8 : bid, wave);
    SEAM();
    { typedef pg8::EpiResid<false, false, false> EpiR; EpiR E{AIN(0), ((float*)AIN(28)), XN, SSQ_AT(5)}; GEMM(EpiR, VB, ws + W_LO, D, D, E); }
    SEAM();
    FFN(3, 5, false, true, 0, 0);
}

extern "C" void kernel_launch(void* const* d_in, const int* in_sizes, int n_in, void* d_out, int out_size, void* d_ws, size_t ws_size, hipStream_t stream) {
    static int grid = 0;
    if (grid == 0) {
        if (n_in != 28 || out_size != M * D || ws_size < WS_END) { fprintf(stderr, "kernel_launch: unexpected problem (n_in %d out %d ws %zu)\n", n_in, out_size, ws_size); grid = -1; return; }
        int dev = 0, cus = 0, per_cu = 0;
        hipGetDevice(&dev); hipDeviceGetAttribute(&cus, hipDeviceAttributeMultiprocessorCount, dev);
        if (hipFuncSetAttribute((const void*)fwd_megakernel, hipFuncAttributeMaxDynamicSharedMemorySize, LDS_BYTES) != hipSuccess) { fprintf(stderr, "kernel_launch: hipFuncSetAttribute failed\n"); grid = -1; return; }
        if (hipOccupancyMaxActiveBlocksPerMultiprocessor(&per_cu, (const void*)fwd_megakernel, 512, LDS_BYTES) != hipSuccess || per_cu < 1) { fprintf(stderr, "kernel_launch: occupancy query says %d\n", per_cu); per_cu = 1; }
        (void)hipGetLastError();
        grid = cus * per_cu;
    }
    if (grid < 0) return;
    if (hipMemsetAsync((char*)d_ws + WS_CTL, 0, CTL_ZERO_BYTES, stream) != hipSuccess) { fprintf(stderr, "memset failed\n"); return; }
    Args a{};
    for (int i = 0; i < 28; ++i) a.in[i] = (const float*)d_in[i];
    a.out = (float*)d_out; a.ws = (unsigned char*)d_ws;
    void* args[] = {&a};
    hipError_t e = hipLaunchCooperativeKernel((const void*)fwd_megakernel, dim3(grid), dim3(512), args, LDS_BYTES, stream);
    if (e != hipSuccess) fprintf(stderr, "cooperative launch failed: %s (grid %d)\n", hipGetErrorString(e), grid);
}
```

```cpp
#include <hip/hip_runtime.h>
#include <hip/hip_cooperative_groups.h>
#include <cstdio>
#include <cstdint>
namespace cg = cooperative_groups;
__device__ __forceinline__ int lane_id_() { int l; asm volatile("v_mbcnt_lo_u32_b32 %0, -1, 0\n\tv_mbcnt_hi_u32_b32 %0, -1, %0" : "=v"(l)); return l; }
namespace pg8 {
#define PG8_LAS __attribute__((address_space(3)))
typedef unsigned short bf16_t;
typedef short bf16x8 __attribute__((ext_vector_type(8)));
typedef float f32x4 __attribute__((ext_vector_type(4)));
typedef unsigned u32x4 __attribute__((ext_vector_type(4)));
constexpr int BM = 256, BK = 64, HALF = 128, HTB = HALF * BK * 2  , STAGE_BYTES = 8 * HTB, NXCD = 8, WGM = 8;

__host__ __device__ __forceinline__ int lds_byte(int r, int c) { const int st = (r >> 4) * 2 + (c >> 5), rr = r & 15, cc = c & 31, ob = rr * 64 + cc * 2; return st * 1024 + (ob ^ (((ob >> 9) & 1) << 5)); }
__host__ __device__ __forceinline__ void stage_rc(int b, int& R, int& C) { const int st = b / 1024, sb = b % 1024, swz = sb ^ (((sb >> 9) & 1) << 5); R = (st >> 1) * 16 + swz / 64; C = (st & 1) * 32 + (swz % 64) / 2; }
__host__ __device__ __forceinline__ int perm32(int rho) { const int n = rho >> 4, i = rho & 15; return 8 * (i >> 2) + 4 * n + (i & 3); }

constexpr int PRE_SLOT = 136192;
struct Unit { int pm, pn; };
struct Gemm { const bf16_t* A; const bf16_t* Bt; int M, N, K; };

struct StaticOrder {
    int nM, nN, nwg, G, c;
    __host__ __device__ void init(int M, int N, int G_, int c_) { nM = M / BM; nN = N / BM; nwg = nM * nN; G = G_; c = c_; }
    __host__ __device__ bool next(int i, Unit& u) const {
        const long L = (long)i * G + c; if (L >= nwg) return false;
        int wgid = (int)L; { const int q = nwg / NXCD, r = nwg % NXCD, xcd = wgid % NXCD, off = wgid / NXCD; wgid = (xcd < r ? xcd * (q + 1) : r * (q + 1) + (xcd - r) * q) + off; }
        const int nig = WGM * nN, gid = wgid / nig, fm = gid * WGM, gsz = (nM - fm) < WGM ? (nM - fm) : WGM;
        u.pm = fm + ((wgid % nig) % gsz); u.pn = (wgid % nig) / gsz; return true;
    }
    __device__ __forceinline__ void a_ready(const Unit&) const {}
    __device__ __forceinline__ void done(const Unit&) const {}
};

__device__ __forceinline__ unsigned cvt_pk_bf16(float lo, float hi) { unsigned r; asm volatile("v_cvt_pk_bf16_f32 %0, %1, %2" : "=v"(r) : "v"(lo), "v"(hi)); return r; }
typedef float f32x2 __attribute__((ext_vector_type(2)));
__device__ __forceinline__ unsigned pk_bf16(float lo, float hi) { typedef __bf16 b2_t __attribute__((ext_vector_type(2))); f32x2 v = {lo, hi}; b2_t b = __builtin_convertvector(v, b2_t); return __builtin_bit_cast(unsigned, b); }
__device__ __forceinline__ float fast_sigmoid(float v) { return __builtin_amdgcn_rcpf(1.0f + __builtin_amdgcn_exp2f(-1.44269504089f * v)); }
struct EpiSwiglu {
    static constexpr bool PERM = true, AFTER_DRAIN = false; static constexpr int NSTORES = 8;
    static constexpr int NPRE = 2;
    __device__ __forceinline__ void prefetch(PG8_LAS unsigned char* lds, int wid, const Unit& u, int wr, int fr, int fq) const {
        { const int l_ = lane_id_(); fr = l_ & 15; fq = l_ >> 4; }
#pragma unroll
        for (int j = 0; j < 2; ++j) { const int i = 2 * fq + j;
            __builtin_amdgcn_global_load_lds((const unsigned*)(ssq + u.pm * BM + wr * 64 + fr + (i >> 2) * HALF + (i & 3) * 16), (PG8_LAS unsigned*)(lds + PRE_SLOT + wid * 512 + j * 256), 4, 0, 0); }
    }
    bf16_t* H; int ldh; const float* ssq;
    __device__ __forceinline__ void operator()(const f32x4 (&acc)[2][2][4][2], const Unit& u, int wr, int wc, int fr, int fq, PG8_LAS unsigned char* lds, int wid) const {
        const int row0 = u.pm * BM + wr * 64 + fr, col0 = u.pn * HALF + wc * 32 + 8 * fq;
#pragma unroll
        for (int ai = 0; ai < 2; ++ai)
#pragma unroll
            for (int m = 0; m < 4; ++m) {
                bf16_t* p = H + (size_t)(row0 + ai * HALF + m * 16) * ldh + col0;
                const float rstd = __builtin_amdgcn_rsqf(*(const PG8_LAS float*)(lds + PRE_SLOT + wid * 512 + (m & 1) * 256 + (fr + 16 * ((ai * 4 + m) >> 1)) * 4) * (1.0f / 1024.0f) + 1e-6f);
                const float c1 = -1.44269504089f * rstd, r2 = rstd * rstd;
                f32x2 hh[4];
#pragma unroll
                for (int q = 0; q < 4; ++q) {
                    const f32x2 ag = {acc[ai][0][m][q >> 1][2 * (q & 1)], acc[ai][0][m][q >> 1][2 * (q & 1) + 1]};
                    const f32x2 au = {acc[ai][1][m][q >> 1][2 * (q & 1)], acc[ai][1][m][q >> 1][2 * (q & 1) + 1]};
                    const f32x2 t = ag * c1;
                    f32x2 e; e.x = __builtin_amdgcn_exp2f(t.x); e.y = __builtin_amdgcn_exp2f(t.y);
                    const f32x2 d = e + 1.0f;
                    f32x2 r; r.x = __builtin_amdgcn_rcpf(d.x); r.y = __builtin_amdgcn_rcpf(d.y);
                    hh[q] = (ag * au) * (r * r2);
                }
                u32x4 w; w.x = pk_bf16(hh[0].x, hh[0].y); w.y = pk_bf16(hh[1].x, hh[1].y); w.z = pk_bf16(hh[2].x, hh[2].y); w.w = pk_bf16(hh[3].x, hh[3].y);
                *(u32x4*)p = w;
            }
    }
};
template <bool FIRST, bool LAST, bool HALF_ALPHA> struct EpiResid {
    static constexpr bool PERM = true, AFTER_DRAIN = false; static constexpr int NSTORES = 0;
    static constexpr int NPRE = 0;
    __device__ __forceinline__ void prefetch(PG8_LAS unsigned char*, int, const Unit&, int, int, int) const {}
    const float* base32; float* out32; bf16_t* xn; float* ssq;
    __device__ __forceinline__ void operator()(const f32x4 (&acc)[2][2][4][2], const Unit& u, int wr, int wc, int fr, int fq, PG8_LAS unsigned char*, int) const {
        const int row0 = u.pm * BM + wr * 64 + fr, col0 = u.pn * BM + wc * 32 + 8 * fq;
        constexpr float alpha = HALF_ALPHA ? 0.5f : 1.0f;
#pragma unroll
        for (int ai = 0; ai < 2; ++ai)
#pragma unroll
            for (int m = 0; m < 4; ++m) {
                float s = 0.f;
#pragma unroll
                for (int bj = 0; bj < 2; ++bj) {
                    const size_t off = (size_t)(row0 + ai * HALF + m * 16) * 1024 + col0 + bj * HALF;
                    f32x4 b0, b1;
                    if (FIRST) { b0 = *(const f32x4*)(base32 + off); b1 = *(const f32x4*)(base32 + off + 4); }
                    else { const u32x4 r = *(const u32x4*)(xn + off);
                        b0 = (f32x4){__uint_as_float(r.x << 16), __uint_as_float(r.x & 0xffff0000u), __uint_as_float(r.y << 16), __uint_as_float(r.y & 0xffff0000u)};
                        b1 = (f32x4){__uint_as_float(r.z << 16), __uint_as_float(r.z & 0xffff0000u), __uint_as_float(r.w << 16), __uint_as_float(r.w & 0xffff0000u)}; }
                    const f32x4 v0 = b0 + alpha * acc[ai][bj][m][0], v1 = b1 + alpha * acc[ai][bj][m][1];
                    if (LAST) { *(f32x4*)(out32 + off) = v0; *(f32x4*)(out32 + off + 4) = v1; }
                    else {
                        u32x4 w; w.x = pk_bf16(v0[0], v0[1]); w.y = pk_bf16(v0[2], v0[3]); w.z = pk_bf16(v1[0], v1[1]); w.w = pk_bf16(v1[2], v1[3]);
                        *(u32x4*)(xn + off) = w;
                        const float r0 = __uint_as_float(w.x << 16), r1 = __uint_as_float(w.x & 0xffff0000u), r2 = __uint_as_float(w.y << 16), r3 = __uint_as_float(w.y & 0xffff0000u);
                        const float r4 = __uint_as_float(w.z << 16), r5 = __uint_as_float(w.z & 0xffff0000u), r6 = __uint_as_float(w.w << 16), r7 = __uint_as_float(w.w & 0xffff0000u);
                        s += (r0 * r0 + r1 * r1) + (r2 * r2 + r3 * r3) + (r4 * r4 + r5 * r5) + (r6 * r6 + r7 * r7);
                    }
                }
                if (!LAST) { s += __shfl_xor(s, 16); s += __shfl_xor(s, 32); if (fq == 0) __hip_atomic_fetch_add(ssq + row0 + ai * HALF + m * 16, s, __ATOMIC_RELAXED, __HIP_MEMORY_SCOPE_AGENT); }
            }
    }
};
template <int GELU_FROM> struct EpiSplit {
    static constexpr bool PERM = true, AFTER_DRAIN = false; static constexpr int NSTORES = 16;
    static constexpr int NPRE = 2;
    __device__ __forceinline__ void prefetch(PG8_LAS unsigned char* lds, int wid, const Unit& u, int wr, int fr, int fq) const {
        { const int l_ = lane_id_(); fr = l_ & 15; fq = l_ >> 4; }
#pragma unroll
        for (int j = 0; j < 2; ++j) { const int i = 2 * fq + j;
            __builtin_amdgcn_global_load_lds((const unsigned*)(ssq + u.pm * BM + wr * 64 + fr + (i >> 2) * HALF + (i & 3) * 16), (PG8_LAS unsigned*)(lds + PRE_SLOT + wid * 512 + j * 256), 4, 0, 0); }
    }
    bf16_t* O; size_t split_stride; const float* ssq;
    __device__ __forceinline__ void operator()(const f32x4 (&acc)[2][2][4][2], const Unit& u, int wr, int wc, int fr, int fq, PG8_LAS unsigned char* lds, int wid) const {
        const int t = u.pn >> 2; bf16_t* basep = O + (size_t)t * split_stride;
        const int row0 = u.pm * BM + wr * 64 + fr, col0 = (u.pn & 3) * BM + wc * 32 + 8 * fq;
        const bool act = t >= GELU_FROM;
#pragma unroll
        for (int ai = 0; ai < 2; ++ai)
#pragma unroll
            for (int m = 0; m < 4; ++m) {
                const float rstd = __builtin_amdgcn_rsqf(*(const PG8_LAS float*)(lds + PRE_SLOT + wid * 512 + (m & 1) * 256 + (fr + 16 * ((ai * 4 + m) >> 1)) * 4) * (1.0f / 1024.0f) + 1e-6f);
#pragma unroll
                for (int bj = 0; bj < 2; ++bj) {
                    float h[8];
#pragma unroll
                    for (int q = 0; q < 4; ++q) {
                        f32x2 v = (f32x2){acc[ai][bj][m][q >> 1][2 * (q & 1)], acc[ai][bj][m][q >> 1][2 * (q & 1) + 1]} * rstd;
                        if (act) { const f32x2 t = ((v * v) * (0.044715f * -1.5957691216f * 1.44269504089f) + (-1.5957691216f * 1.44269504089f)) * v;
                            f32x2 e; e.x = __builtin_amdgcn_exp2f(t.x); e.y = __builtin_amdgcn_exp2f(t.y);
                            const f32x2 d = e + 1.0f;
                            f32x2 r; r.x = __builtin_amdgcn_rcpf(d.x); r.y = __builtin_amdgcn_rcpf(d.y);
                            v = v * r; }
                        h[2 * q] = v.x; h[2 * q + 1] = v.y; }
                    u32x4 w; w.x = pk_bf16(h[0], h[1]); w.y = pk_bf16(h[2], h[3]); w.z = pk_bf16(h[4], h[5]); w.w = pk_bf16(h[6], h[7]);
                    *(u32x4*)(basep + (size_t)(row0 + ai * HALF + m * 16) * 1024 + col0 + bj * HALF) = w;
                }
            }
    }
};
template <class Epi, class Sched, bool ALIGN_EPI = false, bool SP2 = false>
__device__ __forceinline__ void gemm_phase(PG8_LAS unsigned char* lds, const Gemm g, const Sched& S, const Epi& E, int wave_s) {
    int tid = wave_s * 64 + lane_id_(); asm volatile("" : "+v"(tid));
    const int wid = __builtin_amdgcn_readfirstlane(tid >> 6), lane = tid & 63, wr = wid >> 2, wc = wid & 3, fr = lane & 15, fq = lane >> 4;
    const int K = g.K, nt = K / BK;
    unsigned voffA[2], voffB[2];
#pragma unroll
    for (int i = 0; i < 2; ++i) { int R, C; stage_rc(tid * 16 + i * 8192, R, C); const int Rb = Epi::PERM ? ((R & ~31) + perm32(R & 31)) : R;
        voffA[i] = (unsigned)(R * K + C) * 2u; voffB[i] = (unsigned)(Rb * K + C) * 2u; }
    const size_t kstep = (size_t)(BK * 2);
    const size_t hstep = (size_t)HALF * K * 2;
    const size_t tstep = 2 * hstep;
    const unsigned ldsw = (unsigned)wid * 1024u;
    const int aoff = lds_byte(wr * 64 + fr, fq * 8), boff = lds_byte(wc * 32 + fr, fq * 8);
#define PG8_SA(b, h) (((b) * 2 + (h)) * HTB)
#define PG8_SB(b, h) ((4 + (b) * 2 + (h)) * HTB)
#define PG8_STAGE(bufoff, gbase, voff) do { const char* gb_ = (const char*)(gbase); asm volatile("" : "+s"(gb_));   \
        _Pragma("unroll") for (int _i = 0; _i < 2; ++_i) \
        __builtin_amdgcn_global_load_lds((const unsigned*)(gb_ + (voff)[_i]), (PG8_LAS unsigned*)(lds + (bufoff) + ldsw + _i * 8192), 16, 0, 0); } while (0)
#define PG8_LDA(dst, b, h) do { _Pragma("unroll") for (int m = 0; m < 4; ++m) _Pragma("unroll") for (int k = 0; k < 2; ++k) dst[m][k] = *(const PG8_LAS bf16x8*)(lds + PG8_SA(b, h) + aoff + m * 2048 + k * 1024); } while (0)
#define PG8_LDB(dst, b, h) do { _Pragma("unroll") for (int n = 0; n < 2; ++n) _Pragma("unroll") for (int k = 0; k < 2; ++k) dst[n][k] = *(const PG8_LAS bf16x8*)(lds + PG8_SB(b, h) + boff + n * 2048 + k * 1024); } while (0)
#define PG8_MMA(ai, bj, At, Bt) do { __builtin_amdgcn_s_setprio(1); _Pragma("unroll") for (int m = 0; m < 4; ++m) _Pragma("unroll") for (int n = 0; n < 2; ++n) _Pragma("unroll") for (int k = 0; k < 2; ++k) \
        acc[ai][bj][m][n] = __builtin_amdgcn_mfma_f32_16x16x32_bf16(Bt[n][k], At[m][k], acc[ai][bj][m][n], 0, 0, 0); __builtin_amdgcn_s_setprio(0); } while (0)
#define PG8_WAIT_V(n) asm volatile("s_waitcnt vmcnt(" #n ")" ::: "memory")
#define PG8_WAIT_L(n) asm volatile("s_waitcnt lgkmcnt(" #n ")" ::: "memory")
#define PG8_WAIT_V8_STRICT() asm volatile("s_waitcnt vmcnt(8)" ::: "memory")
#define PG8_WAIT_V8_RELAX() do { if constexpr (Epi::NSTORES + Epi::NPRE == 10) asm volatile("s_waitcnt vmcnt(18)" ::: "memory"); else if constexpr (Epi::NSTORES + Epi::NPRE == 18) asm volatile("s_waitcnt vmcnt(26)" ::: "memory"); else asm volatile("s_waitcnt vmcnt(8)" ::: "memory"); } while (0)
#define PG8_BAR __builtin_amdgcn_s_barrier()
#define PG8_SCHED __builtin_amdgcn_sched_barrier(0)
#define PG8_SP2_PAIR(WAITM) do { \
            PG8_LDB(B0, 0, 0); PG8_LDB(B1, 0, 1); PG8_SCHED; PG8_LDA(At, 0, 0); PG8_STAGE(PG8_SA(1, 1), a1 + hstep, voffA); \
            WAITM(); PG8_WAIT_L(0); PG8_BAR; PG8_MMA(0, 0, At, B0); PG8_MMA(0, 1, At, B1); PG8_BAR; PG8_SCHED; \
            PG8_LDA(At, 0, 1); PG8_STAGE(PG8_SB(0, 0), b2, voffB); PG8_STAGE(PG8_SB(0, 1), b2 + hstep, voffB); PG8_STAGE(PG8_SA(0, 0), a2, voffA); \
            WAITM(); PG8_WAIT_L(0); PG8_BAR; PG8_MMA(1, 0, At, B0); PG8_MMA(1, 1, At, B1); PG8_BAR; PG8_SCHED; \
            PG8_LDB(B0, 1, 0); PG8_LDB(B1, 1, 1); PG8_SCHED; PG8_LDA(At, 1, 0); PG8_STAGE(PG8_SA(0, 1), a2 + hstep, voffA); \
            WAITM(); PG8_WAIT_L(0); PG8_BAR; PG8_MMA(0, 0, At, B0); PG8_MMA(0, 1, At, B1); PG8_BAR; PG8_SCHED; \
            PG8_LDA(At, 1, 1); PG8_STAGE(PG8_SB(1, 0), b3, voffB); PG8_STAGE(PG8_SB(1, 1), b3 + hstep, voffB); PG8_STAGE(PG8_SA(1, 0), a3, voffA); \
            WAITM(); PG8_WAIT_L(0); PG8_BAR; PG8_MMA(1, 0, At, B0); PG8_MMA(1, 1, At, B1); PG8_BAR; PG8_SCHED; \
            } while (0)
    Unit cur, nxt; int ui = 0; bool peeled = false;
    if (!S.next(0, cur)) return;
    if constexpr (Epi::NPRE > 0) E.prefetch(lds, wid, cur, wr, fr, fq);
    f32x4 acc[2][2][4][2];
#pragma unroll
    for (int a = 0; a < 2; ++a)
#pragma unroll
        for (int b = 0; b < 2; ++b)
#pragma unroll
            for (int m = 0; m < 4; ++m)
#pragma unroll
                for (int n = 0; n < 2; ++n) acc[a][b][m][n] = (f32x4){0.f, 0.f, 0.f, 0.f};
    bf16x8 At[4][2], B0[2][2], B1[2][2];
    const char* cA = (const char*)g.A + (size_t)cur.pm * tstep; const char* cB = (const char*)g.Bt + (size_t)cur.pn * tstep;
    S.a_ready(cur);
    if constexpr (SP2) {
        PG8_STAGE(PG8_SB(0, 0), cB, voffB); PG8_STAGE(PG8_SB(0, 1), cB + hstep, voffB); PG8_STAGE(PG8_SA(0, 0), cA, voffA); PG8_STAGE(PG8_SA(0, 1), cA + hstep, voffA);
        if (wr == 1) PG8_BAR;
        PG8_WAIT_V(2); PG8_BAR;
        PG8_STAGE(PG8_SB(1, 0), cB + kstep, voffB); PG8_STAGE(PG8_SA(1, 0), cA + kstep, voffA); PG8_STAGE(PG8_SB(1, 1), cB + hstep + kstep, voffB);
        PG8_WAIT_V(6); PG8_BAR;
    } else {
        PG8_STAGE(PG8_SB(0, 0), cB, voffB); PG8_STAGE(PG8_SA(0, 0), cA, voffA); PG8_STAGE(PG8_SB(0, 1), cB + hstep, voffB); PG8_STAGE(PG8_SA(0, 1), cA + hstep, voffA);
        if (wr == 1) PG8_BAR;
        PG8_WAIT_V(4); PG8_BAR;
        PG8_STAGE(PG8_SB(1, 0), cB + kstep, voffB); PG8_STAGE(PG8_SA(1, 0), cA + kstep, voffA); PG8_STAGE(PG8_SB(1, 1), cB + hstep + kstep, voffB);
        PG8_WAIT_V(6); PG8_BAR;
    }
    for (;;) {
        const bool has_next = S.next(ui + 1, nxt);
        const char* nA = has_next ? (const char*)g.A + (size_t)nxt.pm * tstep : cA; const char* nB = has_next ? (const char*)g.Bt + (size_t)nxt.pn * tstep : cB;
        for (int t = peeled ? 2 : 0; t < nt; t += 2) {
            const bool last = (t == nt - 2);
            const char* a1 = cA + (size_t)(t + 1) * kstep;
            const char* a2 = last ? nA : cA + (size_t)(t + 2) * kstep; const char* b2 = last ? nB : cB + (size_t)(t + 2) * kstep;
            const char* a3 = a2 + kstep; const char* b3 = b2 + kstep;
            if (last && has_next) S.a_ready(nxt);
            if constexpr (SP2) {
            PG8_SP2_PAIR(PG8_WAIT_V8_STRICT);
            } else {
            PG8_LDB(B0, 0, 0); PG8_SCHED; PG8_LDA(At, 0, 0); PG8_STAGE(PG8_SA(1, 1), a1 + hstep, voffA);
            PG8_WAIT_L(8); PG8_BAR; PG8_WAIT_L(0); PG8_MMA(0, 0, At, B0); PG8_BAR; PG8_SCHED;
            PG8_LDB(B1, 0, 1); PG8_STAGE(PG8_SB(0, 0), b2, voffB);
            PG8_BAR; PG8_WAIT_L(0); PG8_MMA(0, 1, At, B1); PG8_BAR;
            PG8_LDA(At, 0, 1); PG8_STAGE(PG8_SA(0, 0), a2, voffA);
            PG8_BAR; PG8_WAIT_L(0); PG8_MMA(1, 0, At, B0); PG8_BAR; PG8_SCHED;
            PG8_STAGE(PG8_SB(0, 1), b2 + hstep, voffB);
            PG8_WAIT_V(6); PG8_BAR; PG8_MMA(1, 1, At, B1); PG8_BAR;
            PG8_LDB(B0, 1, 0); PG8_SCHED; PG8_LDA(At, 1, 0); PG8_STAGE(PG8_SA(0, 1), a2 + hstep, voffA);
            PG8_WAIT_L(8); PG8_BAR; PG8_WAIT_L(0); PG8_MMA(0, 0, At, B0); PG8_BAR; PG8_SCHED;
            PG8_LDB(B1, 1, 1); PG8_STAGE(PG8_SB(1, 0), b3, voffB);
            PG8_BAR; PG8_WAIT_L(0); PG8_MMA(0, 1, At, B1); PG8_BAR;
            PG8_LDA(At, 1, 1); PG8_STAGE(PG8_SA(1, 0), a3, voffA);
            PG8_BAR; PG8_WAIT_L(0); PG8_MMA(1, 0, At, B0); PG8_BAR; PG8_SCHED;
            PG8_STAGE(PG8_SB(1, 1), b3 + hstep, voffB);
            PG8_WAIT_V(6); PG8_BAR; PG8_MMA(1, 1, At, B1); PG8_BAR;
            }
        }
        if constexpr (ALIGN_EPI) { if (wr == 0) PG8_BAR; }
        if constexpr (!Epi::AFTER_DRAIN) { E(acc, cur, wr, wc, fr, fq, lds, wid); S.done(cur); }
        if (!has_next) break;
#pragma unroll
        for (int a = 0; a < 2; ++a)
#pragma unroll
            for (int b = 0; b < 2; ++b)
#pragma unroll
                for (int m = 0; m < 4; ++m)
#pragma unroll
                    for (int n = 0; n < 2; ++n) acc[a][b][m][n] = (f32x4){0.f, 0.f, 0.f, 0.f};
        cur = nxt; cA = nA; cB = nB; ++ui;
        if constexpr (ALIGN_EPI) { if (wr == 1) PG8_BAR; }
        if constexpr (Epi::NPRE > 0) E.prefetch(lds, wid, cur, wr, fr, fq);
        if constexpr (SP2 && Epi::NSTORES > 0 && !Epi::AFTER_DRAIN) {
            const char* a1 = cA + kstep; const char* a2 = cA + 2 * kstep; const char* b2 = cB + 2 * kstep; const char* a3 = a2 + kstep; const char* b3 = b2 + kstep;
            PG8_SP2_PAIR(PG8_WAIT_V8_RELAX);
            peeled = true;
        }
    }
    PG8_WAIT_V(0);
    if constexpr (!ALIGN_EPI) { if (wr == 0) PG8_BAR; }
    PG8_BAR;
    if constexpr (Epi::AFTER_DRAIN) { E.fused(acc, cur, wr, wc, fr, fq, lds, wid, lane); S.done(cur); }
#undef PG8_SA
#undef PG8_SB
#undef PG8_STAGE
#undef PG8_LDA
#undef PG8_LDB
#undef PG8_MMA
#undef PG8_WAIT_V
#undef PG8_WAIT_L
#undef PG8_SP2_PAIR
#undef PG8_BAR
#undef PG8_SCHED
}
}
constexpr int BATCH = 8, SEQ = 2048, D = 1024, M = BATCH * SEQ, FF = 2816, NH = 16, HD = 64;
constexpr float EPS = 1e-6f;
constexpr size_t MiB = 1u << 20;
constexpr size_t WS_CTL = 0, WS_SSQ = 65536, CTL_ZERO_BYTES = 65536 + 6 * 65536;
constexpr size_t WS_SUM = 1 * MiB;
constexpr size_t WS_W = 3 * MiB;
constexpr size_t SZ_WIN = (size_t)2 * FF * D * 2, SZ_WOUT = (size_t)D * FF * 2;
constexpr size_t W_FF0 = WS_W, W_FF1 = W_FF0 + SZ_WIN + SZ_WOUT, W_FF2 = W_FF1 + SZ_WIN + SZ_WOUT, W_FF3 = W_FF2 + SZ_WIN + SZ_WOUT;
constexpr size_t W_QKV = W_FF3 + SZ_WIN + SZ_WOUT, W_O = W_QKV + (size_t)3 * D * D * 2, W_LIN = W_O + (size_t)D * D * 2, W_LO = W_LIN + (size_t)2 * D * D * 2;
constexpr size_t W_GR = W_LO + (size_t)D * D * 2, W_GI = W_GR + 16 * 64 * 64 * 2, W_END = W_GI + 16 * 64 * 64 * 2;
constexpr size_t WS_XN = 84 * MiB;
constexpr size_t WS_ACT = 116 * MiB;
constexpr size_t WS_END = WS_ACT + 96 * MiB;
static_assert(W_END <= WS_XN && WS_XN + (size_t)M * D * 2 <= WS_ACT && WS_END <= 256 * MiB && (size_t)M * FF * 2 <= 96 * MiB, "d_ws map");
constexpr int LDS_BYTES = 147456;

#define LAS __attribute__((address_space(3)))
typedef unsigned short bf16;
typedef unsigned v4u __attribute__((ext_vector_type(4)));
typedef unsigned v2u __attribute__((ext_vector_type(2)));
typedef float f32x4 __attribute__((ext_vector_type(4)));
typedef float f32x16 __attribute__((ext_vector_type(16)));
typedef short bf16x8 __attribute__((ext_vector_type(8)));
using pg8::pk_bf16;
__device__ __forceinline__ float bf_lo(unsigned u) { return __uint_as_float(u << 16); }
__device__ __forceinline__ float bf_hi(unsigned u) { return __uint_as_float(u & 0xffff0000u); }
__device__ __forceinline__ float wave_sum(float v) {
#pragma unroll
    for (int o = 1; o < 64; o <<= 1) v += __shfl_xor(v, o);
    return v;
}
#define LOG2E 1.44269504089f
#define LN2 0.69314718056f

__device__ __forceinline__ void transpose_tile(const float* W, const float* gain, int K, int N, int k0, int n0, bf16* WT, int drow0, LAS float* scr, int lane) {
    f32x4 v[8]; float gv[8];
    const int r0 = lane >> 3, c4 = lane & 7;
#pragma unroll
    for (int i = 0; i < 8; ++i) { v[i] = *(const f32x4*)(W + (size_t)(k0 + r0 + 8 * i) * N + n0 + 4 * c4); gv[i] = gain ? gain[k0 + r0 + 8 * i] : 1.0f; }
#pragma unroll
    for (int i = 0; i < 8; ++i) { LAS float* d = scr + (r0 + 8 * i) * 33 + 4 * c4; d[0] = v[i][0] * gv[i]; d[1] = v[i][1] * gv[i]; d[2] = v[i][2] * gv[i]; d[3] = v[i][3] * gv[i]; }
    asm volatile("s_waitcnt lgkmcnt(0)" ::: "memory");
    const int c = lane & 7;
#pragma unroll
    for (int j = 0; j < 4; ++j) { const int n = (lane >> 3) + 8 * j; const LAS float* s = scr + (8 * c) * 33 + n;
        v4u o; o.x = pk_bf16(s[0 * 33], s[1 * 33]); o.y = pk_bf16(s[2 * 33], s[3 * 33]); o.z = pk_bf16(s[4 * 33], s[5 * 33]); o.w = pk_bf16(s[6 * 33], s[7 * 33]);
        *(v4u*)(WT + (size_t)(drow0 + n) * K + k0 + 8 * c) = o; }
    asm volatile("s_waitcnt lgkmcnt(0)" ::: "memory");
}
template <bool SWIGLU> __device__ __forceinline__ void transpose_item(const float* W, const float* gain, int K, int N, bf16* WT, LAS float* scr, int item, int lane) {
    const int nblk = N / 32, kb = item / nblk, nb = item % nblk, n0 = 32 * nb;
    int drow0 = n0;
    if (SWIGLU) { const int up = n0 >= FF, f = up ? n0 - FF : n0; drow0 = 256 * (f >> 7) + (up ? 128 : 0) + (f & 127); }
    transpose_tile(W, gain, K, N, 64 * kb, n0, WT, drow0, scr, lane);
}

__device__ __forceinline__ void cvt_phase(const float* x, bf16* xn, float* ssq, int gw, int ngw, int lane) {
    for (int m = gw; m < M; m += ngw) {
        const f32x4* xr = (const f32x4*)(x + (size_t)m * D) + lane;
        f32x4 v[4]; float s = 0.f;
#pragma unroll
        for (int j = 0; j < 4; ++j) { v[j] = xr[64 * j]; s += (v[j].x * v[j].x + v[j].y * v[j].y) + (v[j].z * v[j].z + v[j].w * v[j].w); }
        s = wave_sum(s);
        if (lane == 0) ssq[m] = s;
        v2u* o = (v2u*)(xn + (size_t)m * D) + lane;
#pragma unroll
        for (int j = 0; j < 4; ++j) { v2u w; w.x = pk_bf16(v[j].x, v[j].y); w.y = pk_bf16(v[j].z, v[j].w); o[64 * j] = w; }
    }
}

constexpr int KP = 72;
constexpr float SB_EXIT = 40.0f * 1.44269504089f;
typedef short v4i16_t __attribute__((ext_vector_type(4)));
__device__ __forceinline__ v2u vtr(const LAS bf16* p) { return __builtin_bit_cast(v2u, __builtin_amdgcn_ds_read_tr16_b64_v4i16((LAS v4i16_t*)p)); }
__device__ __forceinline__ void attn_phase(LAS unsigned char* lds, const bf16* Q, const bf16* K, const bf16* V, bf16* O, const float* qg, const float* kg, int gw, int ngw, int wave_s) {
    int tid_ = wave_s * 64 + lane_id_(); asm volatile("" : "+v"(tid_));
    const int lane = tid_ & 63, w = __builtin_amdgcn_readfirstlane(tid_ >> 6), hi = lane >> 5, ql = lane & 31;
    LAS bf16* Ks = (LAS bf16*)(lds + w * (64 * KP * 2));
    LAS bf16* Vs = Ks + 32 * KP;
    const int skey = lane >> 3, sch = lane & 7;
    const LAS bf16* vtb = Vs + (4 * hi + ((lane & 15) >> 2)) * KP + 16 * ((lane >> 4) & 1) + 4 * (lane & 3);
    for (int wu = gw; wu < BATCH * NH * 64; wu += ngw) {
        const int qblk = wu & 63, bh = wu >> 6, b = bh >> 4, h = bh & 15;
        const int tq = 32 * qblk + ql;
        bf16x8 qf[4];
        {
            const bf16* qp = Q + (size_t)(b * SEQ + tq) * D + h * HD + 8 * hi;
            float qv[4][8]; float ss = 0.f;
#pragma unroll
            for (int s = 0; s < 4; ++s) { const v4u r = *(const v4u*)(qp + 16 * s);
                qv[s][0] = bf_lo(r.x); qv[s][1] = bf_hi(r.x); qv[s][2] = bf_lo(r.y); qv[s][3] = bf_hi(r.y); qv[s][4] = bf_lo(r.z); qv[s][5] = bf_hi(r.z); qv[s][6] = bf_lo(r.w); qv[s][7] = bf_hi(r.w);
#pragma unroll
                for (int j = 0; j < 8; ++j) ss += qv[s][j] * qv[s][j]; }
            ss += __shfl_xor(ss, 32);
            const float rs = (0.125f * LOG2E) * __builtin_amdgcn_rsqf(ss * (1.f / HD) + EPS);
#pragma unroll
            for (int s = 0; s < 4; ++s) { float gp[8];
#pragma unroll
                for (int j = 0; j < 8; ++j) gp[j] = qg[16 * s + 8 * hi + j] * kg[16 * s + 8 * hi + j];
                v4u p;
                p.x = pk_bf16(qv[s][0] * rs * gp[0], qv[s][1] * rs * gp[1]); p.y = pk_bf16(qv[s][2] * rs * gp[2], qv[s][3] * rs * gp[3]);
                p.z = pk_bf16(qv[s][4] * rs * gp[4], qv[s][5] * rs * gp[5]); p.w = pk_bf16(qv[s][6] * rs * gp[6], qv[s][7] * rs * gp[7]);
                qf[s] = __builtin_bit_cast(bf16x8, p); }
        }
        f32x16 o0, o1;
#pragma unroll
        for (int i = 0; i < 16; ++i) { o0[i] = 0.f; o1[i] = 0.f; }
        float R = 0.f;
        v4u krA[4], vrA[4], krB[4], vrB[4];
        int kb = qblk;
        const bf16* kbase = K + (size_t)(b * SEQ + skey) * D + h * HD + 8 * sch;
        const bf16* vbase = V + (size_t)(b * SEQ + skey) * D + h * HD + 8 * sch;
#define ATT_LOAD(KR, VR, KBL) do { _Pragma("unroll") for (int i = 0; i < 4; ++i) { KR[i] = *(const v4u*)(kbase + (size_t)(32 * (KBL) + 8 * i) * D); VR[i] = *(const v4u*)(vbase + (size_t)(32 * (KBL) + 8 * i) * D); } } while (0)
#define ATT_BLOCK(KR, VR, KBC) do { \
            _Pragma("unroll") for (int i = 0; i < 4; ++i) { \
                float kf[8] = {bf_lo(KR[i].x), bf_hi(KR[i].x), bf_lo(KR[i].y), bf_hi(KR[i].y), bf_lo(KR[i].z), bf_hi(KR[i].z), bf_lo(KR[i].w), bf_hi(KR[i].w)}; \
                float ss = 0.f; \
                _Pragma("unroll") for (int j = 0; j < 8; ++j) ss += kf[j] * kf[j]; \
                ss += __uint_as_float(__builtin_amdgcn_mov_dpp(__float_as_uint(ss), 0xB1, 0xF, 0xF, true)); ss += __uint_as_float(__builtin_amdgcn_mov_dpp(__float_as_uint(ss), 0x4E, 0xF, 0xF, true)); ss += __uint_as_float(__builtin_amdgcn_mov_dpp(__float_as_uint(ss), 0x141, 0xF, 0xF, true)); \
                const float rs = __builtin_amdgcn_rsqf(ss * (1.f / HD) + EPS); \
                v4u p_; p_.x = pk_bf16(kf[0] * rs, kf[1] * rs); p_.y = pk_bf16(kf[2] * rs, kf[3] * rs); \
                p_.z = pk_bf16(kf[4] * rs, kf[5] * rs); p_.w = pk_bf16(kf[6] * rs, kf[7] * rs); \
                *(LAS v4u*)(Ks + (skey + 8 * i) * KP + 8 * sch) = p_; \
                *(LAS v4u*)(Vs + (skey + 8 * i) * KP + 8 * sch) = VR[i]; \
            } \
            if ((KBC) >= 2) ATT_LOAD(KR, VR, (KBC) - 2); \
            f32x16 p; \
            _Pragma("unroll") for (int i = 0; i < 16; ++i) p[i] = 0.f; \
            _Pragma("unroll") for (int s = 0; s < 4; ++s) { const bf16x8 kf = *(const LAS bf16x8*)(Ks + ql * KP + 16 * s + 8 * hi); \
                p = __builtin_amdgcn_mfma_f32_32x32x16_bf16(kf, qf[s], p, 0, 0, 0); } \
            const bool diag = ((KBC) == qblk); \
            { \
                float sp[16], lb[16]; \
                _Pragma("unroll") for (int i = 0; i < 16; ++i) { \
                    const float z = p[i]; \
                    const float e = __builtin_amdgcn_exp2f(-fabsf(z)); \
                    const float l = __builtin_amdgcn_logf(1.0f + e); \
                    const int kl = 8 * (i >> 2) + 4 * hi + (i & 3); \
                    const bool valid = !diag || (kl < ql); \
                    sp[i] = valid ? fmaxf(z, 0.f) + l : 0.f; \
                    lb[i] = valid ? fminf(z, 0.f) - l : -1e30f; \
                } \
                float run = R; \
                _Pragma("unroll") for (int g = 3; g >= 0; --g) { \
                    const float Gm = (sp[4 * g] + sp[4 * g + 1]) + (sp[4 * g + 2] + sp[4 * g + 3]); \
                    const float Go = __shfl_xor(Gm, 32); \
                    const float aft = hi ? run : run + Go; \
                    const float e3 = aft, e2 = e3 + sp[4 * g + 3], e1 = e2 + sp[4 * g + 2], e0 = e1 + sp[4 * g + 1]; \
                    p[4 * g + 3] = __builtin_amdgcn_exp2f(lb[4 * g + 3] - e3); \
                    p[4 * g + 2] = __builtin_amdgcn_exp2f(lb[4 * g + 2] - e2); \
                    p[4 * g + 1] = __builtin_amdgcn_exp2f(lb[4 * g + 1] - e1); \
                    p[4 * g + 0] = __builtin_amdgcn_exp2f(lb[4 * g + 0] - e0); \
                    run += Gm + Go; \
                } \
                R = run; \
            } \
            _Pragma("unroll") for (int s2 = 0; s2 < 2; ++s2) { \
                v4u pa; pa.x = pk_bf16(p[8 * s2 + 0], p[8 * s2 + 1]); pa.y = pk_bf16(p[8 * s2 + 2], p[8 * s2 + 3]); \
                pa.z = pk_bf16(p[8 * s2 + 4], p[8 * s2 + 5]); pa.w = pk_bf16(p[8 * s2 + 6], p[8 * s2 + 7]); \
                const bf16x8 pav = __builtin_bit_cast(bf16x8, pa); \
                const LAS bf16* vp = vtb + (16 * s2) * KP; \
                v4u vb; { const v2u a_ = vtr(vp), c_ = vtr(vp + 8 * KP); vb.x = a_.x; vb.y = a_.y; vb.z = c_.x; vb.w = c_.y; } \
                o0 = __builtin_amdgcn_mfma_f32_32x32x16_bf16(pav, __builtin_bit_cast(bf16x8, vb), o0, 0, 0, 0); \
                { const v2u a_ = vtr(vp + 32), c_ = vtr(vp + 8 * KP + 32); vb.x = a_.x; vb.y = a_.y; vb.z = c_.x; vb.w = c_.y; } \
                o1 = __builtin_amdgcn_mfma_f32_32x32x16_bf16(pav, __builtin_bit_cast(bf16x8, vb), o1, 0, 0, 0); \
            } \
            done = ((KBC) == 0) || (__builtin_amdgcn_ballot_w64(R < SB_EXIT) == 0ull); \
        } while (0)
        ATT_LOAD(krA, vrA, kb);
        if (kb >= 1) ATT_LOAD(krB, vrB, kb - 1);
        for (;;) {
            bool done;
            ATT_BLOCK(krA, vrA, kb);
            if (done) break;
            ATT_BLOCK(krB, vrB, kb - 1);
            if (done) break;
            kb -= 2;
        }
#undef ATT_LOAD
#undef ATT_BLOCK
        {
            LAS bf16* Ot = Ks;
#pragma unroll
            for (int i = 0; i < 16; ++i) { const int r = 8 * (i >> 2) + 4 * hi + (i & 3);
                Ot[r * KP + ql] = (bf16)(pk_bf16(o0[i], 0.f) & 0xffffu); Ot[r * KP + 32 + ql] = (bf16)(pk_bf16(o1[i], 0.f) & 0xffffu); }
            bf16* op = O + (size_t)(b * SEQ + 32 * qblk + skey) * D + h * HD + 8 * sch;
#pragma unroll
            for (int i = 0; i < 4; ++i) *(v4u*)(op + (size_t)(8 * i) * D) = *(const LAS v4u*)(Ot + (skey + 8 * i) * KP + 8 * sch);
        }
    }
}

__device__ __forceinline__ void attn_phase2(LAS unsigned char* lds, const bf16* Q, const bf16* K, const bf16* V, bf16* O, const float* qg, const float* kg, int gw, int ngw, int wave_s) {
    int tid_ = wave_s * 64 + lane_id_(); asm volatile("" : "+v"(tid_));
    const int lane = tid_ & 63, w = __builtin_amdgcn_readfirstlane(tid_ >> 6), hi = lane >> 5, ql = lane & 31;
    LAS bf16* Ks = (LAS bf16*)(lds + w * (64 * KP * 2));
    LAS bf16* Vs = Ks + 32 * KP;
    const int skey = lane >> 3, sch = lane & 7;
    const LAS bf16* vtb = Vs + (4 * hi + ((lane & 15) >> 2)) * KP + 16 * ((lane >> 4) & 1) + 4 * (lane & 3);
    for (int wu = gw; wu < BATCH * NH * 32; wu += ngw) {
        const int pq = wu & 31, bh = wu >> 5, b = bh >> 4, h = bh & 15;
        const int qblk0 = 2 * pq, qblk1 = 2 * pq + 1;
        bf16x8 qfa[4], qfb[4];
#define ATT_LOADQ(QF, QBLK) do { \
            const bf16* qp = Q + (size_t)(b * SEQ + 32 * (QBLK) + ql) * D + h * HD + 8 * hi; \
            float qv[4][8]; float ss = 0.f; \
            _Pragma("unroll") for (int s = 0; s < 4; ++s) { const v4u r = *(const v4u*)(qp + 16 * s); \
                qv[s][0] = bf_lo(r.x); qv[s][1] = bf_hi(r.x); qv[s][2] = bf_lo(r.y); qv[s][3] = bf_hi(r.y); qv[s][4] = bf_lo(r.z); qv[s][5] = bf_hi(r.z); qv[s][6] = bf_lo(r.w); qv[s][7] = bf_hi(r.w); \
                _Pragma("unroll") for (int j = 0; j < 8; ++j) ss += qv[s][j] * qv[s][j]; } \
            ss += __shfl_xor(ss, 32); \
            const float rs = (0.125f * LOG2E) * __builtin_amdgcn_rsqf(ss * (1.f / HD) + EPS); \
            _Pragma("unroll") for (int s = 0; s < 4; ++s) { float gp[8]; \
                _Pragma("unroll") for (int j = 0; j < 8; ++j) gp[j] = qg[16 * s + 8 * hi + j] * kg[16 * s + 8 * hi + j]; \
                v4u p; \
                p.x = pk_bf16(qv[s][0] * rs * gp[0], qv[s][1] * rs * gp[1]); p.y = pk_bf16(qv[s][2] * rs * gp[2], qv[s][3] * rs * gp[3]); \
                p.z = pk_bf16(qv[s][4] * rs * gp[4], qv[s][5] * rs * gp[5]); p.w = pk_bf16(qv[s][6] * rs * gp[6], qv[s][7] * rs * gp[7]); \
                QF[s] = __builtin_bit_cast(bf16x8, p); } } while (0)
        ATT_LOADQ(qfa, qblk0);
        ATT_LOADQ(qfb, qblk1);
        f32x16 oa0, oa1, ob0, ob1;
#pragma unroll
        for (int i = 0; i < 16; ++i) { oa0[i] = 0.f; oa1[i] = 0.f; ob0[i] = 0.f; ob1[i] = 0.f; }
        float Ra = 0.f, Rb = 0.f;
        bool da = false, db = false;
        v4u kr[4], vr[4];
        int kb = qblk1;
        const bf16* kbase = K + (size_t)(b * SEQ + skey) * D + h * HD + 8 * sch;
        const bf16* vbase = V + (size_t)(b * SEQ + skey) * D + h * HD + 8 * sch;
#pragma unroll
        for (int i = 0; i < 4; ++i) { kr[i] = *(const v4u*)(kbase + (size_t)(32 * kb + 8 * i) * D); vr[i] = *(const v4u*)(vbase + (size_t)(32 * kb + 8 * i) * D); }
#define ATT_TILE(QF, O0, O1, RR, DIAG) do { \
            f32x16 p; \
            _Pragma("unroll") for (int i = 0; i < 16; ++i) p[i] = 0.f; \
            _Pragma("unroll") for (int s = 0; s < 4; ++s) { const bf16x8 kf = *(const LAS bf16x8*)(Ks + ql * KP + 16 * s + 8 * hi); \
                p = __builtin_amdgcn_mfma_f32_32x32x16_bf16(kf, QF[s], p, 0, 0, 0); } \
            const bool diag = (DIAG); \
            { \
                float sp[16], lb[16]; \
                _Pragma("unroll") for (int i = 0; i < 16; ++i) { \
                    const float z = p[i]; \
                    const float e = __builtin_amdgcn_exp2f(-fabsf(z)); \
                    const float l = __builtin_amdgcn_logf(1.0f + e); \
                    const int kl = 8 * (i >> 2) + 4 * hi + (i & 3); \
                    const bool valid = !diag || (kl < ql); \
                    sp[i] = valid ? fmaxf(z, 0.f) + l : 0.f; \
                    lb[i] = valid ? fminf(z, 0.f) - l : -1e30f; \
                } \
                float run = RR; \
                _Pragma("unroll") for (int g = 3; g >= 0; --g) { \
                    const float Gm = (sp[4 * g] + sp[4 * g + 1]) + (sp[4 * g + 2] + sp[4 * g + 3]); \
                    const float Go = __shfl_xor(Gm, 32); \
                    const float aft = hi ? run : run + Go; \
                    const float e3 = aft, e2 = e3 + sp[4 * g + 3], e1 = e2 + sp[4 * g + 2], e0 = e1 + sp[4 * g + 1]; \
                    p[4 * g + 3] = __builtin_amdgcn_exp2f(lb[4 * g + 3] - e3); \
                    p[4 * g + 2] = __builtin_amdgcn_exp2f(lb[4 * g + 2] - e2); \
                    p[4 * g + 1] = __builtin_amdgcn_exp2f(lb[4 * g + 1] - e1); \
                    p[4 * g + 0] = __builtin_amdgcn_exp2f(lb[4 * g + 0] - e0); \
                    run += Gm + Go; \
                } \
                RR = run; \
            } \
            _Pragma("unroll") for (int s2 = 0; s2 < 2; ++s2) { \
                v4u pa; pa.x = pk_bf16(p[8 * s2 + 0], p[8 * s2 + 1]); pa.y = pk_bf16(p[8 * s2 + 2], p[8 * s2 + 3]); \
                pa.z = pk_bf16(p[8 * s2 + 4], p[8 * s2 + 5]); pa.w = pk_bf16(p[8 * s2 + 6], p[8 * s2 + 7]); \
                const bf16x8 pav = __builtin_bit_cast(bf16x8, pa); \
                const LAS bf16* vp = vtb + (16 * s2) * KP; \
                v4u vb; { const v2u a_ = vtr(vp), c_ = vtr(vp + 8 * KP); vb.x = a_.x; vb.y = a_.y; vb.z = c_.x; vb.w = c_.y; } \
                O0 = __builtin_amdgcn_mfma_f32_32x32x16_bf16(pav, __builtin_bit_cast(bf16x8, vb), O0, 0, 0, 0); \
                { const v2u a_ = vtr(vp + 32), c_ = vtr(vp + 8 * KP + 32); vb.x = a_.x; vb.y = a_.y; vb.z = c_.x; vb.w = c_.y; } \
                O1 = __builtin_amdgcn_mfma_f32_32x32x16_bf16(pav, __builtin_bit_cast(bf16x8, vb), O1, 0, 0, 0); \
            } \
        } while (0)
        for (;;) {
#pragma unroll
            for (int i = 0; i < 4; ++i) {
                float kf[8] = {bf_lo(kr[i].x), bf_hi(kr[i].x), bf_lo(kr[i].y), bf_hi(kr[i].y), bf_lo(kr[i].z), bf_hi(kr[i].z), bf_lo(kr[i].w), bf_hi(kr[i].w)};
                float ss = 0.f;
#pragma unroll
                for (int j = 0; j < 8; ++j) ss += kf[j] * kf[j];
                ss += __uint_as_float(__builtin_amdgcn_mov_dpp(__float_as_uint(ss), 0xB1, 0xF, 0xF, true)); ss += __uint_as_float(__builtin_amdgcn_mov_dpp(__float_as_uint(ss), 0x4E, 0xF, 0xF, true)); ss += __uint_as_float(__builtin_amdgcn_mov_dpp(__float_as_uint(ss), 0x141, 0xF, 0xF, true));
                const float rs = __builtin_amdgcn_rsqf(ss * (1.f / HD) + EPS);
                v4u p_; p_.x = pk_bf16(kf[0] * rs, kf[1] * rs); p_.y = pk_bf16(kf[2] * rs, kf[3] * rs); p_.z = pk_bf16(kf[4] * rs, kf[5] * rs); p_.w = pk_bf16(kf[6] * rs, kf[7] * rs);
                *(LAS v4u*)(Ks + (skey + 8 * i) * KP + 8 * sch) = p_;
                *(LAS v4u*)(Vs + (skey + 8 * i) * KP + 8 * sch) = vr[i];
            }
            if (kb > 0) {
#pragma unroll
                for (int i = 0; i < 4; ++i) { kr[i] = *(const v4u*)(kbase + (size_t)(32 * (kb - 1) + 8 * i) * D); vr[i] = *(const v4u*)(vbase + (size_t)(32 * (kb - 1) + 8 * i) * D); }
            }
            if (!db) { ATT_TILE(qfb, ob0, ob1, Rb, kb == qblk1); db = (__builtin_amdgcn_ballot_w64(Rb < SB_EXIT) == 0ull); }
            if (kb <= qblk0 && !da) { ATT_TILE(qfa, oa0, oa1, Ra, kb == qblk0); da = (__builtin_amdgcn_ballot_w64(Ra < SB_EXIT) == 0ull); }
            if (kb == 0 || (da && db)) break;
            --kb;
        }
#undef ATT_LOADQ
#undef ATT_TILE
#define ATT_STORE(O0, O1, QBLK) do { \
            LAS bf16* Ot = Ks; \
            _Pragma("unroll") for (int i = 0; i < 16; ++i) { const int r = 8 * (i >> 2) + 4 * hi + (i & 3); \
                Ot[r * KP + ql] = (bf16)(pk_bf16(O0[i], 0.f) & 0xffffu); Ot[r * KP + 32 + ql] = (bf16)(pk_bf16(O1[i], 0.f) & 0xffffu); } \
            bf16* op = O + (size_t)(b * SEQ + 32 * (QBLK) + skey) * D + h * HD + 8 * sch; \
            _Pragma("unroll") for (int i = 0; i < 4; ++i) *(v4u*)(op + (size_t)(8 * i) * D) = *(const LAS v4u*)(Ot + (skey + 8 * i) * KP + 8 * sch); } while (0)
        ATT_STORE(oa0, oa1, qblk0);
        ATT_STORE(ob0, ob1, qblk1);
#undef ATT_STORE
    }
}

constexpr int LT = 128, NCH = SEQ / LT;
#define LDS_BARRIER() do { asm volatile("s_waitcnt lgkmcnt(0)" ::: "memory"); __builtin_amdgcn_s_barrier(); asm volatile("" ::: "memory"); } while (0)
__device__ __forceinline__ void lru_phase(LAS unsigned char* lds, const bf16* XB, const bf16* Y, bf16* HY, const bf16* WRt, const bf16* WIt,
        const float* convw, const float* convb, const float* br, const float* bi, const float* lam, unsigned long long* gran, int G, int bid, int wave_s) {
    int tid = wave_s * 64 + lane_id_(); asm volatile("" : "+v"(tid));
    const int lane = tid & 63, w = __builtin_amdgcn_readfirstlane(tid >> 6), hi = lane >> 5, ql = lane & 31;
    LAS float* xcF = (LAS float*)lds;
    LAS bf16* wL = (LAS bf16*)(lds + 32768);
    LAS bf16* xcB = (LAS bf16*)(lds + 65536);
    LAS float* segA = (LAS float*)(lds + 65536 + 128 * KP * 2);
    LAS float* segH = segA + 512;
    LAS float* pA = segH + 512;
    LAS float* pH = pA + 1024;
    LAS bf16* yL = (LAS bf16*)(lds + 65536 + 128 * KP * 2 + 16384);
    const int st = tid >> 3, cc = 8 * (tid & 7);
    LAS float* parL = (LAS float*)(lds + 118784);
    int n_loaded = -1;
    const int rb = w >> 1, cbk = w & 1, d = 32 * cbk + ql;
    v4u xt[2][4], yv[2];
#define LRU_LOAD_X(u_) do { const int ch_ = (u_) >> 7, bn_ = (u_) & 127, b_ = bn_ >> 4, n_ = bn_ & 15, t0_ = ch_ * LT, c0_ = 64 * n_; \
        _Pragma("unroll") for (int r = 0; r < 2; ++r) { yv[r] = *(const v4u*)(Y + (size_t)(b_ * SEQ + t0_ + st + 64 * r) * D + c0_ + cc); \
            _Pragma("unroll") for (int j = 0; j < 4; ++j) { const int ts = t0_ + st + 64 * r + j - 3; xt[r][j] = ts >= 0 ? *(const v4u*)(XB + (size_t)(b_ * SEQ + ts) * D + c0_ + cc) : (v4u){0u, 0u, 0u, 0u}; } } } while (0)
    if (bid < BATCH * 16 * NCH) LRU_LOAD_X(bid);
    for (int unit = bid; unit < BATCH * 16 * NCH; unit += G) {
        const int ch = unit >> 7, bn = unit & 127, b = bn >> 4, n = bn & 15;
        const int t0 = ch * LT, c0 = 64 * n;
        if (n != n_loaded) {
            LDS_BARRIER();
            if (tid < 256) parL[tid] = convw[(tid >> 6) * D + c0 + (tid & 63)];
            else if (tid < 320) parL[tid] = convb[c0 + tid - 256];
            else if (tid < 384) parL[tid] = br[c0 + tid - 320];
            else if (tid < 448) parL[tid] = bi[c0 + tid - 384];
            else { const float lm = lam[c0 + tid - 448]; parL[tid] = -8.0f * (fmaxf(-lm, 0.f) + __builtin_amdgcn_logf(1.0f + __builtin_amdgcn_exp2f(-fabsf(lm) * LOG2E)) * LN2); }
#pragma unroll
            for (int r = 0; r < 2; ++r) { const int e = tid + 512 * r, gate = e >> 9, row = (e >> 3) & 63, chk = e & 7;
                *(LAS v4u*)(wL + (gate * 64 + row) * KP + 8 * chk) = *(const v4u*)((gate ? WIt : WRt) + (size_t)n * 4096 + row * 64 + 8 * chk); }
            n_loaded = n;
        }
        LDS_BARRIER();
        {
            float cw[4][8], cb[8];
#pragma unroll
            for (int j = 0; j < 4; ++j) { const f32x4 c0v = *(const LAS f32x4*)(parL + j * 64 + cc), c1v = *(const LAS f32x4*)(parL + j * 64 + cc + 4);
                cw[j][0] = c0v[0]; cw[j][1] = c0v[1]; cw[j][2] = c0v[2]; cw[j][3] = c0v[3]; cw[j][4] = c1v[0]; cw[j][5] = c1v[1]; cw[j][6] = c1v[2]; cw[j][7] = c1v[3]; }
            { const f32x4 c0v = *(const LAS f32x4*)(parL + 256 + cc), c1v = *(const LAS f32x4*)(parL + 256 + cc + 4);
                cb[0] = c0v[0]; cb[1] = c0v[1]; cb[2] = c0v[2]; cb[3] = c0v[3]; cb[4] = c1v[0]; cb[5] = c1v[1]; cb[6] = c1v[2]; cb[7] = c1v[3]; }
#pragma unroll
            for (int r = 0; r < 2; ++r) {
                const int t = st + 64 * r;
                float acc[8];
#pragma unroll
                for (int e = 0; e < 8; ++e) acc[e] = cb[e];
#pragma unroll
                for (int j = 0; j < 4; ++j) {
                    const v4u x = xt[r][j];
                    acc[0] += cw[j][0] * bf_lo(x.x); acc[1] += cw[j][1] * bf_hi(x.x); acc[2] += cw[j][2] * bf_lo(x.y); acc[3] += cw[j][3] * bf_hi(x.y);
                    acc[4] += cw[j][4] * bf_lo(x.z); acc[5] += cw[j][5] * bf_hi(x.z); acc[6] += cw[j][6] * bf_lo(x.w); acc[7] += cw[j][7] * bf_hi(x.w);
                }
                *(LAS f32x4*)(xcF + t * 64 + cc) = (f32x4){acc[0], acc[1], acc[2], acc[3]}; *(LAS f32x4*)(xcF + t * 64 + cc + 4) = (f32x4){acc[4], acc[5], acc[6], acc[7]};
                v4u p; p.x = pk_bf16(acc[0], acc[1]); p.y = pk_bf16(acc[2], acc[3]); p.z = pk_bf16(acc[4], acc[5]); p.w = pk_bf16(acc[6], acc[7]);
                *(LAS v4u*)(xcB + t * KP + cc) = p;
                *(LAS v4u*)(yL + t * KP + cc) = yv[r];
            }
        }
        if (unit + G < BATCH * 16 * NCH) LRU_LOAD_X(unit + G);
        LDS_BARRIER();
        unsigned xa[2] = {0u, 0u}, xh[2] = {0u, 0u}, xt_[2] = {0u, 0u};
#pragma unroll
        for (int q = 0; q < 2; ++q) { const int kk = w + 8 * q;
            if (kk < ch) { const unsigned long long* g = gran + ((size_t)(b * NCH + kk) * D + c0 + lane) * 2;
                const unsigned long long ya = __hip_atomic_load(g, __ATOMIC_RELAXED, __HIP_MEMORY_SCOPE_AGENT), yh = __hip_atomic_load(g + 1, __ATOMIC_RELAXED, __HIP_MEMORY_SCOPE_AGENT);
                xa[q] = (unsigned)ya; xh[q] = (unsigned)yh; xt_[q] = (unsigned)(ya >> 32) & (unsigned)(yh >> 32); } }
        float av[16], uv[16];
        const int c = lane, sg = 2 * rb + hi, tb = 32 * rb + 16 * hi;
        {
            f32x16 pr, pi;
#pragma unroll
            for (int i = 0; i < 16; ++i) { pr[i] = 0.f; pi[i] = 0.f; }
            const int trow = 32 * rb + 16 * ((ql >> 2) & 1) + 4 * (ql >> 3) + (ql & 3);
#pragma unroll
            for (int s = 0; s < 4; ++s) {
                const bf16x8 af = *(const LAS bf16x8*)(xcB + trow * KP + 16 * s + 8 * hi);
                const bf16x8 wr_ = *(const LAS bf16x8*)(wL + d * KP + 16 * s + 8 * hi), wi_ = *(const LAS bf16x8*)(wL + (64 + d) * KP + 16 * s + 8 * hi);
                pr = __builtin_amdgcn_mfma_f32_32x32x16_bf16(af, wr_, pr, 0, 0, 0);
                pi = __builtin_amdgcn_mfma_f32_32x32x16_bf16(af, wi_, pi, 0, 0, 0);
            }
            const float brv = parL[320 + d], biv = parL[384 + d], ls8 = parL[448 + d];
            float A = 1.f, H = 0.f;
#pragma unroll
            for (int i = 0; i < 16; ++i) {
                const float r = pg8::fast_sigmoid(pr[i] + brv), ig = pg8::fast_sigmoid(pi[i] + biv);
                const float la = ls8 * r;
                const float a = __builtin_amdgcn_exp2f(la * LOG2E);
                const float mult = __builtin_amdgcn_sqrtf(fmaxf(1.0f - a * a, 0.f));
                const float u = mult * ig * xcF[(tb + i) * 64 + d];
                av[i] = a; uv[i] = u; H = a * H + u; A *= a;
            }
            segA[sg * 64 + d] = A; segH[sg * 64 + d] = H;
        }
        LDS_BARRIER();
        if (w == 0 && ch < NCH - 1) {
            float At = 1.f, Ht = 0.f;
#pragma unroll
            for (int s = 0; s < 8; ++s) { const float a = segA[s * 64 + c], hh = segH[s * 64 + c]; Ht = a * Ht + hh; At *= a; }
            unsigned long long* g = gran + ((size_t)(b * NCH + ch) * D + c0 + c) * 2;
            __hip_atomic_store(g, (1ull << 32) | (unsigned long long)__float_as_uint(At), __ATOMIC_RELAXED, __HIP_MEMORY_SCOPE_AGENT);
            __hip_atomic_store(g + 1, (1ull << 32) | (unsigned long long)__float_as_uint(Ht), __ATOMIC_RELAXED, __HIP_MEMORY_SCOPE_AGENT);
        }
#pragma unroll
        for (int q = 0; q < 2; ++q) { const int kk = w + 8 * q;
            if (kk < ch) {
                const unsigned long long* g = gran + ((size_t)(b * NCH + kk) * D + c0 + c) * 2;
                for (unsigned spins = 0; spins < (1u << 22); ++spins) {
                    if (__all(xt_[q] == 1u)) break;
                    __builtin_amdgcn_s_sleep(1);
                    const unsigned long long ya = __hip_atomic_load(g, __ATOMIC_RELAXED, __HIP_MEMORY_SCOPE_AGENT), yh = __hip_atomic_load(g + 1, __ATOMIC_RELAXED, __HIP_MEMORY_SCOPE_AGENT);
                    xa[q] = (unsigned)ya; xh[q] = (unsigned)yh; xt_[q] = (unsigned)(ya >> 32) & (unsigned)(yh >> 32); }
                pA[kk * 64 + c] = __uint_as_float(xa[q]); pH[kk * 64 + c] = __uint_as_float(xh[q]);
            } }
        LDS_BARRIER();
        {
            float h = 0.f;
            for (int kk = 0; kk < ch; ++kk) h = pA[kk * 64 + d] * h + pH[kk * 64 + d];
            for (int s = 0; s < 7; ++s) { if (s < sg) h = segA[s * 64 + d] * h + segH[s * 64 + d]; }
#pragma unroll
            for (int i = 0; i < 16; ++i) { const int t = tb + i; h = av[i] * h + uv[i];
                const float yv_ = __uint_as_float((unsigned)yL[t * KP + d] << 16);
                xcB[t * KP + d] = (bf16)(pk_bf16(h * yv_, 0.f) & 0xffffu); }
        }
        LDS_BARRIER();
#pragma unroll
        for (int r = 0; r < 2; ++r) *(v4u*)(HY + (size_t)(b * SEQ + t0 + st + 64 * r) * D + c0 + cc) = *(const LAS v4u*)(xcB + (st + 64 * r) * KP + cc);
    }
}

#define RLX_AGENT __ATOMIC_RELAXED, __HIP_MEMORY_SCOPE_AGENT
#define XB_TMO      128
#define XB_XCNT(j)  (256  + 64 * (j))
#define XB_XSUB(j)  (1280 + 64 * (j))
#define XB_XGEN(j)  (2304 + 64 * (j))
#define XB_TOP      3328
#define XB_TOPGEN   3392
#define XCD_BAR_WORDS 3456
#define XB_SPIN_CAP (1u << 18)

__device__ __forceinline__ unsigned xb_ld(unsigned* p)              { return __hip_atomic_load(p, __ATOMIC_RELAXED, __HIP_MEMORY_SCOPE_AGENT); }
__device__ __forceinline__ unsigned xb_add(unsigned* p, unsigned v) { return __hip_atomic_fetch_add(p, v, __ATOMIC_RELAXED, __HIP_MEMORY_SCOPE_AGENT); }
__device__ __forceinline__ unsigned xb_xcc_id() { return (unsigned)__builtin_amdgcn_s_getreg((3 << 11) | 20) & 0xFu; }
#define XB_SPIN(cond, bar) do { unsigned _sp = 0; while (cond) { __builtin_amdgcn_s_sleep(1); \
    if ((++_sp & 255u) == 0u) { if (xb_ld(&(bar)[XB_TMO])) break; if (_sp > XB_SPIN_CAP) { atomicAdd(&(bar)[XB_TMO], 1u); break; } } } } while (0)

struct XcdBarrier {
    unsigned* bar; unsigned x;
    volatile LAS unsigned* st;
};

__device__ __forceinline__ XcdBarrier xcd_barrier_post(unsigned* bar, volatile LAS unsigned* st, bool is_t0) {
    XcdBarrier b; b.bar = bar; b.x = xb_xcc_id(); b.st = st;
    if (is_t0) (void)xb_add(&bar[XB_XCNT(b.x)], 1u);
    return b;
}
__device__ __forceinline__ void xcd_barrier_complete(unsigned* bar, unsigned x, unsigned& nloc, unsigned& nx) {
    const unsigned G = gridDim.x * gridDim.y * gridDim.z;
    unsigned sum, cnt, mine, sp = 0u;
    for (;;) {
        sum = 0u; cnt = 0u; mine = 0u;
#pragma unroll
        for (unsigned j = 0; j < 16; ++j) { const unsigned c = xb_ld(&bar[XB_XCNT(j)]); sum += c; cnt += (c > 0u) ? 1u : 0u; mine = (j == x) ? c : mine; }
        if (sum == G) break;
        __builtin_amdgcn_s_sleep(1);
        if ((++sp & 255u) == 0u) { if (xb_ld(&bar[XB_TMO])) break; if (sp > XB_SPIN_CAP) { atomicAdd(&bar[XB_TMO], 1u); break; } }
    }
    nloc = mine > 0u ? mine : 1u; nx = cnt > 0u ? cnt : 1u;
}

__device__ __forceinline__ void xcd_barrier(const XcdBarrier& b, int wave_s) {
    asm volatile("s_waitcnt vmcnt(0)" ::: "memory");
    __syncthreads();
    if (wave_s == 0 && lane_id_() == 0) {
        unsigned* bar = b.bar;
        __builtin_amdgcn_s_waitcnt(0);
        unsigned nloc = b.st[0], nx = b.st[1];
        if (nloc == 0u) { xcd_barrier_complete(bar, b.x, nloc, nx); b.st[0] = nloc; b.st[1] = nx; }
        const unsigned old = xb_add(&bar[XB_XSUB(b.x)], 1u);
        const unsigned gen = old / nloc;
        if (old + 1u == (gen + 1u) * nloc) {
            __builtin_amdgcn_fence(__ATOMIC_RELEASE, "agent");
            asm volatile("s_waitcnt vmcnt(0)" ::: "memory");
            const unsigned og = xb_add(&bar[XB_TOP], 1u);
            const unsigned tg = og / nx;
            if (og + 1u == (tg + 1u) * nx) xb_add(&bar[XB_TOPGEN], 1u);
            else XB_SPIN(xb_ld(&bar[XB_TOPGEN]) == tg, bar);
            __builtin_amdgcn_fence(__ATOMIC_ACQUIRE, "agent");
            xb_add(&bar[XB_XGEN(b.x)], 1u);
            asm volatile("s_waitcnt vmcnt(0)" ::: "memory");
        } else {
            XB_SPIN(xb_ld(&bar[XB_XGEN(b.x)]) == gen, bar);
            __builtin_amdgcn_fence(__ATOMIC_ACQUIRE, "agent");
            asm volatile("s_waitcnt vmcnt(0)" ::: "memory");
        }
    }
    __syncthreads();
}

__device__ __forceinline__ int launder_s_(int k) { asm volatile("" : "+s"(k)); return k; }
struct Args { const float* in[28]; float* out; unsigned char* ws; };
__global__ void __launch_bounds__(512, 2) fwd_megakernel(Args a) {
    const float* const* kin_ = (const float* const*)__builtin_amdgcn_kernarg_segment_ptr();
#define AIN(k) (kin_[launder_s_(k)])
    extern __shared__ __attribute__((aligned(16))) unsigned char lds_raw[];
    cg::grid_group grid = cg::this_grid();
    LAS unsigned char* lds = (LAS unsigned char*)lds_raw;
    const int tid = threadIdx.x, lane = tid & 63, wave = __builtin_amdgcn_readfirstlane(tid >> 6);
    const int G = gridDim.x, bid = blockIdx.x;
    const int gw = bid * 8 + wave, ngw = G * 8;
    unsigned char* ws = a.ws;
    bf16* XN = (bf16*)(ws + WS_XN); bf16* ACT = (bf16*)(ws + WS_ACT);
    bf16* QB = ACT; bf16* KB = ACT + (size_t)M * D; bf16* VB = ACT + (size_t)2 * M * D;
    volatile LAS unsigned* MISC = (volatile LAS unsigned*)(lds + 131072 + 4096);
    if (tid < 2) MISC[tid] = 0u;
    __syncthreads();
    const XcdBarrier xbar = xcd_barrier_post((unsigned*)(ws + WS_CTL), MISC, tid == 0);

    float* SSQ = (float*)(ws + WS_SSQ);
#define SSQ_AT(s) (SSQ + (size_t)(s) * M)
    constexpr int I_IN = (D / 64) * (2 * FF / 32), I_OUT = (FF / 64) * (D / 32), I_QKV = (D / 64) * (3 * D / 32), I_SQ = (D / 64) * (D / 32), I_LIN = (D / 64) * (2 * D / 32), I_G = 16 * 2;
    constexpr int SEG0 = I_IN, SEG1 = SEG0 + I_OUT + I_QKV + I_SQ + I_IN, SEG2 = SEG1 + I_OUT + I_IN + I_OUT, SEG3 = SEG2 + I_LIN + I_SQ + 2 * I_G + I_IN + I_OUT;
#define FFW(f) (ws + W_FF0 + (size_t)(f) * (SZ_WIN + SZ_WOUT))
#define CONVERT_ITEMS(lo_, hi_, wk_, nwk_) do { LAS float* scr = (LAS float*)(lds + wave * 16384); int tl_ = lane_id_(); asm volatile("" : "+v"(tl_)); const int lane = tl_; \
        for (int it = (lo_) + (wk_); it < (hi_); it += (nwk_)) { int r = it; \
            if (r < I_IN) { transpose_item<true>(AIN(2), AIN(1), D, 2 * FF, (bf16*)FFW(0), scr, r, lane); continue; } r -= I_IN; \
            if (r < I_OUT) { transpose_item<false>(AIN(3), nullptr, FF, D, (bf16*)(FFW(0) + SZ_WIN), scr, r, lane); continue; } r -= I_OUT; \
            if (r < I_QKV) { transpose_item<false>(AIN(5), AIN(4), D, 3 * D, (bf16*)(ws + W_QKV), scr, r, lane); continue; } r -= I_QKV; \
            if (r < I_SQ) { transpose_item<false>(AIN(8), nullptr, D, D, (bf16*)(ws + W_O), scr, r, lane); continue; } r -= I_SQ; \
            if (r < I_IN) { transpose_item<true>(AIN(10), AIN(9), D, 2 * FF, (bf16*)FFW(1), scr, r, lane); continue; } r -= I_IN; \
            if (r < I_OUT) { transpose_item<false>(AIN(11), nullptr, FF, D, (bf16*)(FFW(1) + SZ_WIN), scr, r, lane); continue; } r -= I_OUT; \
            if (r < I_IN) { transpose_item<true>(AIN(13), AIN(12), D, 2 * FF, (bf16*)FFW(2), scr, r, lane); continue; } r -= I_IN; \
            if (r < I_OUT) { transpose_item<false>(AIN(14), nullptr, FF, D, (bf16*)(FFW(2) + SZ_WIN), scr, r, lane); continue; } r -= I_OUT; \
            if (r < I_LIN) { transpose_item<false>(AIN(16), AIN(15), D, 2 * D, (bf16*)(ws + W_LIN), scr, r, lane); continue; } r -= I_LIN; \
            if (r < I_SQ) { transpose_item<false>(AIN(24), nullptr, D, D, (bf16*)(ws + W_LO), scr, r, lane); continue; } r -= I_SQ; \
            if (r < I_G) { transpose_item<false>(AIN(19) + (size_t)(r >> 1) * 4096, nullptr, 64, 64, (bf16*)(ws + W_GR) + (size_t)(r >> 1) * 4096, scr, r & 1, lane); continue; } r -= I_G; \
            if (r < I_G) { transpose_item<false>(AIN(21) + (size_t)(r >> 1) * 4096, nullptr, 64, 64, (bf16*)(ws + W_GI) + (size_t)(r >> 1) * 4096, scr, r & 1, lane); continue; } r -= I_G; \
            if (r < I_IN) { transpose_item<true>(AIN(26), AIN(25), D, 2 * FF, (bf16*)FFW(3), scr, r, lane); continue; } r -= I_IN; \
            transpose_item<false>(AIN(27), nullptr, FF, D, (bf16*)(FFW(3) + SZ_WIN), scr, r, lane); } } while (0)
    const int ffn_units = (M / 256) * (2 * FF / 256), ffn_rounds = (ffn_units + G - 1) / G, idle_from = ffn_units - (ffn_rounds - 1) * G;
#define CONVERT_IN_TAIL(lo_, hi_) do { if (idle_from < G) { if (bid >= idle_from) CONVERT_ITEMS(lo_, hi_, (bid - idle_from) * 8 + wave, (G - idle_from) * 8); } \
        else CONVERT_ITEMS(lo_, hi_, gw, ngw); } while (0)
    {
        CONVERT_ITEMS(0, SEG0, gw, ngw);
        cvt_phase(AIN(0), XN, SSQ_AT(0), gw, ngw, lane);
        for (int i = bid * 512 + tid; i < 2 * BATCH * NCH * D; i += G * 512) ((unsigned long long*)(ws + WS_SUM))[i] = 0ull;
    }
#define SEAM() xcd_barrier(xbar, wave)
    if (a.ws == nullptr) grid.sync();
    SEAM();
#define GEMM(EPI, Aptr, Wptr, NN, KK, E) do { pg8::Gemm g{(Aptr), (const bf16*)(Wptr), M, (NN), (KK)}; pg8::StaticOrder S; S.init(M, (NN), G, bid); \
        pg8::gemm_phase<EPI, pg8::StaticOrder, true, true>(lds, g, S, (E), wave); } while (0)
#define FFN(widx, s_in, FIRST, LAST, TLO, THI) do { \
        { pg8::EpiSwiglu E{ACT, FF, SSQ_AT(s_in)}; GEMM(pg8::EpiSwiglu, XN, ws + W_FF0 + (size_t)(widx) * (SZ_WIN + SZ_WOUT), 2 * FF, D, E); } \
        if ((TLO) < (THI)) CONVERT_IN_TAIL(TLO, THI); \
        SEAM(); \
        { typedef pg8::EpiResid<FIRST, LAST, true> EpiR; EpiR E{AIN(0), ((float*)AIN(28)), XN, SSQ_AT((s_in) + 1)}; GEMM(EpiR, ACT, ws + W_FF0 + (size_t)(widx) * (SZ_WIN + SZ_WOUT) + SZ_WIN, D, FF, E); } \
        } while (0)

    FFN(0, 0, false, false, SEG0, SEG1);
    SEAM();
    { pg8::EpiSplit<99> E{ACT, (size_t)M * D, SSQ_AT(1)}; GEMM(pg8::EpiSplit<99>, XN, ws + W_QKV, 3 * D, D, E); }
    SEAM();
    { const int vcu = (G % 8 == 0) ? (bid % 8) * (G / 8) + bid / 8 : bid;
      attn_phase2(lds, QB, KB, VB, QB, AIN(6), AIN(7), vcu * 8 + wave, ngw, wave); }
    SEAM();
    { typedef pg8::EpiResid<false, false, false> EpiR; EpiR E{AIN(0), ((float*)AIN(28)), XN, SSQ_AT(2)}; GEMM(EpiR, QB, ws + W_O, D, D, E); }
    SEAM();
    FFN(1, 2, false, false, SEG1, SEG2);
    SEAM();
    FFN(2, 3, false, false, SEG2, SEG3);
    SEAM();
    { pg8::EpiSplit<1> E{ACT, (size_t)M * D, SSQ_AT(4)}; GEMM(pg8::EpiSplit<1>, XN, ws + W_LIN, 2 * D, D, E); }
    SEAM();
    lru_phase(lds, QB, KB, VB, (const bf16*)(ws + W_GR), (const bf16*)(ws + W_GI), AIN(17), AIN(18), AIN(20), AIN(22), AIN(23), (unsigned long long*)(ws + WS_SUM), G, (G % 8 == 0) ? (bid % 8) * (G / 8) + bid / 8 : bid, wave);
    SEAM();
    { typedef pg8::EpiResid<false, false, false> EpiR; EpiR E{AIN(0), ((float*)AIN(28)), XN, SSQ_AT(5)}; GEMM(EpiR, VB, ws + W_LO, D, D, E); }
    SEAM();
    FFN(3, 5, false, true, 0, 0);
}

extern "C" void kernel_launch(void* const* d_in, const int* in_sizes, int n_in, void* d_out, int out_size, void* d_ws, size_t ws_size, hipStream_t stream) {
    static int grid = 0;
    if (grid == 0) {
        if (n_in != 28 || out_size != M * D || ws_size < WS_END) { fprintf(stderr, "kernel_launch: unexpected problem (n_in %d out %d ws %zu)\n", n_in, out_size, ws_size); grid = -1; return; }
        int dev = 0, cus = 0, per_cu = 0;
        hipGetDevice(&dev); hipDeviceGetAttribute(&cus, hipDeviceAttributeMultiprocessorCount, dev);
        if (hipFuncSetAttribute((const void*)fwd_megakernel, hipFuncAttributeMaxDynamicSharedMemorySize, LDS_BYTES) != hipSuccess) { fprintf(stderr, "kernel_launch: hipFuncSetAttribute failed\n"); grid = -1; return; }
        if (hipOccupancyMaxActiveBlocksPerMultiprocessor(&per_cu, (const void*)fwd_megakernel, 512, LDS_BYTES) != hipSuccess || per_cu < 1) { fprintf(stderr, "kernel_launch: occupancy query says %d\n", per_cu); per_cu = 1; }
        (void)hipGetLastError();
        grid = cus * per_cu;
    }
    if (grid < 0) return;
    if (hipMemsetAsync((char*)d_ws + WS_CTL, 0, CTL_ZERO_BYTES, stream) != hipSuccess) { fprintf(stderr, "memset failed\n"); return; }
    Args a{};
    for (int i = 0; i < 28; ++i) a.in[i] = (const float*)d_in[i];
    a.out = (float*)d_out; a.ws = (unsigned char*)d_ws;
    void* args[] = {&a};
    hipError_t e = hipLaunchCooperativeKernel((const void*)fwd_megakernel, dim3(grid), dim3(512), args, LDS_BYTES, stream);
    if (e != hipSuccess) fprintf(stderr, "cooperative launch failed: %s (grid %d)\n", hipGetErrorString(e), grid);
}
```
